# Optimizing an MI355X kernel written in HIP

```python
import math
import jax, jax.numpy as jnp
from jax import lax
import numpy as np


D_MODEL = 1024
BATCH = 8
SEQ = 4096
DEPTH = 2

CTX_LEN = 256
GRID_W = 64
N_EVEN = (DEPTH + 1) // 2
N_ODD = DEPTH // 2
EPS = 1e-6

D_FOURIER = D_MODEL // 2
N_FOURIER_GROUPS = 4
FOURIER_GROUP_DIM = D_FOURIER // N_FOURIER_GROUPS

D_HYENA = D_MODEL // 2
HYENA_EMB_DIM = 33
HYENA_BANDS = (HYENA_EMB_DIM - 1) // 2
HYENA_FILTER_WIDTH = 64
HYENA_TARGET = 1e-2
HYENA_FAST_DECAY_PCT = 0.3
HYENA_SLOW_DECAY_PCT = 1.5
HYENA_MIN_DECAY = math.log(HYENA_TARGET) / HYENA_FAST_DECAY_PCT
HYENA_MAX_DECAY = math.log(HYENA_TARGET) / HYENA_SLOW_DECAY_PCT

MLA_HEADS = 16
Q_LORA_RANK = 256
KV_LORA_RANK = 128
QK_NOPE_DIM = 64
QK_ROPE_DIM = 32
V_HEAD_DIM = 64
QK_HEAD_DIM = QK_NOPE_DIM + QK_ROPE_DIM
ROPE_THETA = 10000.0
Q_BLOCK = 128

D_FF = 2816

kernel_name = 'hybrid_fourier_hyena_mla_dit_block'


def _f32(a):
    return a.astype(jnp.float32)


def _rms_norm(x, g):
    x32 = _f32(x)
    y = x32 * lax.rsqrt(jnp.mean(x32 * x32, axis=-1, keepdims=True) + EPS)
    return (y * _f32(g)).astype(x.dtype)


def _dwconv3(x, w, b):
    xp = jnp.pad(x, ((0, 0), (1, 1), (0, 0)))
    return xp[:, :-2] * w[0] + xp[:, 1:-1] * w[1] + xp[:, 2:] * w[2] + b


def _adaln(cond, w_mod, b_mod):
    mod = jax.nn.silu(cond) @ w_mod + b_mod
    return jnp.split(mod[:, None, :], 6, axis=-1)


def _modulate(h, shift, scale):
    return h * (1 + scale) + shift


def _hyena_filter_spectrum(L, w1, b1, w2, b2, w3, b3, w4, freq):
    pos = jnp.arange(L, dtype=jnp.float32)
    t = pos / max(L - 1, 1)
    bands = jnp.linspace(1e-4, HYENA_BANDS - 1, HYENA_BANDS, dtype=jnp.float32)
    ang = (2.0 * math.pi / L) * pos[:, None] * bands[None, :]
    z = jnp.concatenate([t[:, None], jnp.cos(ang), -jnp.sin(ang)], axis=-1)
    f = _f32(freq)
    h = jnp.sin(f * (z @ _f32(w1) + _f32(b1)))
    h = jnp.sin(f * (h @ _f32(w2) + _f32(b2)))
    h = jnp.sin(f * (h @ _f32(w3) + _f32(b3)))
    h = h @ _f32(w4)
    deltas = jnp.linspace(HYENA_MIN_DECAY, HYENA_MAX_DECAY, D_HYENA, dtype=jnp.float32)
    decay = jnp.exp(-t[:, None] * jnp.abs(deltas)[None, :])
    h_fwd = h[:, :D_HYENA] * decay
    h_bwd = h[:, D_HYENA:] * decay
    two_sided = jnp.concatenate([h_fwd, jnp.zeros((1, D_HYENA), jnp.float32), h_bwd[:0:-1]], axis=0)
    two_sided = two_sided / jnp.sum(jnp.abs(two_sided), axis=0, keepdims=True)
    return jnp.fft.rfft(two_sided, axis=0)


def _long_conv(u, spectrum, bias):
    L = u.shape[1]
    u32 = _f32(u)
    y = jnp.fft.irfft(jnp.fft.rfft(u32, n=2 * L, axis=1) * spectrum[None], n=2 * L, axis=1)[:, :L]
    return (y + u32 * _f32(bias)).astype(u.dtype)


def _fourier_hyena_mixer(h, w_in, w_out, conv_w, conv_b, w1, b1, w2, b2, w3, b3, w4, freq, hy_bias):
    B, L, _ = h.shape
    proj = h @ w_in
    u_f = _f32(proj[..., :D_FOURIER]).reshape(B, L, N_FOURIER_GROUPS, FOURIER_GROUP_DIM)
    y_f = jnp.fft.fft2(u_f, axes=(1, 3), norm='ortho').real.reshape(B, L, D_FOURIER).astype(h.dtype)
    u_h = _dwconv3(proj[..., D_FOURIER:], conv_w, conv_b)
    x0, x1, v = jnp.split(u_h, 3, axis=-1)
    spectrum = _hyena_filter_spectrum(L, w1, b1, w2, b2, w3, b3, w4, freq)
    y_h = x0 * _long_conv(v * x1, spectrum, hy_bias)
    return jnp.concatenate([y_f, y_h], axis=-1) @ w_out


def _rope_2d(x, rope):
    cos_r, sin_r, cos_c, sin_c = rope
    q4 = QK_ROPE_DIM // 4
    half = QK_ROPE_DIM // 2

    def rot(xa, cos, sin):
        x1, x2 = xa[..., :q4], xa[..., q4:]
        cos = cos[None, :, None, :]
        sin = sin[None, :, None, :]
        return jnp.concatenate([x1 * cos - x2 * sin, x1 * sin + x2 * cos], axis=-1)

    out = jnp.concatenate([rot(x[..., :half], cos_r, sin_r), rot(x[..., half:], cos_c, sin_c)], axis=-1)
    return out.astype(x.dtype)


def _mla_queries(a_q, q_a_norm, w_uq, q_norm, rope):
    B, L, _ = a_q.shape
    q = (_rms_norm(a_q, q_a_norm) @ w_uq).reshape(B, L, MLA_HEADS, QK_HEAD_DIM)
    q = _rms_norm(q, q_norm)
    if rope is not None:
        q = jnp.concatenate([q[..., :QK_NOPE_DIM], _rope_2d(q[..., QK_NOPE_DIM:], rope)], axis=-1)
    return q


def _mla_keys_values(a_kv, kv_a_norm, w_ukv, k_norm, rope):
    B, L, _ = a_kv.shape
    ckv = _rms_norm(a_kv[..., :KV_LORA_RANK], kv_a_norm)
    k_pe = a_kv[..., KV_LORA_RANK:]
    kv = (ckv @ w_ukv).reshape(B, L, MLA_HEADS, QK_NOPE_DIM + V_HEAD_DIM)
    k_nope, v = kv[..., :QK_NOPE_DIM], kv[..., QK_NOPE_DIM:]
    k_pe = jnp.broadcast_to(k_pe[:, :, None, :], (B, L, MLA_HEADS, QK_ROPE_DIM))
    k = _rms_norm(jnp.concatenate([k_nope, k_pe], axis=-1), k_norm)
    if rope is not None:
        k = jnp.concatenate([k[..., :QK_NOPE_DIM], _rope_2d(k[..., QK_NOPE_DIM:], rope)], axis=-1)
    return k, v


def _attend_blocks(q, k, v):
    B, S, H, Dq = q.shape
    nb = S // Q_BLOCK
    qb = q.reshape(B, nb, Q_BLOCK, H, Dq).transpose(1, 0, 2, 3, 4)
    scale = QK_HEAD_DIM ** -0.5

    def one(qblk):
        s = jnp.einsum('bqhd,bkhd->bhqk', qblk, k, preferred_element_type=jnp.float32) * scale
        p = jax.nn.softmax(s, axis=-1).astype(v.dtype)
        return jnp.einsum('bhqk,bkhv->bqhv', p, v)

    o = lax.map(one, qb)
    return o.transpose(1, 0, 2, 3, 4).reshape(B, S, H * V_HEAD_DIM)


def _conv_ffn(h, w_up, conv_w, conv_b, w_down):
    gate, val = jnp.split(h @ w_up, 2, axis=-1)
    return (jax.nn.silu(_dwconv3(gate, conv_w, conv_b)) * val) @ w_down


def setup_inputs(seed: int = 0) -> dict:
    key = jax.random.key(seed)
    ks = iter(jax.random.split(key, 40))

    def nrm(shape, scale):
        return scale * jax.random.normal(next(ks), shape, jnp.float32)

    def gain(shape):
        return 1.0 + 0.02 * jax.random.normal(next(ks), shape, jnp.float32)

    D = D_MODEL
    return {
        'x': nrm((BATCH, SEQ, D), 1.0),
        'c': nrm((BATCH, D), 1.0),
        'ctx': nrm((BATCH, CTX_LEN, D), 1.0),
        'c_ctx': nrm((D,), 1.0),
        'norm1': gain((DEPTH, D)),
        'norm2': gain((DEPTH, D)),
        'w_mod': nrm((DEPTH, D, 6 * D), 0.5 * D ** -0.5),
        'b_mod': nrm((DEPTH, 6 * D), 0.01),
        'ffn_w_up': nrm((DEPTH, D, 2 * D_FF), D ** -0.5),
        'ffn_conv_w': nrm((DEPTH, 3, D_FF), 3 ** -0.5),
        'ffn_conv_b': nrm((DEPTH, D_FF), 0.01),
        'ffn_w_down': nrm((DEPTH, D_FF, D), D_FF ** -0.5),
        'fh_w_in': nrm((N_EVEN, D, D_FOURIER + 3 * D_HYENA), D ** -0.5),
        'fh_w_out': nrm((N_EVEN, D_FOURIER + D_HYENA, D), (D_FOURIER + D_HYENA) ** -0.5),
        'hy_conv_w': nrm((N_EVEN, 3, 3 * D_HYENA), 3 ** -0.5),
        'hy_conv_b': nrm((N_EVEN, 3 * D_HYENA), 0.01),
        'hy_filt_w1': nrm((N_EVEN, HYENA_EMB_DIM, HYENA_FILTER_WIDTH), HYENA_EMB_DIM ** -0.5),
        'hy_filt_b1': nrm((N_EVEN, HYENA_FILTER_WIDTH), 0.1),
        'hy_filt_w2': nrm((N_EVEN, HYENA_FILTER_WIDTH, HYENA_FILTER_WIDTH), HYENA_FILTER_WIDTH ** -0.5),
        'hy_filt_b2': nrm((N_EVEN, HYENA_FILTER_WIDTH), 0.1),
        'hy_filt_w3': nrm((N_EVEN, HYENA_FILTER_WIDTH, HYENA_FILTER_WIDTH), HYENA_FILTER_WIDTH ** -0.5),
        'hy_filt_b3': nrm((N_EVEN, HYENA_FILTER_WIDTH), 0.1),
        'hy_filt_w4': nrm((N_EVEN, HYENA_FILTER_WIDTH, 2 * D_HYENA), HYENA_FILTER_WIDTH ** -0.5),
        'hy_freq': gain((N_EVEN, HYENA_FILTER_WIDTH)),
        'hy_bias': nrm((N_EVEN, D_HYENA), 0.5),
        'mla_w_in': nrm((N_ODD, D, Q_LORA_RANK + KV_LORA_RANK + QK_ROPE_DIM), D ** -0.5),
        'mla_q_a_norm': gain((N_ODD, Q_LORA_RANK)),
        'mla_w_uq': nrm((N_ODD, Q_LORA_RANK, MLA_HEADS * QK_HEAD_DIM), Q_LORA_RANK ** -0.5),
        'mla_kv_a_norm': gain((N_ODD, KV_LORA_RANK)),
        'mla_w_ukv': nrm((N_ODD, KV_LORA_RANK, MLA_HEADS * (QK_NOPE_DIM + V_HEAD_DIM)), KV_LORA_RANK ** -0.5),
        'mla_q_norm': gain((N_ODD, QK_HEAD_DIM)),
        'mla_k_norm': gain((N_ODD, QK_HEAD_DIM)),
        'mla_w_o': nrm((N_ODD, MLA_HEADS * V_HEAD_DIM, D), (MLA_HEADS * V_HEAD_DIM) ** -0.5),
    }


def reference(x, c, ctx, c_ctx, norm1, norm2, w_mod, b_mod, ffn_w_up, ffn_conv_w, ffn_conv_b, ffn_w_down,
              fh_w_in, fh_w_out, hy_conv_w, hy_conv_b, hy_filt_w1, hy_filt_b1, hy_filt_w2, hy_filt_b2,
              hy_filt_w3, hy_filt_b3, hy_filt_w4, hy_freq, hy_bias, mla_w_in, mla_q_a_norm, mla_w_uq,
              mla_kv_a_norm, mla_w_ukv, mla_q_norm, mla_k_norm, mla_w_o):
    L = x.shape[1]
    ROWS = L // GRID_W
    rows = jnp.broadcast_to(jnp.arange(ROWS, dtype=jnp.float32)[:, None], (ROWS, GRID_W)).reshape(-1)
    cols = jnp.broadcast_to(jnp.arange(GRID_W, dtype=jnp.float32)[None, :], (ROWS, GRID_W)).reshape(-1)
    n_freq = QK_ROPE_DIM // 4
    inv_freq = ROPE_THETA ** (-jnp.arange(n_freq, dtype=jnp.float32) / n_freq)
    ang_r = rows[:, None] * inv_freq[None, :]
    ang_c = cols[:, None] * inv_freq[None, :]
    rope = (jnp.cos(ang_r), jnp.sin(ang_r), jnp.cos(ang_c), jnp.sin(ang_c))

    for i in range(DEPTH):
        last = i == DEPTH - 1
        odd = i % 2 == 1
        j = i // 2
        sh1, sc1, g1, sh2, sc2, g2 = _adaln(c, w_mod[i], b_mod[i])
        hx = _modulate(_rms_norm(x, norm1[i]), sh1, sc1)
        if (not last) or odd:
            csh1, csc1, cg1, csh2, csc2, cg2 = _adaln(c_ctx[None, :], w_mod[i], b_mod[i])
            hc = _modulate(_rms_norm(ctx, norm1[i]), csh1, csc1)
        if not odd:
            fh = (fh_w_in[j], fh_w_out[j], hy_conv_w[j], hy_conv_b[j], hy_filt_w1[j], hy_filt_b1[j],
                  hy_filt_w2[j], hy_filt_b2[j], hy_filt_w3[j], hy_filt_b3[j], hy_filt_w4[j], hy_freq[j], hy_bias[j])
            yx = _fourier_hyena_mixer(hx, *fh)
            if not last:
                yc = _fourier_hyena_mixer(hc, *fh)
        else:
            w_in = mla_w_in[j]
            q_args = (mla_q_a_norm[j], mla_w_uq[j], mla_q_norm[j])
            kv_args = (mla_kv_a_norm[j], mla_w_ukv[j], mla_k_norm[j])
            a_x = hx @ w_in
            q_x = _mla_queries(a_x[..., :Q_LORA_RANK], *q_args, rope)
            k_x, v_x = _mla_keys_values(a_x[..., Q_LORA_RANK:], *kv_args, rope)
            a_c = hc @ (w_in if not last else w_in[:, Q_LORA_RANK:])
            k_c, v_c = _mla_keys_values(a_c[..., -(KV_LORA_RANK + QK_ROPE_DIM):], *kv_args, None)
            k_all = jnp.concatenate([k_x, k_c], axis=1)
            v_all = jnp.concatenate([v_x, v_c], axis=1)
            yx = _attend_blocks(q_x, k_all, v_all) @ mla_w_o[j]
            if not last:
                q_c = _mla_queries(a_c[..., :Q_LORA_RANK], *q_args, None)
                yc = _attend_blocks(q_c, k_c, v_c) @ mla_w_o[j]
        ffn = (ffn_w_up[i], ffn_conv_w[i], ffn_conv_b[i], ffn_w_down[i])
        x = x + g1 * yx
        x = x + g2 * _conv_ffn(_modulate(_rms_norm(x, norm2[i]), sh2, sc2), *ffn)
        if not last:
            ctx = ctx + cg1 * yc
            ctx = ctx + cg2 * _conv_ffn(_modulate(_rms_norm(ctx, norm2[i]), csh2, csc2), *ffn)
    return x
```

```cpp
#include <hip/hip_runtime.h>
#include <hip/hip_cooperative_groups.h>
#include <cstdio>
#include <cstdint>
namespace cg = cooperative_groups;

#ifndef MK_COOP
#define MK_COOP 1
#endif

#define LAS __attribute__((address_space(3)))
#define DEV __device__ __forceinline__
typedef unsigned short bf16_t;
typedef short bf16x8 __attribute__((ext_vector_type(8)));
typedef short s16x4 __attribute__((ext_vector_type(4)));
typedef float f32x4 __attribute__((ext_vector_type(4)));
typedef float f32x2 __attribute__((ext_vector_type(2)));
typedef float f32x16 __attribute__((ext_vector_type(16)));
typedef unsigned u32x4 __attribute__((ext_vector_type(4)));
typedef unsigned u32x2 __attribute__((ext_vector_type(2)));

constexpr int DM = 1024, NB = 8, SEQ = 4096, CTXL = 256;
constexpr int TX = NB * SEQ, TC = NB * CTXL, TT = TX + TC;
constexpr int DFF = 2816;
constexpr float EPS = 1e-6f;
constexpr int NPH = 20;
constexpr int NTHREADS = 512;
constexpr int RING_BYTES = 131072, MISC_OFF = RING_BYTES, LDS_BYTES = 147456;

constexpr size_t MiB = (size_t)1 << 20;
constexpr size_t WS_MOD = 0;
constexpr size_t WS_H3X = 1 * MiB, WS_H3C = 2 * MiB;
constexpr size_t WS_SMALL = 2 * MiB + 512 * 1024;
constexpr size_t WS_W = 4 * MiB;
constexpr size_t W_W1T = WS_W, W_WOUT = WS_W + 5 * MiB, W_WUP = WS_W + 7 * MiB, W_WDOWN = WS_W + 18 * MiB;
constexpr size_t W_MLAIN = WS_W, W_WUQ = WS_W + 1 * MiB, W_WUKV = WS_W + 2 * MiB, W_WO = WS_W + 3 * MiB;
constexpr size_t WS_XR = 28 * MiB;
constexpr size_t WS_PQT = 28 * MiB, WS_PQTC = 92 * MiB, WS_WT = 96 * MiB, WS_WTC = 128 * MiB, WS_X0C = 130 * MiB, WS_X0CC = 162 * MiB;
constexpr size_t WS_HX = 164 * MiB;
constexpr size_t WS_BIG = 232 * MiB;
constexpr size_t WS_T1 = 232 * MiB, WS_T2 = 296 * MiB, WS_HT = 360 * MiB, WS_HTC = 456 * MiB, WS_KF = 462 * MiB, WS_KFC = 494 * MiB;
constexpr size_t WS_FILT = 496 * MiB, WS_FILTC = 504 * MiB, WS_T1C = 505 * MiB, WS_CSC = 505 * MiB + 512 * 1024;
constexpr size_t WS_YT = WS_HT, WS_YTC = WS_HTC;
constexpr size_t WS_ACT = 232 * MiB;
constexpr size_t WS_SB = 420 * MiB;
constexpr size_t WS_SSQ2 = 2 * MiB + 512 * 1024;
constexpr size_t WS_ABUF = 232 * MiB, WS_KRAW = 232 * MiB, WS_OB = 232 * MiB, WS_AQN = 300 * MiB, WS_CKVN = 316 * MiB, WS_KB = 300 * MiB, WS_KPE = 402 * MiB, WS_QB = 416 * MiB;
constexpr size_t WS_VB = WS_HX;
constexpr size_t WS_END = 512 * MiB;

DEV unsigned cvt_pk_bf16(float lo, float hi) { unsigned r; asm volatile("v_cvt_pk_bf16_f32 %0, %1, %2" : "=v"(r) : "v"(lo), "v"(hi)); return r; }
DEV float bf2f(unsigned short h) { return __uint_as_float(((unsigned)h) << 16); }
DEV float wave_sum(float v) {
#pragma unroll
    for (int o = 1; o < 64; o <<= 1) v += __shfl_xor(v, o);
    return v;
}
DEV float silu_f(float x) { return x / (1.f + __expf(-x)); }

namespace pg8 {
constexpr int BM = 256, BK = 64, HALF = 128, HTB = HALF * BK * 2, STAGE_BYTES = 8 * HTB;
__host__ __device__ __forceinline__ int lds_byte(int r, int c) { const int st = (r >> 4) * 2 + (c >> 5), rr = r & 15, cc = c & 31, ob = rr * 64 + cc * 2; return st * 1024 + (ob ^ (((ob >> 9) & 1) << 5)); }
__host__ __device__ __forceinline__ void stage_rc(int b, int& R, int& C) { const int st = b / 1024, sb = b % 1024, swz = sb ^ (((sb >> 9) & 1) << 5); R = (st >> 1) * 16 + swz / 64; C = (st & 1) * 32 + (swz % 64) / 2; }
__host__ __device__ __forceinline__ int perm32(int rho) { const int n = rho >> 4, i = rho & 15; return 8 * (i >> 2) + 4 * n + (i & 3); }

struct Unit { int pm, pn, pz; long arow, brow; };
struct Gemm { const bf16_t* A; const bf16_t* Bt; int lda, ldb, K; long sAz, sBz; };

struct Sched {
    int nM, nN, nZ, G, c, mode;
    DEV bool next(int i, Unit& u) const {
        const long L = (long)i * G + c; const int per = nM * nN; if (L >= (long)per * nZ) return false;
        u.pz = (int)(L / per); int wgid = (int)(L % per);
        { const int q = per / 8, r = per % 8, xcd = wgid % 8, off = wgid / 8; wgid = (xcd < r ? xcd * (q + 1) : r * (q + 1) + (xcd - r) * q) + off; }
        const int nig = 8 * nN, gid = wgid / nig, fm = gid * 8, gsz = (nM - fm) < 8 ? (nM - fm) : 8;
        u.pm = fm + ((wgid % nig) % gsz); u.pn = (wgid % nig) / gsz;
        u.brow = (long)u.pn * 256;
        u.arow = (long)u.pm * 256;
        return true;
    }
};

template <class Epi>
DEV void gemm_phase(LAS unsigned char* lds, const Gemm g, const Sched& S, const Epi& E, const int tid) {
    const int wid = __builtin_amdgcn_readfirstlane(tid >> 6), lane = tid & 63, wr = wid >> 2, wc = wid & 3, fr = lane & 15, fq = lane >> 4;
    const int K = g.K, nt = K / BK;
    unsigned voffA[2], voffB[2];
#pragma unroll
    for (int i = 0; i < 2; ++i) { int R, C; stage_rc(tid * 16 + i * 8192, R, C); const int Rb = Epi::PERM ? ((R & ~31) + perm32(R & 31)) : R;
        voffA[i] = (unsigned)(R * g.lda + C) * 2u; voffB[i] = (unsigned)(Rb * g.ldb + C) * 2u; }
    const size_t kstep = (size_t)(BK * 2);
    const size_t hstepA = (size_t)HALF * g.lda * 2, hstepB = (size_t)HALF * g.ldb * 2;
    const unsigned ldsw = (unsigned)wid * 1024u;
    const int aoff = lds_byte(wr * 64 + fr, fq * 8), boff = lds_byte(wc * 32 + fr, fq * 8);
#define PG8_SA(b, h) (((b) * 2 + (h)) * HTB)
#define PG8_SB(b, h) ((4 + (b) * 2 + (h)) * HTB)
#define PG8_STAGE(bufoff, gbase, voff) do { _Pragma("unroll") for (int _i = 0; _i < 2; ++_i) \
        __builtin_amdgcn_global_load_lds((const unsigned*)((const char*)(gbase) + (voff)[_i]), (LAS unsigned*)(lds + (bufoff) + ldsw + _i * 8192), 16, 0, 0); } while (0)
#define PG8_LDA(dst, b, h) do { _Pragma("unroll") for (int m = 0; m < 4; ++m) _Pragma("unroll") for (int k = 0; k < 2; ++k) dst[m][k] = *(const LAS bf16x8*)(lds + PG8_SA(b, h) + aoff + m * 2048 + k * 1024); } while (0)
#define PG8_LDB(dst, b, h) do { _Pragma("unroll") for (int n = 0; n < 2; ++n) _Pragma("unroll") for (int k = 0; k < 2; ++k) dst[n][k] = *(const LAS bf16x8*)(lds + PG8_SB(b, h) + boff + n * 2048 + k * 1024); } while (0)
#define PG8_MMA(ai, bj, At, Bt) do { __builtin_amdgcn_s_setprio(1); _Pragma("unroll") for (int m = 0; m < 4; ++m) _Pragma("unroll") for (int n = 0; n < 2; ++n) _Pragma("unroll") for (int k = 0; k < 2; ++k) \
        acc[ai][bj][m][n] = __builtin_amdgcn_mfma_f32_16x16x32_bf16(Bt[n][k], At[m][k], acc[ai][bj][m][n], 0, 0, 0); __builtin_amdgcn_s_setprio(0); } while (0)
#define PG8_WAIT_V(n) asm volatile("s_waitcnt vmcnt(" #n ")" ::: "memory")
#define PG8_WAIT_L(n) asm volatile("s_waitcnt lgkmcnt(" #n ")" ::: "memory")
#define PG8_BAR __builtin_amdgcn_s_barrier()
#define PG8_SCHED __builtin_amdgcn_sched_barrier(0)
    Unit cur, nxt; int ui = 0;
    if (!S.next(0, cur)) return;
    f32x4 acc[2][2][4][2];
#pragma unroll
    for (int a = 0; a < 2; ++a)
#pragma unroll
        for (int b = 0; b < 2; ++b)
#pragma unroll
            for (int m = 0; m < 4; ++m)
#pragma unroll
                for (int n = 0; n < 2; ++n) acc[a][b][m][n] = (f32x4){0.f, 0.f, 0.f, 0.f};
    bf16x8 At[4][2], B0[2][2], B1[2][2];
    const char* cA = (const char*)g.A + ((long)cur.pz * g.sAz + cur.arow * (long)g.lda) * 2;
    const char* cB = (const char*)g.Bt + ((long)cur.pz * g.sBz + cur.brow * (long)g.ldb) * 2;
    PG8_STAGE(PG8_SB(0, 0), cB, voffB); PG8_STAGE(PG8_SB(0, 1), cB + hstepB, voffB); PG8_STAGE(PG8_SA(0, 0), cA, voffA); PG8_STAGE(PG8_SA(0, 1), cA + hstepA, voffA);
    if (wr == 1) PG8_BAR;
    PG8_WAIT_V(2); PG8_BAR;
    PG8_STAGE(PG8_SB(1, 0), cB + kstep, voffB); PG8_STAGE(PG8_SA(1, 0), cA + kstep, voffA); PG8_STAGE(PG8_SB(1, 1), cB + hstepB + kstep, voffB);
    PG8_WAIT_V(6); PG8_BAR;
    for (;;) {
        const bool has_next = S.next(ui + 1, nxt);
        const char* nA = has_next ? (const char*)g.A + ((long)nxt.pz * g.sAz + nxt.arow * (long)g.lda) * 2 : cA;
        const char* nB = has_next ? (const char*)g.Bt + ((long)nxt.pz * g.sBz + nxt.brow * (long)g.ldb) * 2 : cB;
        for (int t = 0; t < nt; t += 2) {
            const bool last = (t == nt - 2);
            const char* a1 = cA + (size_t)(t + 1) * kstep;
            const char* a2 = last ? nA : cA + (size_t)(t + 2) * kstep; const char* b2 = last ? nB : cB + (size_t)(t + 2) * kstep;
            const char* a3 = a2 + kstep; const char* b3 = b2 + kstep;
            PG8_LDB(B0, 0, 0); PG8_LDB(B1, 0, 1); PG8_SCHED; PG8_LDA(At, 0, 0); PG8_STAGE(PG8_SA(1, 1), a1 + hstepA, voffA);
            PG8_WAIT_V(8); PG8_WAIT_L(0); PG8_BAR; PG8_MMA(0, 0, At, B0); PG8_MMA(0, 1, At, B1); PG8_BAR; PG8_SCHED;
            PG8_LDA(At, 0, 1); PG8_STAGE(PG8_SB(0, 0), b2, voffB); PG8_STAGE(PG8_SB(0, 1), b2 + hstepB, voffB); PG8_STAGE(PG8_SA(0, 0), a2, voffA);
            PG8_WAIT_V(8); PG8_WAIT_L(0); PG8_BAR; PG8_MMA(1, 0, At, B0); PG8_MMA(1, 1, At, B1); PG8_BAR; PG8_SCHED;
            PG8_LDB(B0, 1, 0); PG8_LDB(B1, 1, 1); PG8_SCHED; PG8_LDA(At, 1, 0); PG8_STAGE(PG8_SA(0, 1), a2 + hstepA, voffA);
            PG8_WAIT_V(8); PG8_WAIT_L(0); PG8_BAR; PG8_MMA(0, 0, At, B0); PG8_MMA(0, 1, At, B1); PG8_BAR; PG8_SCHED;
            PG8_LDA(At, 1, 1); PG8_STAGE(PG8_SB(1, 0), b3, voffB); PG8_STAGE(PG8_SB(1, 1), b3 + hstepB, voffB); PG8_STAGE(PG8_SA(1, 0), a3, voffA);
            PG8_WAIT_V(8); PG8_WAIT_L(0); PG8_BAR; PG8_MMA(1, 0, At, B0); PG8_MMA(1, 1, At, B1); PG8_BAR; PG8_SCHED;
        }
        if (wr == 0) PG8_BAR;
        E(acc, cur, wr, wc, fr, fq, lds + MISC_OFF);
        if (!has_next) break;
#pragma unroll
        for (int a = 0; a < 2; ++a)
#pragma unroll
            for (int b = 0; b < 2; ++b)
#pragma unroll
                for (int m = 0; m < 4; ++m)
#pragma unroll
                    for (int n = 0; n < 2; ++n) acc[a][b][m][n] = (f32x4){0.f, 0.f, 0.f, 0.f};
        cur = nxt; cA = nA; cB = nB; ++ui;
        if (wr == 1) PG8_BAR;
    }
    PG8_WAIT_V(0);
    PG8_BAR;
#undef PG8_SA
#undef PG8_SB
#undef PG8_STAGE
#undef PG8_LDA
#undef PG8_LDB
#undef PG8_MMA
}

typedef f32x4 Acc[2][2][4][2];

struct EpiG1 {
    static constexpr bool PERM = true;
    bf16_t* PQt; bf16_t* Ht; bf16_t* PQtc; bf16_t* Htc;
    DEV void operator()(const Acc& acc, const Unit& u, int wr, int wc, int fr, int fq, LAS unsigned char*) const {
        const bool isx = u.pn < 128; const int b = isx ? (u.pn >> 4) : (u.pn - 128); const int tb = isx ? ((u.pn & 15) * 256) : 0;
#pragma unroll
        for (int ai = 0; ai < 2; ++ai)
#pragma unroll
            for (int m = 0; m < 4; ++m) {
                const int mrow = u.pm * 256 + ai * 128 + wr * 64 + m * 16 + fr;
                bf16_t* rowp;
                if (mrow < 1024) { const int nf = mrow >> 1, part = mrow & 1;
                    rowp = isx ? PQt + ((size_t)(b * 512 + nf) * 8192 + part * 4096) : PQtc + ((size_t)(b * 512 + nf) * 512 + part * 256); }
                else { const int cp = mrow - 1024; rowp = isx ? Ht + (size_t)(b * 1536 + cp) * 4096 : Htc + (size_t)(b * 1536 + cp) * 256; }
#pragma unroll
                for (int bj = 0; bj < 2; ++bj) { const int t0 = tb + bj * 128 + wc * 32 + 8 * fq;
                    const f32x4 v0 = acc[ai][bj][m][0], v1 = acc[ai][bj][m][1]; u32x4 w;
                    w.x = cvt_pk_bf16(v0[0], v0[1]); w.y = cvt_pk_bf16(v0[2], v0[3]); w.z = cvt_pk_bf16(v1[0], v1[1]); w.w = cvt_pk_bf16(v1[2], v1[3]);
                    *(u32x4*)(rowp + t0) = w; }
                asm volatile("" ::: "memory");
            }
    }
};
struct EpiBf16 {
    static constexpr bool PERM = true;
    bf16_t* O0; bf16_t* O1; int ldc, split, rowbase, zrows; float scale; const float* rs; int rsi; float rsdiv;
    DEV void operator()(const Acc& acc, const Unit& u, int wr, int wc, int fr, int fq, LAS unsigned char*) const {
        asm volatile("" : "+v"(fr), "+v"(fq));
        int colt = u.pn * 256; bf16_t* base = O0; if (split && colt >= split) { base = O1; colt -= split; }
        const int row0 = rowbase + u.pz * zrows + u.pm * 256 + wr * 64 + fr, col0 = colt + wc * 32 + 8 * fq;
#pragma unroll
        for (int ai = 0; ai < 2; ++ai)
#pragma unroll
            for (int m = 0; m < 4; ++m) { const int row = row0 + ai * 128 + m * 16; bf16_t* rowp = base + (size_t)row * ldc + col0;
                const float sc = rs ? scale / sqrtf(rs[(size_t)row * 2 + rsi] * rsdiv + EPS) : scale;
#pragma unroll
                for (int bj = 0; bj < 2; ++bj) { const f32x4 v0 = acc[ai][bj][m][0] * sc, v1 = acc[ai][bj][m][1] * sc; u32x4 w;
                    w.x = cvt_pk_bf16(v0[0], v0[1]); w.y = cvt_pk_bf16(v0[2], v0[3]); w.z = cvt_pk_bf16(v1[0], v1[1]); w.w = cvt_pk_bf16(v1[2], v1[3]);
                    *(u32x4*)(rowp + bj * 128) = w; } }
    }
};
struct EpiF32 {
    static constexpr bool PERM = false;
    float* O; int ldc;
    DEV void operator()(const Acc& acc, const Unit& u, int wr, int wc, int fr, int fq, LAS unsigned char*) const {
        const int row0 = u.pm * 256 + wr * 64 + fr, col0 = u.pn * 256 + wc * 32 + 4 * fq;
#pragma unroll
        for (int ai = 0; ai < 2; ++ai)
#pragma unroll
            for (int m = 0; m < 4; ++m) { float* rowp = O + (size_t)(row0 + ai * 128 + m * 16) * ldc + col0;
#pragma unroll
                for (int bj = 0; bj < 2; ++bj)
#pragma unroll
                    for (int n = 0; n < 2; ++n) *(f32x4*)(rowp + bj * 128 + n * 16) = acc[ai][bj][m][n]; }
    }
};
struct EpiMla {
    static constexpr bool PERM = false;
    bf16_t* aqn; bf16_t* ckvn; float* kpe; float* ssq; const float* gq; const float* gk;
    DEV void operator()(const Acc& acc, const Unit& u, int wr, int wc, int fr, int fq, LAS unsigned char* misc) const {
        asm volatile("" : "+v"(fr), "+v"(fq));
        const int rt = u.pm * 256; const bool isq = (u.pn == 0);
#pragma unroll
        for (int ai = 0; ai < 2; ++ai)
#pragma unroll
            for (int m = 0; m < 4; ++m) { const int rl = ai * 128 + wr * 64 + m * 16 + fr, row = rt + rl; float sq = 0.f;
#pragma unroll
                for (int bj = 0; bj < 2; ++bj)
#pragma unroll
                    for (int n = 0; n < 2; ++n) { const int c = bj * 128 + wc * 32 + n * 16 + 4 * fq; const f32x4 a = acc[ai][bj][m][n];
                        if (isq) { sq += (a[0] * a[0] + a[1] * a[1]) + (a[2] * a[2] + a[3] * a[3]);
                            if (row < TX) { const f32x4 g = *(const f32x4*)(gq + c); u32x2 w; w.x = cvt_pk_bf16(a[0] * g[0], a[1] * g[1]); w.y = cvt_pk_bf16(a[2] * g[2], a[3] * g[3]); *(u32x2*)(aqn + (size_t)row * 256 + c) = w; } }
                        else if (bj == 0) { sq += (a[0] * a[0] + a[1] * a[1]) + (a[2] * a[2] + a[3] * a[3]);
                            const f32x4 g = *(const f32x4*)(gk + c); u32x2 w; w.x = cvt_pk_bf16(a[0] * g[0], a[1] * g[1]); w.y = cvt_pk_bf16(a[2] * g[2], a[3] * g[3]); *(u32x2*)(ckvn + (size_t)row * 128 + c) = w; }
                        else if (wc == 0) { *(f32x4*)(kpe + (size_t)row * 32 + n * 16 + 4 * fq) = a; } }
                sq += __shfl_xor(sq, 16); sq += __shfl_xor(sq, 32); if (fq == 0) ((LAS float*)misc)[rl * 4 + wc] = sq;
                if (m & 1) asm volatile("" ::: "memory"); }
        asm volatile("s_waitcnt lgkmcnt(0)" ::: "memory"); __builtin_amdgcn_s_barrier(); asm volatile("" ::: "memory");
        const int t_ = (wr * 4 + wc) * 64 + fq * 16 + fr;
        if (t_ < 256) { const f32x4 p4 = *(const LAS f32x4*)((LAS float*)misc + t_ * 4); ssq[(size_t)(rt + t_) * 2 + u.pn] = (p4[0] + p4[1]) + (p4[2] + p4[3]); }
        asm volatile("s_waitcnt lgkmcnt(0)" ::: "memory"); __builtin_amdgcn_s_barrier(); asm volatile("" ::: "memory");
    }
};
struct EpiRes {
    static constexpr bool PERM = false;
    const float* baseX; const float* baseC; float* outX; float* outC; const float* gate; int ntst;
    DEV void operator()(const Acc& acc, const Unit& u, int wr, int wc, int fr, int fq, LAS unsigned char*) const {
        asm volatile("" : "+v"(fr), "+v"(fq));
        const int rt = u.pm * 256; const bool isx = rt < TX; const int mr = isx ? (rt >> 12) : 8;
        const float* bp = isx ? baseX + (size_t)rt * DM : baseC + (size_t)(rt - TX) * DM;
        float* op = isx ? outX + (size_t)rt * DM : outC + (size_t)(rt - TX) * DM;
        const int col0 = u.pn * 256 + wc * 32 + 4 * fq; const float* gp = gate + (size_t)mr * 6144 + col0;
        f32x4 gv[2][2];
#pragma unroll
        for (int bj = 0; bj < 2; ++bj)
#pragma unroll
            for (int n = 0; n < 2; ++n) gv[bj][n] = *(const f32x4*)(gp + bj * 128 + n * 16);
#pragma unroll
        for (int ai = 0; ai < 2; ++ai)
#pragma unroll
            for (int m = 0; m < 4; ++m) { const size_t off = (size_t)(ai * 128 + wr * 64 + m * 16 + fr) * DM + col0;
#pragma unroll
                for (int bj = 0; bj < 2; ++bj)
#pragma unroll
                    for (int n = 0; n < 2; ++n) { const f32x4 bs = *(const f32x4*)(bp + off + bj * 128 + n * 16);
                        const f32x4 ov = bs + gv[bj][n] * acc[ai][bj][m][n];
                        if (ntst) __builtin_nontemporal_store(ov, (f32x4*)(op + off + bj * 128 + n * 16)); else *(f32x4*)(op + off + bj * 128 + n * 16) = ov; }
                if (m & 1) asm volatile("" ::: "memory"); }
    }
};
struct EpiHF {
    static constexpr bool PERM = false;
    bf16_t* Yt; const float* KF; const float* l1inv; int Nh;
    DEV void operator()(const Acc& acc, const Unit& u, int wr, int wc, int fr, int fq, LAS unsigned char*) const {
        const int ldk = 2 * Nh; const float wN = 1.0f / (float)(2 * Nh);
#pragma unroll
        for (int ai = 0; ai < 2; ++ai)
#pragma unroll
            for (int m = 0; m < 4; ++m) { const int r = u.pm * 256 + ai * 128 + wr * 64 + m * 16 + fr, c = r & 511; const float s = l1inv[c] * wN;
                const float* k1p = KF + (size_t)c * ldk; const float* k2p = KF + (size_t)(512 + c) * ldk; bf16_t* yp = Yt + (size_t)r * ldk;
#pragma unroll
                for (int bj = 0; bj < 2; ++bj)
#pragma unroll
                    for (int n = 0; n < 2; ++n) { const int c0 = u.pn * 256 + bj * 128 + wc * 32 + n * 16 + 4 * fq, f0 = c0 >> 1;
                        const f32x4 k1 = *(const f32x4*)(k1p + c0), k2 = *(const f32x4*)(k2p + c0), a = acc[ai][bj][m][n];
                        const float kr0 = k1[0] + k2[0], ki0 = k1[1] - k2[1], kr1 = k1[2] + k2[2], ki1 = k1[3] - k2[3];
                        const float w0 = (c0 == 0) ? s : 2.f * s, w1 = 2.f * s;
                        const float yr0 = (a[0] * kr0 - a[1] * ki0) * w0, yi0 = (a[0] * ki0 + a[1] * kr0) * w0;
                        const float yr1 = (a[2] * kr1 - a[3] * ki1) * w1, yi1 = (a[2] * ki1 + a[3] * kr1) * w1;
                        *(unsigned*)(yp + f0) = cvt_pk_bf16(yr0, yr1); *(unsigned*)(yp + Nh + f0) = cvt_pk_bf16(yi0, yi1); }
                asm volatile("" ::: "memory"); }
    }
};
struct EpiHI {
    static constexpr bool PERM = false;
    bf16_t* ycat; const bf16_t* Wt; const bf16_t* x0c; const float* ynq; const float* bias; int L, rowbase;
    DEV void operator()(const Acc& acc, const Unit& u, int wr, int wc, int fr, int fq, LAS unsigned char*) const {
#pragma unroll
        for (int ai = 0; ai < 2; ++ai)
#pragma unroll
            for (int m = 0; m < 4; ++m) { const int r = u.pm * 256 + ai * 128 + wr * 64 + m * 16 + fr, b = r >> 9, c = r & 511; const float ny = ynq[r], bs = bias[c];
                const bf16_t* wp = Wt + (size_t)r * L; const bf16_t* xp = x0c + (size_t)r * L;
                bf16_t* op = ycat + (size_t)(rowbase + b * L) * DM + 512 + c;
#pragma unroll
                for (int bj = 0; bj < 2; ++bj)
#pragma unroll
                    for (int n = 0; n < 2; ++n) { const int t0 = u.pn * 256 + bj * 128 + wc * 32 + n * 16 + 4 * fq;
                        const u32x2 wv = *(const u32x2*)(wp + t0), xv = *(const u32x2*)(xp + t0); const f32x4 a = acc[ai][bj][m][n];
                        const float w0 = __uint_as_float(wv.x << 16), w1 = __uint_as_float(wv.x & 0xffff0000u), w2 = __uint_as_float(wv.y << 16), w3 = __uint_as_float(wv.y & 0xffff0000u);
                        const float x0 = __uint_as_float(xv.x << 16), x1 = __uint_as_float(xv.x & 0xffff0000u), x2 = __uint_as_float(xv.y << 16), x3 = __uint_as_float(xv.y & 0xffff0000u);
                        const float y0 = x0 * (a[0] + ny + w0 * bs), y1 = x1 * (a[1] - ny + w1 * bs), y2 = x2 * (a[2] + ny + w2 * bs), y3 = x3 * (a[3] - ny + w3 * bs);
                        const unsigned p01 = cvt_pk_bf16(y0, y1), p23 = cvt_pk_bf16(y2, y3);
                        op[(size_t)(t0 + 0) * DM] = (bf16_t)(p01 & 0xffffu); op[(size_t)(t0 + 1) * DM] = (bf16_t)(p01 >> 16);
                        op[(size_t)(t0 + 2) * DM] = (bf16_t)(p23 & 0xffffu); op[(size_t)(t0 + 3) * DM] = (bf16_t)(p23 >> 16); }
                asm volatile("" ::: "memory"); }
    }
};
struct EpiFFN {
    static constexpr bool PERM = true;
    bf16_t* act; const float* cw; const float* cb; float* sb;
    DEV void operator()(const Acc& acc, const Unit& u, int wr, int wc, int fr, int fq, LAS unsigned char* misc) const {
        asm volatile("" : "+v"(fr), "+v"(fq));
        const int lane = fq * 16 + fr;
        const int sbase = u.pm * 256, s0 = 0;
        float* sbp = sb + (size_t)u.pm * 6 * DFF;
        LAS float* xl = (LAS float*)misc;
        LAS float* xf = xl + 512;
#pragma unroll
        for (int ai = 0; ai < 2; ++ai) { const int q = 2 * ai + wr;
#pragma unroll
            for (int n = 0; n < 2; ++n) { const int cc = wc * 32 + 8 * fq + 4 * n;
                if (fr == 15) *(LAS f32x4*)(xl + q * 128 + cc) = acc[ai][0][3][n];
                if (fr == 0) *(LAS f32x4*)(xf + q * 128 + cc) = acc[ai][0][0][n]; } }
        asm volatile("s_waitcnt lgkmcnt(0)" ::: "memory"); __builtin_amdgcn_s_barrier(); asm volatile("" ::: "memory");
#define ROR1(x) __int_as_float(__builtin_amdgcn_update_dpp(0, __float_as_int(x), 0x121, 0xf, 0xf, false))
#define ROR15(x) __int_as_float(__builtin_amdgcn_update_dpp(0, __float_as_int(x), 0x12F, 0xf, 0xf, false))
#pragma unroll
        for (int n = 0; n < 2; ++n) { const int cc = wc * 32 + 8 * fq + 4 * n, j = u.pn * 128 + cc;
            const f32x4 w0 = *(const f32x4*)(cw + j), w1 = *(const f32x4*)(cw + DFF + j), w2 = *(const f32x4*)(cw + 2 * DFF + j), bb = *(const f32x4*)(cb + j);
#pragma unroll
            for (int ai = 0; ai < 2; ++ai) { const int q = 2 * ai + wr;
                const f32x4 bup = (q > 0) ? *(LAS f32x4*)(xl + (q - 1) * 128 + cc) : (f32x4){0.f, 0.f, 0.f, 0.f};
                const f32x4 bdn = (q < 3) ? *(LAS f32x4*)(xf + (q + 1) * 128 + cc) : (f32x4){0.f, 0.f, 0.f, 0.f};
                f32x4 Rprev = bup, Dcur;
#pragma unroll
                for (int e = 0; e < 4; ++e) Dcur[e] = ROR15(acc[ai][0][0][n][e]);
#pragma unroll
                for (int m = 0; m < 4; ++m) {
                    f32x4 Rm, Dnext = bdn;
#pragma unroll
                    for (int e = 0; e < 4; ++e) { Rm[e] = ROR1(acc[ai][0][m][n][e]); if (m < 3) Dnext[e] = ROR15(acc[ai][0][m < 3 ? m + 1 : 3][n][e]); }
                    const f32x4 up = (fr > 0) ? Rm : Rprev;
                    const f32x4 dn = (fr < 15) ? Dcur : Dnext;
                    Rprev = Rm; Dcur = Dnext;
                    const int rr = q * 64 + m * 16 + fr, sq = s0 + rr;
                    const f32x4 g = acc[ai][0][m][n], v = acc[ai][1][m][n];
                    f32x4 o;
#pragma unroll
                    for (int e = 0; e < 4; ++e) { const float z = w0[e] * up[e] + w1[e] * g[e] + w2[e] * dn[e] + bb[e]; o[e] = z * __builtin_amdgcn_rcpf(1.f + __builtin_amdgcn_exp2f(-1.4426950408889634f * z)) * v[e]; }
                    if (rr >= 1 && rr <= 254) { u32x2 w; w.x = cvt_pk_bf16(o[0], o[1]); w.y = cvt_pk_bf16(o[2], o[3]);
                        *(u32x2*)(act + (size_t)(sbase + sq) * DFF + j) = w; }
                    if (rr < 2 || rr > 253) { const int rid = rr < 2 ? rr : rr - 252; *(f32x4*)(sbp + (size_t)rid * DFF + j) = g;
                        if (rr == 0 || rr == 255) *(f32x4*)(sbp + (size_t)(4 + (rr == 255)) * DFF + j) = v; }
                }
                asm volatile("" ::: "memory");
            } }
#undef ROR1
#undef ROR15
    }
};
}

namespace att {
constexpr int KST = 12288, VST = 8192, STG = KST + VST;
constexpr int OFF_WS = 2 * STG;
constexpr int NT = 68;
constexpr float QSCALE = 0.10206207261596577f * 1.4426950408889634f;
DEV int crow(int r, int hi) { return (r & 3) + 8 * (r >> 2) + 4 * hi; }
DEV unsigned cvtpk(float lo, float hi) { return cvt_pk_bf16(lo, hi); }
DEV void pv(f32x16* o, int vb, bf16x8 pa0, bf16x8 pa1, bf16x8 pa2, bf16x8 pa3) {
#pragma unroll
    for (int d0 = 0; d0 < 2; ++d0) { s16x4 lo[4], hi[4];
#pragma unroll
        for (int ks = 0; ks < 4; ++ks) {
            asm volatile("ds_read_b64_tr_b16 %0,%1 offset:%c2" : "=&v"(lo[ks]) : "v"(vb), "i"(d0 * 4096 + ks * 1024) : "memory");
            asm volatile("ds_read_b64_tr_b16 %0,%1 offset:%c2" : "=&v"(hi[ks]) : "v"(vb), "i"(d0 * 4096 + ks * 1024 + 512) : "memory"); }
        asm volatile("s_waitcnt lgkmcnt(0)" ::: "memory"); __builtin_amdgcn_sched_barrier(0);
#define PKV(k) (bf16x8){lo[k][0], lo[k][1], lo[k][2], lo[k][3], hi[k][0], hi[k][1], hi[k][2], hi[k][3]}
        o[d0] = __builtin_amdgcn_mfma_f32_32x32x16_bf16(pa0, PKV(0), o[d0], 0, 0, 0);
        o[d0] = __builtin_amdgcn_mfma_f32_32x32x16_bf16(pa1, PKV(1), o[d0], 0, 0, 0);
        o[d0] = __builtin_amdgcn_mfma_f32_32x32x16_bf16(pa2, PKV(2), o[d0], 0, 0, 0);
        o[d0] = __builtin_amdgcn_mfma_f32_32x32x16_bf16(pa3, PKV(3), o[d0], 0, 0, 0);
#undef PKV
    }
}
DEV void pvh(f32x16* o, int vb, bf16x8 pa, bf16x8 pb) {
    s16x4 lo[4], hi[4];
#pragma unroll
    for (int d0 = 0; d0 < 2; ++d0)
#pragma unroll
        for (int kk = 0; kk < 2; ++kk) {
            asm volatile("ds_read_b64_tr_b16 %0,%1 offset:%c2" : "=&v"(lo[d0 * 2 + kk]) : "v"(vb), "i"(d0 * 4096 + kk * 1024) : "memory");
            asm volatile("ds_read_b64_tr_b16 %0,%1 offset:%c2" : "=&v"(hi[d0 * 2 + kk]) : "v"(vb), "i"(d0 * 4096 + kk * 1024 + 512) : "memory"); }
    asm volatile("s_waitcnt lgkmcnt(0)" ::: "memory"); __builtin_amdgcn_sched_barrier(0);
#define PKV(k) (bf16x8){lo[k][0], lo[k][1], lo[k][2], lo[k][3], hi[k][0], hi[k][1], hi[k][2], hi[k][3]}
    o[0] = __builtin_amdgcn_mfma_f32_32x32x16_bf16(pa, PKV(0), o[0], 0, 0, 0);
    o[1] = __builtin_amdgcn_mfma_f32_32x32x16_bf16(pa, PKV(2), o[1], 0, 0, 0);
    o[0] = __builtin_amdgcn_mfma_f32_32x32x16_bf16(pb, PKV(1), o[0], 0, 0, 0);
    o[1] = __builtin_amdgcn_mfma_f32_32x32x16_bf16(pb, PKV(3), o[1], 0, 0, 0);
#undef PKV
}
DEV float max3f(float a, float b, float c) { return fmaxf(fmaxf(a, b), c); }
DEV void attn_unit(int b, int h, int qb, const bf16_t* Q, const bf16_t* K, const bf16_t* V, bf16_t* O, LAS unsigned char* sh, const int tid, const float* qgain) {
    const int lane = tid & 63, r32 = lane & 31, hi = lane >> 5; const int wid = __builtin_amdgcn_readfirstlane(tid >> 6);
    const long qrow0 = (long)b * SEQ + qb * 256 + wid * 32;
    const bf16_t* Qw = Q + qrow0 * 1536 + h * 96;
    const unsigned lds0 = (unsigned)(uintptr_t)sh;
    LAS float* wsf = (LAS float*)(sh + OFF_WS) + wid * 64;
    bf16x8 qr[6];
#pragma unroll
    for (int d0 = 0; d0 < 6; ++d0) qr[d0] = *(const bf16x8*)(Qw + (long)r32 * 1536 + d0 * 16 + hi * 8);
    {
        float qv[6][8]; float ss = 0.f;
#pragma unroll
        for (int d0 = 0; d0 < 6; ++d0) { const u32x4 raw = __builtin_bit_cast(u32x4, qr[d0]);
            qv[d0][0] = __uint_as_float(raw.x << 16); qv[d0][1] = __uint_as_float(raw.x & 0xffff0000u); qv[d0][2] = __uint_as_float(raw.y << 16); qv[d0][3] = __uint_as_float(raw.y & 0xffff0000u);
            qv[d0][4] = __uint_as_float(raw.z << 16); qv[d0][5] = __uint_as_float(raw.z & 0xffff0000u); qv[d0][6] = __uint_as_float(raw.w << 16); qv[d0][7] = __uint_as_float(raw.w & 0xffff0000u);
#pragma unroll
            for (int e = 0; e < 8; ++e) ss += qv[d0][e] * qv[d0][e]; }
        ss += __shfl_xor(ss, 32);
        const float rstd = 1.0f / sqrtf(ss * (1.f / 96.f) + EPS);
#pragma unroll
        for (int d0 = 0; d0 < 6; ++d0) { const f32x4 g0 = *(const f32x4*)(qgain + d0 * 16 + hi * 8), g1 = *(const f32x4*)(qgain + d0 * 16 + hi * 8 + 4);
#pragma unroll
            for (int e = 0; e < 4; ++e) { qv[d0][e] *= rstd * g0[e]; qv[d0][4 + e] *= rstd * g1[e]; } }
        const int tq = qb * 256 + wid * 32 + r32; const float pr = (float)(tq >> 6), pc = (float)(tq & 63);
#pragma unroll
        for (int e = 0; e < 8; ++e) { const float invf = exp2f(-(float)e * (13.287712379549449f / 8.f));
            const float rr_ = pr * invf * 0.15915494309189535f, rc_ = pc * invf * 0.15915494309189535f;
            const float sr = __builtin_amdgcn_sinf(rr_), cr = __builtin_amdgcn_cosf(rr_), sc_ = __builtin_amdgcn_sinf(rc_), cc = __builtin_amdgcn_cosf(rc_);
            const float o4 = qv[4][e], o5 = qv[5][e], p4 = __shfl_xor(o4, 32), p5 = __shfl_xor(o5, 32);
            qv[4][e] = hi ? (p4 * sr + o4 * cr) : (o4 * cr - p4 * sr);
            qv[5][e] = hi ? (p5 * sc_ + o5 * cc) : (o5 * cc - p5 * sc_); }
#pragma unroll
        for (int d0 = 0; d0 < 6; ++d0) { u32x4 w; w.x = cvt_pk_bf16(qv[d0][0] * QSCALE, qv[d0][1] * QSCALE); w.y = cvt_pk_bf16(qv[d0][2] * QSCALE, qv[d0][3] * QSCALE);
            w.z = cvt_pk_bf16(qv[d0][4] * QSCALE, qv[d0][5] * QSCALE); w.w = cvt_pk_bf16(qv[d0][6] * QSCALE, qv[d0][7] * QSCALE); qr[d0] = __builtin_bit_cast(bf16x8, w); }
    }
    u32x4 kreg0, kreg1, vreg;
    const bool k2 = wid < 4;
#define KBASE(t) ((t) < 64 ? (long)b * SEQ + (t) * 64 : (long)TX + b * CTXL + ((t) - 64) * 64)
#define LOADT(t) do { const long kb_ = KBASE(t); \
        kreg0 = *(const u32x4*)(K + (kb_ + lane) * 1536 + h * 96 + wid * 8); \
        if (k2) kreg1 = *(const u32x4*)(K + (kb_ + lane) * 1536 + h * 96 + (8 + wid) * 8); \
        vreg = *(const u32x4*)(V + (kb_ + 16 * (wid & 3) + (lane >> 2)) * 1024 + h * 64 + (wid >> 2) * 32 + (lane & 3) * 8); } while (0)
#define STORET(s) do { LAS unsigned char* st_ = sh + (s) * STG; \
        *(LAS u32x4*)(st_ + wid * 1024 + lane * 16) = kreg0; if (k2) *(LAS u32x4*)(st_ + (8 + wid) * 1024 + lane * 16) = kreg1; \
        *(LAS u32x4*)(st_ + KST + wid * 1024 + lane * 16) = vreg; } while (0)
    float mrun = 0.f, lsum = 0.f; f32x16 o[2]; o[0] = f32x16{}; o[1] = f32x16{}; const f32x16 zero16 = f32x16{};
#define LOADK(t) do { const long kb_ = KBASE(t); kreg0 = *(const u32x4*)(K + (kb_ + lane) * 1536 + h * 96 + wid * 8); \
        if (k2) kreg1 = *(const u32x4*)(K + (kb_ + lane) * 1536 + h * 96 + (8 + wid) * 8); } while (0)
#define LOADV(t) do { const long kb_ = KBASE(t); vreg = *(const u32x4*)(V + (kb_ + 16 * (wid & 3) + (lane >> 2)) * 1024 + h * 64 + (wid >> 2) * 32 + (lane & 3) * 8); } while (0)
#define STOREK(s) do { LAS unsigned char* st_ = sh + (s) * STG; *(LAS u32x4*)(st_ + wid * 1024 + lane * 16) = kreg0; if (k2) *(LAS u32x4*)(st_ + (8 + wid) * 1024 + lane * 16) = kreg1; } while (0)
#define STOREV(s) do { LAS unsigned char* st_ = sh + (s) * STG; *(LAS u32x4*)(st_ + KST + wid * 1024 + lane * 16) = vreg; } while (0)
#define QKT(P0, P1, s) do { LAS unsigned char* kb = sh + (s) * STG + hi * 1024 + r32 * 16; \
        _Pragma("unroll") for (int d0 = 0; d0 < 6; ++d0) { \
            const bf16x8 b0 = *(const LAS bf16x8*)(kb + d0 * 2048), b1 = *(const LAS bf16x8*)(kb + d0 * 2048 + 512); \
            P0 = __builtin_amdgcn_mfma_f32_32x32x16_bf16(b0, qr[d0], d0 == 0 ? zero16 : P0, 0, 0, 0); \
            P1 = __builtin_amdgcn_mfma_f32_32x32x16_bf16(b1, qr[d0], d0 == 0 ? zero16 : P1, 0, 0, 0); } } while (0)
#define SOFTPAIR(P, r) do { mx = max3f(mx, P[r], P[r + 1]); f32x2 v_ = (f32x2){P[r], P[r + 1]} - m2; v_.x = __builtin_amdgcn_exp2f(v_.x); v_.y = __builtin_amdgcn_exp2f(v_.y); P[r] = v_.x; P[r + 1] = v_.y; sum2 += v_; } while (0)
#define STEP(PA0, PA1, PB0, PB1, t, HASQK) do { const int s = (t) & 1; const bool more1 = (t) + 1 < NT, more2 = (t) + 2 < NT; \
        if (more2) LOADK((t) + 2); if (more1) LOADV((t) + 1); \
        if (HASQK) QKT(PB0, PB1, s ^ 1); \
        float mx = PA0[0]; f32x2 sum2 = (f32x2){0.f, 0.f}; const f32x2 m2 = (f32x2){mrun, mrun}; \
        _Pragma("unroll") for (int r = 0; r < 16; r += 2) { SOFTPAIR(PA0, r); } \
        u32x4 pw0, pw1, pw2, pw3; \
        pw0 = (u32x4){cvtpk(PA0[0], PA0[1]), cvtpk(PA0[2], PA0[3]), cvtpk(PA0[4], PA0[5]), cvtpk(PA0[6], PA0[7])}; \
        pw1 = (u32x4){cvtpk(PA0[8], PA0[9]), cvtpk(PA0[10], PA0[11]), cvtpk(PA0[12], PA0[13]), cvtpk(PA0[14], PA0[15])}; \
        if (HASQK) { __builtin_amdgcn_sched_group_barrier(0x100, 3, 0); \
            _Pragma("unroll") for (int i_ = 0; i_ < 12; ++i_) { __builtin_amdgcn_sched_group_barrier(0x008, 1, 0); __builtin_amdgcn_sched_group_barrier(0x100, 1, 0); __builtin_amdgcn_sched_group_barrier(0x002, 5, 0); } } \
        __builtin_amdgcn_sched_barrier(0); \
        const int vb = (int)(lds0 + s * STG + KST) + ((lane >> 4) & 1) * 32 + (lane & 3) * 8 + (4 * hi + ((lane & 15) >> 2)) * 64; \
        pvh(o, vb, __builtin_bit_cast(bf16x8, pw0), __builtin_bit_cast(bf16x8, pw1)); \
        _Pragma("unroll") for (int r = 0; r < 16; r += 2) { SOFTPAIR(PA1, r); } \
        pw2 = (u32x4){cvtpk(PA1[0], PA1[1]), cvtpk(PA1[2], PA1[3]), cvtpk(PA1[4], PA1[5]), cvtpk(PA1[6], PA1[7])}; \
        pw3 = (u32x4){cvtpk(PA1[8], PA1[9]), cvtpk(PA1[10], PA1[11]), cvtpk(PA1[12], PA1[13]), cvtpk(PA1[14], PA1[15])}; \
        __builtin_amdgcn_sched_barrier(0); \
        pvh(o, vb + 2048, __builtin_bit_cast(bf16x8, pw2), __builtin_bit_cast(bf16x8, pw3)); \
        lsum += sum2.x + sum2.y; \
        float rm = fmaxf(mx, __shfl_xor(mx, 32)); \
        if (__any(rm - mrun > 8.0f)) { const float dl = fmaxf(rm - mrun, 0.f); mrun += dl; \
            const float f = __builtin_amdgcn_exp2f(-dl); lsum *= f; \
            if (hi == 0) wsf[r32] = f; \
            asm volatile("s_waitcnt lgkmcnt(0)" ::: "memory"); \
            _Pragma("unroll") for (int r = 0; r < 16; ++r) { const float fr_ = wsf[crow(r, hi)]; o[0][r] *= fr_; o[1][r] *= fr_; } } \
        if (more2) STOREK(s); if (more1) STOREV(s ^ 1); \
        __syncthreads(); } while (0)
    LOADK(0); LOADV(0); STOREK(0); STOREV(0); LOADK(1); STOREK(1); __syncthreads();
    f32x16 pA0, pA1, pB0 = f32x16{}, pB1 = f32x16{};
    QKT(pA0, pA1, 0);
    { float m0 = pA0[0];
#pragma unroll
        for (int r = 0; r < 16; ++r) m0 = max3f(m0, pA0[r], pA1[r]);
        mrun = fmaxf(m0, __shfl_xor(m0, 32)); }
    for (int t = 0; t < NT - 2; t += 2) {
        STEP(pA0, pA1, pB0, pB1, t, true);
        STEP(pB0, pB1, pA0, pA1, t + 1, true);
    }
    STEP(pA0, pA1, pB0, pB1, NT - 2, true);
    STEP(pB0, pB1, pA0, pA1, NT - 1, false);
#undef SOFTPAIR
#undef LOADK
#undef LOADV
#undef STOREK
#undef STOREV
#undef QKT
#undef STEP
#undef LOADT
#undef STORET
#undef KBASE
    lsum += __shfl_xor(lsum, 32);
    if (hi == 0) wsf[r32] = 1.0f / lsum;
    asm volatile("s_waitcnt lgkmcnt(0)" ::: "memory");
    bf16_t* Ow = O + qrow0 * 1024 + h * 64;
#pragma unroll
    for (int r = 0; r < 16; ++r) { const int q = crow(r, hi); const float f = wsf[q];
        const unsigned a = cvt_pk_bf16(o[0][r] * f, o[1][r] * f);
        Ow[(long)q * 1024 + r32] = (bf16_t)(a & 0xffffu); Ow[(long)q * 1024 + 32 + r32] = (bf16_t)(a >> 16); }
    __syncthreads();
}
}

namespace fftl {
constexpr float W16C[8] = {1.f, 0.923879533f, 0.707106781f, 0.382683432f, 0.f, -0.382683432f, -0.707106781f, -0.923879533f};
constexpr float W16S[8] = {0.f, 0.382683432f, 0.707106781f, 0.923879533f, 1.f, 0.923879533f, 0.707106781f, 0.382683432f};
DEV int padi(int n) { return n + ((n >> 5) << 2); }
template <bool INV> DEV void bfly(float& xr, float& xi, float& yr, float& yi, const float c, const float s) {
    if (!INV) { const float dr = xr - yr, di = xi - yi; xr += yr; xi += yi; yr = dr * c + di * s; yi = di * c - dr * s; }
    else { const float tr = yr * c - yi * s, ti = yr * s + yi * c; yr = xr - tr; yi = xi - ti; xr += tr; xi += ti; }
}
template <int LR, bool INV, bool PRUNE = false> DEV void pass_strided(LAS float* re, LAS float* im, const int N, const int s, const int tid, const int ncol, const int cstride) {
    constexpr int R = 1 << LR; const int h2 = N >> (s + LR), ngr = N / R; const float invN = 1.f / (float)N;
    const bool lin = (h2 & 31) == 0; const int ph2 = h2 + ((h2 >> 5) << 2);
    for (int w = tid; w < ngr * ncol; w += NTHREADS) {
        const int col = w >> __builtin_ctz(ngr), g = w & (ngr - 1);
        const int j = g & (h2 - 1), base = (g - j) * R + j, pbase = padi(base);
        float twc[LR][R / 2], tws[LR][R / 2];
        { const float rev = (float)(j << s) * invN; float c = __builtin_amdgcn_cosf(rev), sn = __builtin_amdgcn_sinf(rev);
#pragma unroll
            for (int k = 0; k < LR; ++k) { const int dk = R >> (k + 1);
#pragma unroll
                for (int mm = 0; mm < R / 2; ++mm) { float cc = 0.f, ss = 0.f;
                    if (mm < dk) { const int e8 = mm * (4 / dk);
                        if (e8 == 0) { cc = c; ss = sn; } else if (e8 == 1) { cc = (c - sn) * 0.70710678f; ss = (sn + c) * 0.70710678f; } else if (e8 == 2) { cc = -sn; ss = c; } else { cc = (-c - sn) * 0.70710678f; ss = (c - sn) * 0.70710678f; } }
                    twc[k][mm] = cc; tws[k][mm] = ss; }
                const float c2 = c * c - sn * sn, s2 = 2.f * c * sn; c = c2; sn = s2; } }
        LAS float* r_ = re + col * cstride; LAS float* i_ = im + col * cstride;
        float xr[R], xi[R];
#pragma unroll
        for (int m = 0; m < R; ++m) { if (PRUNE && !INV && m >= R / 2) { xr[m] = 0.f; xi[m] = 0.f; } else { const int p = lin ? pbase + m * ph2 : padi(base + m * h2); xr[m] = r_[p]; xi[m] = i_[p]; } }
#pragma unroll
        for (int kk = 0; kk < LR; ++kk) { const int k = INV ? LR - 1 - kk : kk; const int dk = R >> (k + 1);
#pragma unroll
            for (int m = 0; m < R; ++m) if ((m & dk) == 0) bfly<INV>(xr[m], xi[m], xr[m + dk], xi[m + dk], twc[k][m & (dk - 1)], tws[k][m & (dk - 1)]); }
#pragma unroll
        for (int m = 0; m < R; ++m) { if (!(PRUNE && INV && m >= R / 2)) { const int p = lin ? pbase + m * ph2 : padi(base + m * h2); r_[p] = xr[m]; i_[p] = xi[m]; } }
    }
}
template <bool INV> DEV void pass_final16(LAS float* re, LAS float* im, const int N, const int tid, const int ncol, const int cstride) {
    const int ng = N >> 4;
    for (int w = tid; w < ng * ncol; w += NTHREADS) { const int col = w >> __builtin_ctz(ng), g = w & (ng - 1); const int p0 = padi(16 * g);
        LAS float* r_ = re + col * cstride + p0; LAS float* i_ = im + col * cstride + p0;
        float xr[16], xi[16];
#pragma unroll
        for (int m = 0; m < 16; ++m) { xr[m] = r_[m]; xi[m] = i_[m]; }
#pragma unroll
        for (int kk = 0; kk < 4; ++kk) { const int k = INV ? 3 - kk : kk; const int dk = 8 >> k;
#pragma unroll
            for (int m = 0; m < 16; ++m) if ((m & dk) == 0) bfly<INV>(xr[m], xi[m], xr[m + dk], xi[m + dk], W16C[(m & (dk - 1)) << k], W16S[(m & (dk - 1)) << k]); }
#pragma unroll
        for (int m = 0; m < 16; ++m) { r_[m] = xr[m]; i_[m] = xi[m]; }
    }
}
template <bool INV> DEV void pass_any(const int LR, LAS float* re, LAS float* im, const int N, const int s, const int tid, const int ncol, const int cstride) {
    if (LR == 3) pass_strided<3, INV>(re, im, N, s, tid, ncol, cstride);
    else if (LR == 2) pass_strided<2, INV>(re, im, N, s, tid, ncol, cstride);
    else pass_strided<1, INV>(re, im, N, s, tid, ncol, cstride);
}
template <bool INV, bool PRUNE = false> DEV void run(LAS float* re, LAS float* im, const int logN, const int tid_in, const int ncol, const int cstride) {
    int tid = tid_in; asm volatile("" : "+v"(tid));
    const int N = 1 << logN, front = logN - 4;
    if (!INV) {
        if (PRUNE) pass_strided<3, false, true>(re, im, N, 0, tid, ncol, cstride); else pass_strided<3, false, false>(re, im, N, 0, tid, ncol, cstride);
        __syncthreads();
        for (int s = 3; s < front;) { const int LR = (front - s >= 3) ? 3 : front - s; pass_any<false>(LR, re, im, N, s, tid, ncol, cstride); __syncthreads(); s += LR; }
        pass_final16<false>(re, im, N, tid, ncol, cstride); __syncthreads();
    } else {
        pass_final16<true>(re, im, N, tid, ncol, cstride); __syncthreads();
        int s = front; const int rem = front % 3;
        if (rem) { s -= rem; pass_any<true>(rem, re, im, N, s, tid, ncol, cstride); __syncthreads(); }
        while (s > 3) { s -= 3; pass_any<true>(3, re, im, N, s, tid, ncol, cstride); __syncthreads(); }
        if (PRUNE) pass_strided<3, true, true>(re, im, N, 0, tid, ncol, cstride); else pass_strided<3, true, false>(re, im, N, 0, tid, ncol, cstride);
        __syncthreads();
    }
}
}

struct Args { const float* in[33]; float* out; unsigned char* ws; int ph_lo, ph_hi; };
enum { I_X = 0, I_C, I_CTX, I_CCTX, I_NORM1, I_NORM2, I_WMOD, I_BMOD, I_FUP, I_FCW, I_FCB, I_FDOWN, I_FHIN, I_FHOUT, I_HCW, I_HCB,
       I_HW1, I_HB1, I_HW2, I_HB2, I_HW3, I_HB3, I_HW4, I_HFREQ, I_HBIAS, I_MIN, I_MQAN, I_MUQ, I_MKVAN, I_MUKV, I_MQN, I_MKN, I_MWO };

struct Op {
    int type; const bf16_t* A; const bf16_t* Bt; int lda, ldb, K; long sAz, sBz; int nM, nN, nZ, mode, rot;
    void* o0; void* o1; const void* p0; const void* p1; const void* p2; const void* p3; void* x0; void* x1;
    int i0, i1, i2, i3, i4; float f0, f1;
};
enum { T_G1 = 0, T_BF16, T_F32, T_RES, T_HF, T_HI, T_FFN, T_MLA };

typedef const __attribute__((address_space(4))) unsigned char* kptr_t;
#define KIN(i) (((const float* const __attribute__((address_space(4)))*)kp)[i])
#define KOUT (*(float* const __attribute__((address_space(4)))*)(kp + 264))
#define KWS (*(unsigned char* const __attribute__((address_space(4)))*)(kp + 272))
DEV bool get_op(kptr_t kp, int ph, int idx, Op& o) {
    unsigned char* ws = KWS;
#define BF(off) ((bf16_t*)(ws + (off)))
#define FP(off) ((float*)(ws + (off)))
    o.sAz = 0; o.sBz = 0; o.nZ = 1; o.mode = 0; o.rot = 0; o.o1 = nullptr; o.p0 = o.p1 = o.p2 = o.p3 = nullptr; o.x0 = o.x1 = nullptr; o.i0 = o.i1 = o.i2 = o.i3 = o.i4 = 0; o.f0 = 1.f; o.f1 = 0.f;
    float* mod = FP(WS_MOD);
    switch (ph) {
    case 2:
        if (idx == 0) { o.type = T_G1; o.A = BF(W_W1T); o.Bt = BF(WS_HX); o.lda = 1024; o.ldb = 1024; o.K = 1024; o.nM = 10; o.nN = 136; o.o0 = BF(WS_PQT); o.o1 = BF(WS_HT); o.p0 = BF(WS_PQTC); o.p1 = BF(WS_HTC); return true; }
        if (idx == 99) { o.type = T_F32; o.A = BF(WS_FILT); o.Bt = BF(WS_T1); o.lda = 4096; o.ldb = 4096; o.K = 4096; o.nM = 4; o.nN = 32; o.rot = 176; o.o0 = FP(WS_KF); o.i0 = 8192; return true; }
        if (idx == 98) { o.type = T_F32; o.A = BF(WS_FILTC); o.Bt = BF(WS_T1C); o.lda = 256; o.ldb = 256; o.K = 256; o.nM = 4; o.nN = 2; o.rot = 240; o.o0 = FP(WS_KFC); o.i0 = 512; return true; }
        return false;
    case 4:
        if (idx == 95) { o.type = T_BF16; o.A = BF(WS_T2); o.Bt = BF(WS_PQT); o.lda = 8192; o.ldb = 8192; o.K = 8192; o.sBz = 512L * 8192; o.nM = 16; o.nN = 2; o.nZ = 8; o.o0 = BF(WS_HX); o.i0 = 1024; o.i1 = 0; o.i2 = 0; o.i3 = 4096; o.f0 = 0.001381067932004975f; return true; }
        if (idx == 97) { o.type = T_HF; o.A = BF(WS_WT); o.Bt = BF(WS_T1); o.lda = 4096; o.ldb = 4096; o.K = 4096; o.nM = 16; o.nN = 32; o.o0 = BF(WS_YT); o.p0 = FP(WS_KF); o.p1 = FP(WS_SMALL); o.i0 = 4096; return true; }
        if (idx == 94) { o.type = T_BF16; o.A = BF(WS_CSC); o.Bt = BF(WS_PQTC); o.lda = 512; o.ldb = 512; o.K = 512; o.sBz = 512L * 512; o.nM = 1; o.nN = 2; o.nZ = 8; o.rot = 128; o.o0 = BF(WS_HX); o.i0 = 1024; o.i1 = 0; o.i2 = TX; o.i3 = 256; o.f0 = 0.005524271728019903f; return true; }
        if (idx == 96) { o.type = T_HF; o.A = BF(WS_WTC); o.Bt = BF(WS_T1C); o.lda = 256; o.ldb = 256; o.K = 256; o.nM = 16; o.nN = 2; o.rot = 160; o.o0 = BF(WS_YTC); o.p0 = FP(WS_KFC); o.p1 = FP(WS_SMALL + 4096); o.i0 = 256; return true; }
        return false;
    case 5:
        return false;
        if (idx == 0) { o.type = T_HI; o.A = BF(WS_YT); o.Bt = BF(WS_T1); o.lda = 8192; o.ldb = 8192; o.K = 8192; o.nM = 16; o.nN = 16; o.o0 = BF(WS_HX); o.p0 = BF(WS_WT); o.p1 = BF(WS_X0C); o.p2 = FP(WS_SMALL + 16384); o.p3 = KIN(I_HBIAS); o.i0 = 4096; o.i1 = 0; return true; }
        if (idx == 1) { o.type = T_HI; o.A = BF(WS_YTC); o.Bt = BF(WS_T1C); o.lda = 512; o.ldb = 512; o.K = 512; o.nM = 16; o.nN = 1; o.o0 = BF(WS_HX); o.p0 = BF(WS_WTC); o.p1 = BF(WS_X0CC); o.p2 = FP(WS_SMALL + 32768); o.p3 = KIN(I_HBIAS); o.i0 = 256; o.i1 = TX; return true; }
        return false;
    case 6:
        if (idx == 0) { o.type = T_RES; o.A = BF(WS_HX); o.Bt = BF(W_WOUT); o.lda = 1024; o.ldb = 1024; o.K = 1024; o.nM = 136; o.nN = 4; o.p0 = KIN(I_X); o.p1 = KIN(I_CTX); o.o0 = FP(WS_XR); o.o1 = FP(WS_XR) + (size_t)TX * DM; o.p2 = mod + 2 * 1024; return true; }
        return false;
    case 8:
        if (idx == 0) { o.type = T_FFN; o.A = BF(WS_HX); o.Bt = BF(W_WUP); o.lda = 1024; o.ldb = 1024; o.K = 1024; o.nM = 136; o.nN = 22; o.mode = 0; o.o0 = BF(WS_ACT); o.o1 = FP(WS_SB); o.p0 = KIN(I_FCW); o.p1 = KIN(I_FCB); return true; }
        return false;
    case 9:
        if (idx == 0) { o.type = T_RES; o.A = BF(WS_ACT); o.Bt = BF(W_WDOWN); o.lda = DFF; o.ldb = DFF; o.K = DFF; o.nM = 136; o.nN = 4; o.p0 = FP(WS_XR); o.p1 = FP(WS_XR) + (size_t)TX * DM; o.o0 = FP(WS_XR); o.o1 = FP(WS_XR) + (size_t)TX * DM; o.p2 = mod + 5 * 1024; return true; }
        return false;
    case 11:
        if (idx == 0) { o.type = T_MLA; o.A = BF(WS_HX); o.Bt = BF(W_MLAIN); o.lda = 1024; o.ldb = 1024; o.K = 1024; o.nM = 136; o.nN = 2; o.o0 = BF(WS_AQN); o.o1 = BF(WS_CKVN); o.x0 = FP(WS_KPE); o.x1 = FP(WS_SSQ2); o.p0 = KIN(I_MQAN); o.p1 = KIN(I_MKVAN); return true; }
        return false;
    case 13:
        if (idx == 0) { o.type = T_BF16; o.A = BF(WS_AQN); o.Bt = BF(W_WUQ); o.lda = 256; o.ldb = 256; o.K = 256; o.nM = 128; o.nN = 6; o.o0 = BF(WS_QB); o.i0 = 1536; o.i3 = 0; o.p0 = FP(WS_SSQ2); o.i4 = 0; o.f1 = 1.f / 256.f; return true; }
        if (idx == 1) { o.type = T_BF16; o.A = BF(WS_CKVN); o.Bt = BF(W_WUKV); o.lda = 128; o.ldb = 128; o.K = 128; o.nM = 136; o.nN = 8; o.o0 = BF(WS_KRAW); o.o1 = BF(WS_VB); o.i0 = 1024; o.i1 = 1024; o.p0 = FP(WS_SSQ2); o.i4 = 1; o.f1 = 1.f / 128.f; return true; }
        return false;
    case 16:
        if (idx == 0) { o.type = T_RES; o.A = BF(WS_OB); o.Bt = BF(W_WO); o.lda = 1024; o.ldb = 1024; o.K = 1024; o.nM = 128; o.nN = 4; o.p0 = FP(WS_XR); o.p1 = FP(WS_XR) + (size_t)TX * DM; o.o0 = FP(WS_XR); o.o1 = FP(WS_XR) + (size_t)TX * DM; o.p2 = mod + 9 * 6144 + 2 * 1024; return true; }
        return false;
    case 18:
        if (idx == 0) { o.type = T_FFN; o.A = BF(WS_HX); o.Bt = BF(W_WUP); o.lda = 1024; o.ldb = 1024; o.K = 1024; o.nM = 128; o.nN = 22; o.mode = 0; o.o0 = BF(WS_ACT); o.o1 = FP(WS_SB); o.p0 = KIN(I_FCW) + 3 * DFF; o.p1 = KIN(I_FCB) + DFF; return true; }
        return false;
    case 19:
        if (idx == 0) { o.type = T_RES; o.A = BF(WS_ACT); o.Bt = BF(W_WDOWN); o.lda = DFF; o.ldb = DFF; o.K = DFF; o.nM = 128; o.nN = 4; o.p0 = FP(WS_XR); o.p1 = FP(WS_XR) + (size_t)TX * DM; o.o0 = KOUT; o.o1 = KOUT; o.p2 = mod + 9 * 6144 + 5 * 1024; o.i0 = 1; return true; }
        return false;
    default: return false;
    }
#undef BF
#undef FP
}

DEV void tr_item(const float* W, int ldw, int K, bf16_t* WT, int dst_n0, int src_n0, int k0, LAS float* scr, int lane) {
#pragma unroll 8
    for (int i = 0; i < 32; ++i) { const int kk = 2 * i + (lane >> 5); scr[kk * 33 + (lane & 31)] = (src_n0 >= 0) ? W[(size_t)(k0 + kk) * ldw + src_n0 + (lane & 31)] : 0.f; }
    asm volatile("s_waitcnt lgkmcnt(0)" ::: "memory");
    const int c = lane & 7;
#pragma unroll
    for (int j = 0; j < 4; ++j) { const int n = (lane >> 3) + 8 * j; const LAS float* s = scr + (8 * c) * 33 + n;
        u32x4 o; o.x = cvt_pk_bf16(s[0 * 33], s[1 * 33]); o.y = cvt_pk_bf16(s[2 * 33], s[3 * 33]); o.z = cvt_pk_bf16(s[4 * 33], s[5 * 33]); o.w = cvt_pk_bf16(s[6 * 33], s[7 * 33]);
        *(u32x4*)(WT + (size_t)(dst_n0 + n) * K + k0 + 8 * c) = o; }
    asm volatile("s_waitcnt lgkmcnt(0)" ::: "memory");
}
DEV void tr_matrix(const float* W, int ldw, int K, int Ndst, bf16_t* WT, int map, int nvalid, int src_off, LAS float* scr, int gw, int NGW, int lane) {
    const int nblk = Ndst / 32, nit = (K / 64) * nblk;
    for (int it = gw; it < nit; it += NGW) { const int kb = it / nblk, nb = it % nblk, d0 = nb * 32; int s0 = d0;
        if (map == 1) { const int pn = d0 >> 8, wi = d0 & 255, bj = wi >> 7, jj = wi & 127; s0 = bj * DFF + 128 * pn + jj; }
        else if (map == 2) { if (d0 < 1024) s0 = (d0 >> 6) * 128 + (d0 & 63); else { const int n2 = d0 - 1024; s0 = (n2 >> 6) * 128 + 64 + (n2 & 63); } }
        else if (map == 3) { if (d0 >= nvalid) s0 = -1; }
        tr_item(W, ldw, K, WT, d0, s0 < 0 ? -1 : s0 + src_off, kb * 64, scr, lane); }
}
DEV void modnorm_rows(const float* srcX, const float* srcC, int nrows, const float* g, const float* shift, const float* scale, bf16_t* dst, int gw, int NGW, int lane) {
    for (int row0 = gw; row0 < nrows; row0 += 2 * NGW) {
        const int row1 = row0 + NGW; const bool has1 = row1 < nrows;
        const float* xr0 = (row0 < TX) ? srcX + (size_t)row0 * DM : srcC + (size_t)(row0 - TX) * DM;
        const float* xr1 = !has1 ? xr0 : ((row1 < TX) ? srcX + (size_t)row1 * DM : srcC + (size_t)(row1 - TX) * DM);
        f32x4 v0[4], v1[4]; float s0 = 0.f, s1 = 0.f;
#pragma unroll
        for (int j = 0; j < 4; ++j) { v0[j] = __builtin_nontemporal_load((const f32x4*)(xr0 + 256 * j + 4 * lane)); v1[j] = __builtin_nontemporal_load((const f32x4*)(xr1 + 256 * j + 4 * lane)); }
#pragma unroll
        for (int j = 0; j < 4; ++j) { s0 += (v0[j][0] * v0[j][0] + v0[j][1] * v0[j][1]) + (v0[j][2] * v0[j][2] + v0[j][3] * v0[j][3]); s1 += (v1[j][0] * v1[j][0] + v1[j][1] * v1[j][1]) + (v1[j][2] * v1[j][2] + v1[j][3] * v1[j][3]); }
        const float rstd0 = 1.0f / sqrtf(wave_sum(s0) * (1.f / DM) + EPS), rstd1 = 1.0f / sqrtf(wave_sum(s1) * (1.f / DM) + EPS);
        const int mr0 = (row0 < TX) ? (row0 >> 12) : 8, mr1 = (row1 < TX) ? (row1 >> 12) : 8;
#pragma unroll
        for (int j = 0; j < 4; ++j) { const int col = 256 * j + 4 * lane; const f32x4 gg = *(const f32x4*)(g + col);
            { const f32x4 sh = *(const f32x4*)(shift + (size_t)mr0 * 6144 + col), sc = *(const f32x4*)(scale + (size_t)mr0 * 6144 + col); f32x4 y;
#pragma unroll
                for (int e = 0; e < 4; ++e) y[e] = (v0[j][e] * rstd0 * gg[e]) * (1.f + sc[e]) + sh[e];
                u32x2 w; w.x = cvt_pk_bf16(y[0], y[1]); w.y = cvt_pk_bf16(y[2], y[3]); *(u32x2*)(dst + (size_t)row0 * DM + col) = w; }
            if (has1) { const f32x4 sh = *(const f32x4*)(shift + (size_t)mr1 * 6144 + col), sc = *(const f32x4*)(scale + (size_t)mr1 * 6144 + col); f32x4 y;
#pragma unroll
                for (int e = 0; e < 4; ++e) y[e] = (v1[j][e] * rstd1 * gg[e]) * (1.f + sc[e]) + sh[e];
                u32x2 w; w.x = cvt_pk_bf16(y[0], y[1]); w.y = cvt_pk_bf16(y[2], y[3]); *(u32x2*)(dst + (size_t)row1 * DM + col) = w; } }
    }
}

constexpr size_t WS_BAR = 3 * MiB;
DEV void grid_barrier(unsigned* cnt, const unsigned target, const int tid) {
    asm volatile("s_waitcnt vmcnt(0)" ::: "memory");
    __syncthreads();
    if (tid == 0) {
        __builtin_amdgcn_fence(__ATOMIC_RELEASE, "agent");
        __hip_atomic_fetch_add(cnt, 1u, __ATOMIC_RELAXED, __HIP_MEMORY_SCOPE_AGENT);
        while (__hip_atomic_load(cnt, __ATOMIC_RELAXED, __HIP_MEMORY_SCOPE_AGENT) < target) __builtin_amdgcn_s_sleep(2);
        __builtin_amdgcn_fence(__ATOMIC_ACQUIRE, "agent");
        asm volatile("s_waitcnt vmcnt(0)" ::: "memory");
    }
    __syncthreads();
}
DEV void ffn_fixup(const float* sb, bf16_t* act, const float* cw, const float* cb, const int nrt, const int gt, const int NGT) {
    const int per = DFF / 4;
    for (int i = gt; i < nrt * 2 * per; i += NGT) { const int pm = i / (2 * per), r2 = i - pm * 2 * per, e = r2 / per, j = (r2 - e * per) * 4;
        const bool isx = pm < 128; const bool first = isx ? ((pm & 15) == 0) : true, last = isx ? ((pm & 15) == 15) : true;
        const float* me = sb + (size_t)pm * 6 * DFF + j; const f32x4 z4 = (f32x4){0.f, 0.f, 0.f, 0.f};
        f32x4 up, g, dn, v;
        if (e == 0) { up = first ? z4 : *(const f32x4*)(me - (size_t)6 * DFF + (size_t)3 * DFF); g = *(const f32x4*)(me); dn = *(const f32x4*)(me + DFF); v = *(const f32x4*)(me + (size_t)4 * DFF); }
        else { up = *(const f32x4*)(me + (size_t)2 * DFF); g = *(const f32x4*)(me + (size_t)3 * DFF); dn = last ? z4 : *(const f32x4*)(me + (size_t)6 * DFF); v = *(const f32x4*)(me + (size_t)5 * DFF); }
        const f32x4 w0 = *(const f32x4*)(cw + j), w1 = *(const f32x4*)(cw + DFF + j), w2 = *(const f32x4*)(cw + 2 * DFF + j), bb = *(const f32x4*)(cb + j);
        f32x4 o;
#pragma unroll
        for (int q = 0; q < 4; ++q) { const float z = w0[q] * up[q] + w1[q] * g[q] + w2[q] * dn[q] + bb[q]; o[q] = z * __builtin_amdgcn_rcpf(1.f + __builtin_amdgcn_exp2f(-1.4426950408889634f * z)) * v[q]; }
        const int row = pm * 256 + (e ? 255 : 0);
        u32x2 w; w.x = cvt_pk_bf16(o[0], o[1]); w.y = cvt_pk_bf16(o[2], o[3]); *(u32x2*)(act + (size_t)row * DFF + j) = w; }
}
DEV void hy_conv8(const bf16_t* ht, const int b, const int c, const int L, const int t0, const bool act_, const float* cwp, const float* cbp, float (&x0o)[8], float (&wo)[8]) {
    float outv[3][8];
#pragma unroll
    for (int q = 0; q < 3; ++q) { const int cp = q * 512 + c; const bf16_t* src = ht + (size_t)(b * 1536 + cp) * L;
        const float w0 = cwp[cp], w1 = cwp[1536 + cp], w2 = cwp[3072 + cp], bq = cbp[cp];
        float x[10];
        if (act_) { const u32x4 raw = *(const u32x4*)(src + t0);
            x[1] = __uint_as_float(raw.x << 16); x[2] = __uint_as_float(raw.x & 0xffff0000u); x[3] = __uint_as_float(raw.y << 16); x[4] = __uint_as_float(raw.y & 0xffff0000u);
            x[5] = __uint_as_float(raw.z << 16); x[6] = __uint_as_float(raw.z & 0xffff0000u); x[7] = __uint_as_float(raw.w << 16); x[8] = __uint_as_float(raw.w & 0xffff0000u);
            x[0] = (t0 > 0) ? bf2f(src[t0 - 1]) : 0.f; x[9] = (t0 + 8 < L) ? bf2f(src[t0 + 8]) : 0.f; }
        else {
#pragma unroll
            for (int e = 0; e < 10; ++e) x[e] = 0.f; }
#pragma unroll
        for (int e = 0; e < 8; ++e) outv[q][e] = w0 * x[e] + w1 * x[e + 1] + w2 * x[e + 2] + bq; }
#pragma unroll
    for (int e = 0; e < 8; ++e) { x0o[e] = outv[0][e]; wo[e] = outv[2][e] * outv[1][e]; }
}
#define BF(off) ((bf16_t*)(ws + (off)))
#define FP(off) ((float*)(ws + (off)))
#define PHASE(k) ((LO) <= (k) && (k) < (HI) && ph == (k))
#ifndef DUP_PH
#define DUP_PH -1
#endif
template <int LO, int HI>
DEV void run_phases(LAS unsigned char* lds, const int ph_lo, const int ph_hi, const int G, const int wave0, unsigned& nbar) {
    int dup_left = 1;
    for (int ph = (ph_lo > LO ? ph_lo : LO); ph < (ph_hi < HI ? ph_hi : HI); ++ph) {
        if (ph == 3 || ph == 5 || ph == 12) continue;
        kptr_t kp = (kptr_t)__builtin_amdgcn_kernarg_segment_ptr(); asm volatile("" : "+s"(kp));
        int bid = blockIdx.x; asm volatile("" : "+s"(bid));
        const int NGW = G * 8, NGT = G * NTHREADS;
        unsigned char* ws = KWS;
        float* mod = FP(WS_MOD);
        {
        int tid; asm volatile("v_mbcnt_lo_u32_b32 %0, -1, 0\n\tv_mbcnt_hi_u32_b32 %0, -1, %0" : "=v"(tid)); tid += wave0 * 64; asm volatile("" : "+v"(tid));
        const int gt = bid * NTHREADS + tid;
        if (PHASE(9) || PHASE(19)) {
            const int l1_ = (ph == 19);
            ffn_fixup(FP(WS_SB), BF(WS_ACT), KIN(I_FCW) + l1_ * 3 * DFF, KIN(I_FCB) + l1_ * DFF, l1_ ? 128 : 136, gt, NGT);
            if (ph_lo < ph) { ++nbar; grid_barrier((unsigned*)(ws + WS_BAR), nbar * (unsigned)G, tid); }
        }
        {
            Op o;
            for (int idx = 0; get_op(kp, ph, idx, o); ++idx) {
                pg8::Gemm g{o.A, o.Bt, o.lda, o.ldb, o.K, o.sAz, o.sBz};
                pg8::Sched S{o.nM, o.nN, o.nZ, G, (bid + o.rot) % G, o.mode};
                int tid2 = tid; asm volatile("" : "+v"(tid2));
                switch (o.type) {
                case T_G1: if (LO <= 2 && 2 < HI) { pg8::EpiG1 E{(bf16_t*)o.o0, (bf16_t*)o.o1, (bf16_t*)o.p0, (bf16_t*)o.p1}; pg8::gemm_phase(lds, g, S, E, tid2); } break;
                case T_BF16: if (LO <= 13 && 13 < HI) { pg8::EpiBf16 E{(bf16_t*)o.o0, (bf16_t*)o.o1, o.i0, o.i1, o.i2, o.i3, o.f0, (const float*)o.p0, o.i4, o.f1}; pg8::gemm_phase(lds, g, S, E, tid2); } break;
                case T_F32: if (LO <= 11 && 11 < HI) { pg8::EpiF32 E{(float*)o.o0, o.i0}; pg8::gemm_phase(lds, g, S, E, tid2); } break;
                case T_RES: if (HI > 6) { pg8::EpiRes E{(const float*)o.p0, (const float*)o.p1, (float*)o.o0, (float*)o.o1, (const float*)o.p2, o.i0}; pg8::gemm_phase(lds, g, S, E, tid2); } break;
                case T_FFN: if (HI > 8) { pg8::EpiFFN E{(bf16_t*)o.o0, (const float*)o.p0, (const float*)o.p1, (float*)o.o1}; pg8::gemm_phase(lds, g, S, E, tid2); } break;
                case T_MLA: if (LO <= 11 && 11 < HI) { pg8::EpiMla E{(bf16_t*)o.o0, (bf16_t*)o.o1, (float*)o.x0, (float*)o.x1, (const float*)o.p0, (const float*)o.p1}; pg8::gemm_phase(lds, g, S, E, tid2); } break;
                }
                __syncthreads();
            }
        }
        }
        int tid; asm volatile("v_mbcnt_lo_u32_b32 %0, -1, 0\n\tv_mbcnt_hi_u32_b32 %0, -1, %0" : "=v"(tid)); tid += wave0 * 64; asm volatile("" : "+v"(tid));
        const int lane = tid & 63, wave = __builtin_amdgcn_readfirstlane(tid >> 6);
        const int gw = bid * 8 + wave;
        const int gt = bid * NTHREADS + tid;
        if (PHASE(0)) {
            const bool bal0 = (G == 256); const int nrep0 = (bal0 && bid >= 192) ? 2 : 1, vNGW0 = bal0 ? 2560 : NGW;
            {
                LAS float* sl = (LAS float*)lds;
                LAS float* part = sl + 9 * 1024;
                bool loaded = false;
                for (int it = bid; it < 192; it += G) {
                    if (!loaded) { for (int i = tid; i < 9 * 1024; i += NTHREADS) { const float x = (i < 8192) ? KIN(I_C)[i] : KIN(I_CCTX)[i - 8192]; sl[i] = silu_f(x); } loaded = true; __syncthreads(); }
                    const int l = it / 96, n0 = (it % 96) * 64; const float* wm = KIN(I_WMOD) + (size_t)l * 1024 * 6144 + n0 + lane;
                    float acc9[9];
#pragma unroll
                    for (int r = 0; r < 9; ++r) acc9[r] = 0.f;
#pragma unroll 32
                    for (int k = wave * 128; k < wave * 128 + 128; ++k) { const float wv = wm[(size_t)k * 6144];
#pragma unroll
                        for (int r = 0; r < 9; ++r) acc9[r] += sl[r * 1024 + k] * wv; }
#pragma unroll
                    for (int r = 0; r < 9; ++r) part[(wave * 9 + r) * 64 + lane] = acc9[r];
                    __syncthreads();
                    for (int i = tid; i < 576; i += NTHREADS) { const int r = i >> 6, ln = i & 63; float s = 0.f;
#pragma unroll
                        for (int w = 0; w < 8; ++w) s += part[(w * 9 + r) * 64 + ln];
                        mod[(size_t)(l * 9 + r) * 6144 + n0 + ln] = s + KIN(I_BMOD)[l * 6144 + n0 + ln]; }
                    __syncthreads();
                }
                __syncthreads();
            }
            {
                LAS float* scr = (LAS float*)(lds + wave * 16384);
                for (int rep = 0; rep < nrep0; ++rep) { const int vgw = bal0 ? (bid < 192 ? gw : 1536 + (bid - 192) * 16 + rep * 8 + wave) : gw;
                    tr_matrix(KIN(I_FHIN), 2048, 1024, 1536, BF(W_W1T) + (size_t)1024 * 1024, 0, 0, 512, scr, vgw, vNGW0, lane);
                    tr_matrix(KIN(I_FHOUT), 1024, 1024, 1024, BF(W_WOUT), 0, 0, 0, scr, vgw, vNGW0, lane);
                    tr_matrix(KIN(I_FUP), 2 * DFF, 1024, 2 * DFF, BF(W_WUP), 1, 0, 0, scr, vgw, vNGW0, lane);
                    tr_matrix(KIN(I_FDOWN), 1024, DFF, 1024, BF(W_WDOWN), 0, 0, 0, scr, vgw, vNGW0, lane); }
                __syncthreads();
            }
            {
                LAS float* wt = (LAS float*)lds;
                LAS float* cs = wt + 16 * 128;
                if (tid < 128) { cs[tid] = __builtin_amdgcn_cosf((float)tid / 128.f); cs[128 + tid] = __builtin_amdgcn_sinf((float)tid / 128.f); }
                for (int it = bid; it < 256; it += G) { const int g = it >> 6, k0 = (it & 63) * 16;
                    __syncthreads();
                    for (int i = tid; i < 2048; i += NTHREADS) { const int kk = i >> 7, j = i & 127; wt[i] = KIN(I_FHIN)[(size_t)(k0 + kk) * 2048 + g * 128 + j]; }
                    __syncthreads();
                    const int rowi = tid >> 1, hh = tid & 1, m = rowi >> 1, part = rowi & 1;
                    float s[8];
#pragma unroll
                    for (int e = 0; e < 8; ++e) s[e] = 0.f;
                    for (int j = 0; j < 128; ++j) { const float tr = cs[part * 128 + ((j * m) & 127)];
#pragma unroll
                        for (int e = 0; e < 8; ++e) s[e] += wt[(hh * 8 + e) * 128 + j] * tr; }
                    u32x4 w; w.x = cvt_pk_bf16(s[0], s[1]); w.y = cvt_pk_bf16(s[2], s[3]); w.z = cvt_pk_bf16(s[4], s[5]); w.w = cvt_pk_bf16(s[6], s[7]);
                    *(u32x4*)(BF(W_W1T) + (size_t)(2 * (g * 128 + m) + part) * 1024 + k0 + hh * 8) = w;
                }
                __syncthreads();
            }
            for (int rep = 0; rep < nrep0; ++rep)
            for (int it = bal0 ? (bid < 192 ? gw : 1536 + (bid - 192) * 16 + rep * 8 + wave) : gw; it < 4096 + 256; it += vNGW0) {
                const bool isc = it >= 4096; const int L = isc ? 256 : 4096, pos = isc ? it - 4096 : it;
                const float t = (float)pos / (float)(L - 1);
                float z = 0.f;
                if (lane == 0) z = t;
                else if (lane < 33) { const int i = (lane - 1) & 15; const float band = 1e-4f + (float)i * ((15.0f - 1e-4f) / 15.0f);
                    const float ang = (6.283185307179586f / (float)L) * (float)pos * band; z = (lane <= 16) ? cosf(ang) : -sinf(ang); }
                const float fr_ = KIN(I_HFREQ)[lane];
                float h = KIN(I_HB1)[lane];
#pragma unroll 11
                for (int i = 0; i < 33; ++i) h += __shfl(z, i) * KIN(I_HW1)[i * 64 + lane];
                h = sinf(fr_ * h);
                float h2 = KIN(I_HB2)[lane];
#pragma unroll 16
                for (int i = 0; i < 64; ++i) h2 += __shfl(h, i) * KIN(I_HW2)[i * 64 + lane];
                h2 = sinf(fr_ * h2);
                float h3 = KIN(I_HB3)[lane];
#pragma unroll 16
                for (int i = 0; i < 64; ++i) h3 += __shfl(h2, i) * KIN(I_HW3)[i * 64 + lane];
                h3 = sinf(fr_ * h3);
                (isc ? FP(WS_H3C) : FP(WS_H3X))[(size_t)pos * 64 + lane] = h3;
            }
        }
        else if (PHASE(1)) {
            modnorm_rows(KIN(I_X), KIN(I_CTX), TT, KIN(I_NORM1), mod + 0 * 1024, mod + 1 * 1024, BF(WS_HX), gw, NGW, lane);
        }
        else if (PHASE(4)) {
            {
            LAS float* re = (LAS float*)lds; LAS float* im = re + 9216; LAS float* kre = re + 18432; LAS float* kim = kre + 8192;
            LAS float* w4 = kim + 8192; LAS float* red = w4 + 128;
            for (int it = bid; it < 1024; it += G) {
                const bool isc = it >= 512; const int c = (G == 256) ? ((((it >> 8) & 1) * 8 + (bid & 7)) * 32 + (bid >> 3)) : (it & 511), L = isc ? 256 : 4096, N = 2 * L, logN = isc ? 9 : 13;
                const float invN = 1.f / (float)N;
                const float* h3 = isc ? FP(WS_H3C) : FP(WS_H3X);
                __syncthreads();
                if (tid < 128) w4[tid] = KIN(I_HW4)[(size_t)(tid & 63) * 1024 + (tid >> 6) * 512 + c];
                __syncthreads();
                const float MIND = -15.350567286626973f, MAXD = -3.0701134573253946f;
                const float ad = fabsf(MIND + (float)c * ((MAXD - MIND) / 511.f));
                float l1 = 0.f;
                for (int p = tid; p < L; p += NTHREADS) { const float* hp = h3 + (size_t)p * 64; float sf = 0.f, sb = 0.f;
#pragma unroll
                    for (int j4 = 0; j4 < 16; ++j4) { const f32x4 hv = *(const f32x4*)(hp + 4 * j4);
#pragma unroll
                        for (int e = 0; e < 4; ++e) { sf += hv[e] * w4[4 * j4 + e]; sb += hv[e] * w4[64 + 4 * j4 + e]; } }
                    const float t = (float)p / (float)(L - 1), dec = expf(-t * ad); sf *= dec; sb = (p == 0) ? 0.f : sb * dec;
                    re[fftl::padi(p)] = sf; im[fftl::padi(p)] = 0.f; im[fftl::padi(p + L)] = 0.f;
                    if (p > 0) re[fftl::padi(N - p)] = sb; else re[fftl::padi(L)] = 0.f;
                    l1 += fabsf(sf) + fabsf(sb); }
                l1 = wave_sum(l1);
                if (lane == 0) red[wave] = l1;
                __syncthreads();
                float l1t = 0.f;
#pragma unroll
                for (int w = 0; w < 8; ++w) l1t += red[w];
                const float ksc = invN / l1t;
                fftl::run<false>(re, im, logN, tid, 1, 0);
                for (int i = tid; i < N; i += NTHREADS) { const int p = fftl::padi(i); kre[i] = re[p] * ksc; kim[i] = im[p] * ksc; }
                __syncthreads();
                const bf16_t* ht = isc ? BF(WS_HTC) : BF(WS_HT);
                const float* cwp = KIN(I_HCW); const float* cbp = KIN(I_HCB); const float hb_ = KIN(I_HBIAS)[c];
                const int npb = isc ? 4 : 1, cst = isc ? 576 : 0, cpp = L / 8;
                const int pl = tid >> __builtin_ctz(cpp), t0 = (tid & (cpp - 1)) * 8; const bool act_ = pl < npb; const int pt0 = pl * cst + fftl::padi(t0), pt1 = pl * cst + fftl::padi(L + t0);
                for (int bp0 = 0; bp0 < 4; bp0 += npb) { const int bp = bp0 + (act_ ? pl : 0);
                    float xk[2][8], wk[2][8];
                    hy_conv8(ht, 2 * bp, c, L, t0, act_, cwp, cbp, xk[0], wk[0]); hy_conv8(ht, 2 * bp + 1, c, L, t0, act_, cwp, cbp, xk[1], wk[1]);
                    if (act_) {
#pragma unroll
                        for (int e = 0; e < 8; ++e) { re[pt0 + e] = wk[0][e]; im[pt0 + e] = wk[1][e]; } }
                    __syncthreads();
                    fftl::run<false, true>(re, im, logN, tid, npb, cst);
                    for (int i = tid; i < N * npb; i += NTHREADS) { const int cl = i >> logN, ii = i & (N - 1); const int p = cl * cst + fftl::padi(ii); const float zr = re[p], zi = im[p], kr = kre[ii], ki = kim[ii]; re[p] = zr * kr - zi * ki; im[p] = zr * ki + zi * kr; }
                    __syncthreads();
                    fftl::run<true, true>(re, im, logN, tid, npb, cst);
                    if (act_) {
#pragma unroll
                        for (int bb = 0; bb < 2; ++bb) { const int b = 2 * bp + bb; bf16_t* op = BF(WS_HX) + (size_t)((isc ? TX : 0) + b * L + t0) * DM + 512 + c;
#pragma unroll
                            for (int e = 0; e < 8; e += 2) { const float y0 = (bb ? im[pt0 + e] : re[pt0 + e]), y1 = (bb ? im[pt0 + e + 1] : re[pt0 + e + 1]);
                                const unsigned pk = cvt_pk_bf16(xk[bb][e] * (y0 + wk[bb][e] * hb_), xk[bb][e + 1] * (y1 + wk[bb][e + 1] * hb_));
                                op[(size_t)e * DM] = (bf16_t)(pk & 0xffffu); op[(size_t)(e + 1) * DM] = (bf16_t)(pk >> 16); } } }
                    __syncthreads();
                }
            }
            __syncthreads();
            }
            {
                LAS float* fre = (LAS float*)lds; LAS float* fim = fre + 9216;
                u32x4 pfc[2], pfs[2];
#define FPRE(itn) do { if ((itn) < 4096) { const bool isc_ = (itn) >= 2048; const int L_ = isc_ ? 256 : 4096, b_ = ((itn) & 2047) >> 8, n_ = ((G == 256) ? ((bid & 7) * 32 + (bid >> 3)) : ((itn) & 255)) * 2; \
                        const bf16_t* src_ = (isc_ ? BF(WS_PQTC) : BF(WS_PQT)) + (size_t)(b_ * 512 + n_) * (2 * L_); \
                        _Pragma("unroll") for (int u_ = 0; u_ < 2; ++u_) { const int i_ = tid + u_ * NTHREADS; if (i_ < L_ / 4) { const int j_ = i_ / (L_ / 8), t_ = (i_ % (L_ / 8)) * 8; \
                            pfc[u_] = *(const u32x4*)(src_ + (size_t)j_ * 2 * L_ + t_); pfs[u_] = *(const u32x4*)(src_ + (size_t)j_ * 2 * L_ + L_ + t_); } } } } while (0)
                pfc[0] = pfc[1] = pfs[0] = pfs[1] = u32x4{};
                FPRE(bid);
                for (int it = bid; it < 4096; it += G) {
                    const bool isc = it >= 2048; const int L = isc ? 256 : 4096, logL = isc ? 8 : 12, b = (it & 2047) >> 8, n0 = ((G == 256) ? ((bid & 7) * 32 + (bid >> 3)) : (it & 255)) * 2;
                    const float oscale = isc ? 0.005524271728019903f : 0.001381067932004975f;
                    __syncthreads();
#pragma unroll
                    for (int u_ = 0; u_ < 2; ++u_) { const int i = tid + u_ * NTHREADS; if (i < L / 4) { const int j = i / (L / 8), t0 = (i % (L / 8)) * 8;
                        const u32x4 rc = pfc[u_], rs = pfs[u_];
                        LAS float* pr = fre + j * 4608 + fftl::padi(t0); LAS float* pi = fim + j * 4608 + fftl::padi(t0);
                        pr[0] = __uint_as_float(rc.x << 16); pr[1] = __uint_as_float(rc.x & 0xffff0000u); pr[2] = __uint_as_float(rc.y << 16); pr[3] = __uint_as_float(rc.y & 0xffff0000u);
                        pr[4] = __uint_as_float(rc.z << 16); pr[5] = __uint_as_float(rc.z & 0xffff0000u); pr[6] = __uint_as_float(rc.w << 16); pr[7] = __uint_as_float(rc.w & 0xffff0000u);
                        pi[0] = -__uint_as_float(rs.x << 16); pi[1] = -__uint_as_float(rs.x & 0xffff0000u); pi[2] = -__uint_as_float(rs.y << 16); pi[3] = -__uint_as_float(rs.y & 0xffff0000u);
                        pi[4] = -__uint_as_float(rs.z << 16); pi[5] = -__uint_as_float(rs.z & 0xffff0000u); pi[6] = -__uint_as_float(rs.w << 16); pi[7] = -__uint_as_float(rs.w & 0xffff0000u); } }
                    __syncthreads();
                    FPRE(it + G);
                    fftl::run<false>(fre, fim, logL, tid, 2, 4608);
                    bf16_t* yb = BF(WS_HX) + (size_t)((isc ? TX : 0) + b * L) * DM + n0;
                    for (int p = tid; p < L; p += NTHREADS) { const int k1 = (int)(__brev((unsigned)p) >> (32 - logL)); const int pp = fftl::padi(p);
                        *(unsigned*)(yb + (size_t)k1 * DM) = cvt_pk_bf16(fre[pp] * oscale, fre[4608 + pp] * oscale); }
                }
#undef FPRE
                __syncthreads();
            }
        }
        else if (PHASE(7)) {
            modnorm_rows(FP(WS_XR), FP(WS_XR) + (size_t)TX * DM, TT, KIN(I_NORM2), mod + 3 * 1024, mod + 4 * 1024, BF(WS_HX), gw, NGW, lane);
        }
        else if (PHASE(6)) {
            LAS float* scr = (LAS float*)(lds + wave * 16384);
            tr_matrix(KIN(I_MIN), 416, 1024, 512, BF(W_MLAIN), 3, 416, 0, scr, gw, NGW, lane);
            tr_matrix(KIN(I_MUQ), 1536, 256, 1536, BF(W_WUQ), 0, 0, 0, scr, gw, NGW, lane);
            tr_matrix(KIN(I_MUKV), 2048, 128, 2048, BF(W_WUKV), 2, 0, 0, scr, gw, NGW, lane);
            tr_matrix(KIN(I_MWO), 1024, 1024, 1024, BF(W_WO), 0, 0, 0, scr, gw, NGW, lane);
            __syncthreads();
        }
        else if (PHASE(9)) {
            LAS float* scr = (LAS float*)(lds + wave * 16384);
            tr_matrix(KIN(I_FUP) + (size_t)1024 * 2 * DFF, 2 * DFF, 1024, 2 * DFF, BF(W_WUP), 1, 0, 0, scr, gw, NGW, lane);
            __syncthreads();
        }
        else if (PHASE(10)) {
            modnorm_rows(FP(WS_XR), FP(WS_XR) + (size_t)TX * DM, TT, KIN(I_NORM1) + 1024, mod + 9 * 6144 + 0 * 1024, mod + 9 * 6144 + 1 * 1024, BF(WS_HX), gw, NGW, lane);
        }
        else if (PHASE(11)) {
            LAS float* scr = (LAS float*)(lds + wave * 16384);
            tr_matrix(KIN(I_FDOWN) + (size_t)DFF * 1024, 1024, DFF, 1024, BF(W_WDOWN), 0, 0, 0, scr, gw, NGW, lane);
            __syncthreads();
        }
        else if (PHASE(12)) {
            const float* ab = FP(WS_ABUF);
            for (int row = gw; row < TT; row += NGW) { const float* ar = ab + (size_t)row * 512;
                const f32x4 q = *(const f32x4*)(ar + 4 * lane); const f32x2 kv = *(const f32x2*)(ar + 256 + 2 * lane);
                const float sq = wave_sum((q[0] * q[0] + q[1] * q[1]) + (q[2] * q[2] + q[3] * q[3])), sk = wave_sum(kv[0] * kv[0] + kv[1] * kv[1]);
                const float rq = 1.0f / sqrtf(sq * (1.f / 256.f) + EPS), rk = 1.0f / sqrtf(sk * (1.f / 128.f) + EPS);
                if (row < TX) { const f32x4 gq = *(const f32x4*)(KIN(I_MQAN) + 4 * lane); u32x2 w; w.x = cvt_pk_bf16(q[0] * rq * gq[0], q[1] * rq * gq[1]); w.y = cvt_pk_bf16(q[2] * rq * gq[2], q[3] * rq * gq[3]);
                    *(u32x2*)(BF(WS_AQN) + (size_t)row * 256 + 4 * lane) = w; }
                const f32x2 gk = *(const f32x2*)(KIN(I_MKVAN) + 2 * lane);
                *(unsigned*)(BF(WS_CKVN) + (size_t)row * 128 + 2 * lane) = cvt_pk_bf16(kv[0] * rk * gk[0], kv[1] * rk * gk[1]);
                if (lane < 32) FP(WS_KPE)[(size_t)row * 32 + lane] = ar[384 + lane];
            }
        }
        else if (PHASE(14)) {
            const int h = lane >> 2, q = lane & 3;
            for (int it = TX + gw; it < TX + TT; it += NGW) {
                const bool isq = it < TX; const int row = isq ? it : it - TX;
                const bf16_t* bsrc = isq ? BF(WS_QB) + (size_t)row * 1536 + h * 96 : BF(WS_KRAW) + (size_t)row * 1024 + h * 64;
                const float* kper = FP(WS_KPE) + (size_t)row * 32;
                const float* gn = isq ? KIN(I_MQN) : KIN(I_MKN);
                float v[3][8]; float ss = 0.f;
#pragma unroll
                for (int j = 0; j < 3; ++j) { const int d0 = 8 * (3 * q + j); const bool frombf = isq || d0 < 64;
                    const int db = frombf ? d0 : 0, dk = frombf ? 0 : d0 - 64;
                    const u32x4 raw = *(const u32x4*)(bsrc + db); const f32x4 t0 = *(const f32x4*)(kper + dk), t1 = *(const f32x4*)(kper + dk + 4);
                    v[j][0] = frombf ? __uint_as_float(raw.x << 16) : t0[0]; v[j][1] = frombf ? __uint_as_float(raw.x & 0xffff0000u) : t0[1];
                    v[j][2] = frombf ? __uint_as_float(raw.y << 16) : t0[2]; v[j][3] = frombf ? __uint_as_float(raw.y & 0xffff0000u) : t0[3];
                    v[j][4] = frombf ? __uint_as_float(raw.z << 16) : t1[0]; v[j][5] = frombf ? __uint_as_float(raw.z & 0xffff0000u) : t1[1];
                    v[j][6] = frombf ? __uint_as_float(raw.w << 16) : t1[2]; v[j][7] = frombf ? __uint_as_float(raw.w & 0xffff0000u) : t1[3];
#pragma unroll
                    for (int e = 0; e < 8; ++e) ss += v[j][e] * v[j][e]; }
                ss += __shfl_xor(ss, 1); ss += __shfl_xor(ss, 2);
                const float rstd = 1.0f / sqrtf(ss * (1.f / 96.f) + EPS);
#pragma unroll
                for (int j = 0; j < 3; ++j) { const int d0 = 8 * (3 * q + j); const f32x4 g0 = *(const f32x4*)(gn + d0), g1 = *(const f32x4*)(gn + d0 + 4);
#pragma unroll
                    for (int e = 0; e < 4; ++e) { v[j][e] *= rstd * g0[e]; v[j][4 + e] *= rstd * g1[e]; } }
                if (row < TX) { const int t = row & 4095; const float pr = (float)(t >> 6), pc = (float)(t & 63);
#pragma unroll
                    for (int e = 0; e < 8; ++e) { const float invf = exp2f(-(float)e * (13.287712379549449f / 8.f));
                        const float rr_ = pr * invf * 0.15915494309189535f, rc_ = pc * invf * 0.15915494309189535f;
                        const float sr = __builtin_amdgcn_sinf(rr_), cr = __builtin_amdgcn_cosf(rr_), sc_ = __builtin_amdgcn_sinf(rc_), cc = __builtin_amdgcn_cosf(rc_);
                        const float send = (q == 2) ? v[2][e] : v[0][e]; const float recv = __shfl_xor(send, 1);
                        if (q == 2) v[2][e] = v[2][e] * cr - recv * sr;
                        if (q == 3) { v[0][e] = recv * sr + v[0][e] * cr; const float b1 = v[1][e], b2 = v[2][e]; v[1][e] = b1 * cc - b2 * sc_; v[2][e] = b1 * sc_ + b2 * cc; } } }
                const float osc = isq ? att::QSCALE : 1.f;
                bf16_t* dst = (isq ? BF(WS_QB) : BF(WS_KB)) + (size_t)row * 1536 + h * 96;
#pragma unroll
                for (int j = 0; j < 3; ++j) { const int d0 = 8 * (3 * q + j); u32x4 w; w.x = cvt_pk_bf16(v[j][0] * osc, v[j][1] * osc); w.y = cvt_pk_bf16(v[j][2] * osc, v[j][3] * osc);
                    w.z = cvt_pk_bf16(v[j][4] * osc, v[j][5] * osc); w.w = cvt_pk_bf16(v[j][6] * osc, v[j][7] * osc); *(u32x4*)(dst + d0) = w; }
            }
        }
        else if (PHASE(15)) {
            const int vcu = (G % 8 == 0) ? (bid % 8) * (G / 8) + bid / 8 : bid;
            const int per = (2048 + G - 1) / G;
            int tid3 = tid; asm volatile("" : "+v"(tid3));
            for (int k = 0; k < per; ++k) {
                int un = vcu * per + k;
                if (G == 256) {
                    const int xcd = vcu >> 5, loc = vcu & 31; un = ((xcd * 16 + 2 * k + (loc >> 4)) << 4) | (loc & 15); }
                if (un >= 2048) break;
                const int bh = un >> 4, qb = un & 15;
                att::attn_unit(bh >> 4, bh & 15, qb, BF(WS_QB), BF(WS_KB), BF(WS_VB), BF(WS_OB), lds, tid3, KIN(I_MQN)); }
        }
        else if (PHASE(17)) {
            modnorm_rows(FP(WS_XR), FP(WS_XR) + (size_t)TX * DM, TX, KIN(I_NORM2) + 1024, mod + 9 * 6144 + 3 * 1024, mod + 9 * 6144 + 4 * 1024, BF(WS_HX), gw, NGW, lane);
        }
        if (ph + 1 < ph_hi) { __syncthreads(); if (HI == 1) cg::this_grid().sync(); else { ++nbar; grid_barrier((unsigned*)(ws + WS_BAR), nbar * (unsigned)G, tid); } }
        if (DUP_PH >= 0 && ph == DUP_PH && dup_left > 0) { --dup_left; --ph; }
    }
}
#undef PHASE
#undef BF
#undef FP
__global__ void __launch_bounds__(NTHREADS, 2) mega(Args a) {
    extern __shared__ __attribute__((aligned(16))) unsigned char lds_raw[];
    LAS unsigned char* lds = (LAS unsigned char*)lds_raw;
    const int G = gridDim.x;
    const int ph_lo = a.ph_lo, ph_hi = a.ph_hi;
    const int wave0 = __builtin_amdgcn_readfirstlane((int)threadIdx.x >> 6);
    unsigned nbar = 0;
    run_phases<0, 1>(lds, ph_lo, ph_hi, G, wave0, nbar);
    run_phases<1, 10>(lds, ph_lo, ph_hi, G, wave0, nbar);
    run_phases<10, 20>(lds, ph_lo, ph_hi, G, wave0, nbar);
}

extern "C" void kernel_launch(void* const* d_in, const int* in_sizes, int n_in, void* d_out, int out_size, void* d_ws, size_t ws_size, hipStream_t stream) {
    static int grid = 0;
    if (grid == 0) {
        if (n_in != 33 || ws_size < WS_END) { fprintf(stderr, "kernel_launch: need 33 inputs and >= %zu bytes of workspace; got %d, %zu\n", (size_t)WS_END, n_in, ws_size); grid = -1; return; }
        int dev = 0, cus = 0, per_cu = 0;
        hipGetDevice(&dev); hipDeviceGetAttribute(&cus, hipDeviceAttributeMultiprocessorCount, dev);
        if (hipFuncSetAttribute((const void*)mega, hipFuncAttributeMaxDynamicSharedMemorySize, LDS_BYTES) != hipSuccess) { fprintf(stderr, "kernel_launch: hipFuncSetAttribute failed\n"); grid = -1; return; }
        hipOccupancyMaxActiveBlocksPerMultiprocessor(&per_cu, (const void*)mega, NTHREADS, LDS_BYTES);
        if (per_cu < 1) { fprintf(stderr, "kernel_launch: occupancy query says %d blocks per CU\n", per_cu); per_cu = 1; }
        (void)hipGetLastError();
        grid = cus;
    }
    if (grid < 0) return;
    Args a{};
    for (int i = 0; i < 33; ++i) a.in[i] = (const float*)d_in[i];
    a.out = (float*)d_out; a.ws = (unsigned char*)d_ws;
#if MK_COOP
    (void)hipMemsetAsync((char*)d_ws + WS_BAR, 0, 256, stream);
    a.ph_lo = 0; a.ph_hi = NPH;
    void* args[] = {&a};
    hipError_t e = hipLaunchCooperativeKernel((const void*)mega, dim3(grid), dim3(NTHREADS), args, LDS_BYTES, stream);
    if (e != hipSuccess) fprintf(stderr, "cooperative launch failed: %s (grid %d)\n", hipGetErrorString(e), grid);
#else
#ifndef NPH_RUN
#define NPH_RUN NPH
#endif
    for (int ph = 0; ph < NPH_RUN; ++ph) { a.ph_lo = ph; a.ph_hi = ph + 1;
        hipLaunchKernelGGL(mega, dim3(grid), dim3(NTHREADS), LDS_BYTES, stream, a); }
#endif
}
```

```cpp
#include <hip/hip_runtime.h>
#include <hip/hip_cooperative_groups.h>
#include <cstdio>
#include <cstdint>
namespace cg = cooperative_groups;

#ifndef MK_COOP
#define MK_COOP 1
#endif

#define LAS __attribute__((address_space(3)))
#define DEV __device__ __forceinline__
typedef unsigned short bf16_t;
typedef short bf16x8 __attribute__((ext_vector_type(8)));
typedef short s16x4 __attribute__((ext_vector_type(4)));
typedef float f32x4 __attribute__((ext_vector_type(4)));
typedef float f32x2 __attribute__((ext_vector_type(2)));
typedef float f32x16 __attribute__((ext_vector_type(16)));
typedef unsigned u32x4 __attribute__((ext_vector_type(4)));
typedef unsigned u32x2 __attribute__((ext_vector_type(2)));

constexpr int DM = 1024, NB = 8, SEQ = 4096, CTXL = 256;
constexpr int TX = NB * SEQ, TC = NB * CTXL, TT = TX + TC;
constexpr int DFF = 2816;
constexpr float EPS = 1e-6f;
constexpr int NPH = 20;
constexpr int NTHREADS = 512;
constexpr int RING_BYTES = 131072, MISC_OFF = RING_BYTES, LDS_BYTES = 147456;

constexpr size_t MiB = (size_t)1 << 20;
constexpr size_t WS_MOD = 0;
constexpr size_t WS_H3X = 1 * MiB, WS_H3C = 2 * MiB;
constexpr size_t WS_SMALL = 2 * MiB + 512 * 1024;
constexpr size_t WS_W = 4 * MiB;
constexpr size_t W_W1T = WS_W, W_WOUT = WS_W + 5 * MiB, W_WUP = WS_W + 7 * MiB, W_WDOWN = WS_W + 18 * MiB;
constexpr size_t W_MLAIN = WS_W, W_WUQ = WS_W + 1 * MiB, W_WUKV = WS_W + 2 * MiB, W_WO = WS_W + 3 * MiB;
constexpr size_t WS_XR = 28 * MiB;
constexpr size_t WS_PQT = 28 * MiB, WS_PQTC = 92 * MiB, WS_WT = 96 * MiB, WS_WTC = 128 * MiB, WS_X0C = 130 * MiB, WS_X0CC = 162 * MiB;
constexpr size_t WS_HX = 164 * MiB;
constexpr size_t WS_BIG = 232 * MiB;
constexpr size_t WS_T1 = 232 * MiB, WS_T2 = 296 * MiB, WS_HT = 360 * MiB, WS_HTC = 456 * MiB, WS_KF = 462 * MiB, WS_KFC = 494 * MiB;
constexpr size_t WS_FILT = 496 * MiB, WS_FILTC = 504 * MiB, WS_T1C = 505 * MiB, WS_CSC = 505 * MiB + 512 * 1024;
constexpr size_t WS_YT = WS_HT, WS_YTC = WS_HTC;
constexpr size_t WS_ACT = 232 * MiB;
constexpr size_t WS_SB = 420 * MiB;
constexpr size_t WS_SSQ2 = 2 * MiB + 512 * 1024;
constexpr size_t WS_ABUF = 232 * MiB, WS_KRAW = 232 * MiB, WS_OB = 232 * MiB, WS_AQN = 300 * MiB, WS_CKVN = 316 * MiB, WS_KB = 300 * MiB, WS_KPE = 402 * MiB, WS_QB = 416 * MiB;
constexpr size_t WS_VB = WS_HX;
constexpr size_t WS_END = 512 * MiB;

DEV unsigned cvt_pk_bf16(float lo, float hi) { unsigned r; asm volatile("v_cvt_pk_bf16_f32 %0, %1, %2" : "=v"(r) : "v"(lo), "v"(hi)); return r; }
DEV float bf2f(unsigned short h) { return __uint_as_float(((unsigned)h) << 16); }
DEV float wave_sum(float v) {
#pragma unroll
    for (int o = 1; o < 64; o <<= 1) v += __shfl_xor(v, o);
    return v;
}
DEV float silu_f(float x) { return x / (1.f + __expf(-x)); }

namespace pg8 {
constexpr int BM = 256, BK = 64, HALF = 128, HTB = HALF * BK * 2, STAGE_BYTES = 8 * HTB;
__host__ __device__ __forceinline__ int lds_byte(int r, int c) { const int st = (r >> 4) * 2 + (c >> 5), rr = r & 15, cc = c & 31, ob = rr * 64 + cc * 2; return st * 1024 + (ob ^ (((ob >> 9) & 1) << 5)); }
__host__ __device__ __forceinline__ void stage_rc(int b, int& R, int& C) { const int st = b / 1024, sb = b % 1024, swz = sb ^ (((sb >> 9) & 1) << 5); R = (st >> 1) * 16 + swz / 64; C = (st & 1) * 32 + (swz % 64) / 2; }
__host__ __device__ __forceinline__ int perm32(int rho) { const int n = rho >> 4, i = rho & 15; return 8 * (i >> 2) + 4 * n + (i & 3); }

struct Unit { int pm, pn, pz; long arow, brow; };
struct Gemm { const bf16_t* A; const bf16_t* Bt; int lda, ldb, K; long sAz, sBz; };

struct Sched {
    int nM, nN, nZ, G, c, mode;
    DEV bool next(int i, Unit& u) const {
        const long L = (long)i * G + c; const int per = nM * nN; if (L >= (long)per * nZ) return false;
        u.pz = (int)(L / per); int wgid = (int)(L % per);
        { const int q = per / 8, r = per % 8, xcd = wgid % 8, off = wgid / 8; wgid = (xcd < r ? xcd * (q + 1) : r * (q + 1) + (xcd - r) * q) + off; }
        const int nig = 8 * nN, gid = wgid / nig, fm = gid * 8, gsz = (nM - fm) < 8 ? (nM - fm) : 8;
        u.pm = fm + ((wgid % nig) % gsz); u.pn = (wgid % nig) / gsz;
        u.brow = (long)u.pn * 256;
        u.arow = (long)u.pm * 256;
        return true;
    }
};

template <class Epi>
DEV void gemm_phase(LAS unsigned char* lds, const Gemm g, const Sched& S, const Epi& E, const int tid) {
    const int wid = __builtin_amdgcn_readfirstlane(tid >> 6), lane = tid & 63, wr = wid >> 2, wc = wid & 3, fr = lane & 15, fq = lane >> 4;
    const int K = g.K, nt = K / BK;
    unsigned voffA[2], voffB[2];
#pragma unroll
    for (int i = 0; i < 2; ++i) { int R, C; stage_rc(tid * 16 + i * 8192, R, C); const int Rb = Epi::PERM ? ((R & ~31) + perm32(R & 31)) : R;
        voffA[i] = (unsigned)(R * g.lda + C) * 2u; voffB[i] = (unsigned)(Rb * g.ldb + C) * 2u; }
    const size_t kstep = (size_t)(BK * 2);
    const size_t hstepA = (size_t)HALF * g.lda * 2, hstepB = (size_t)HALF * g.ldb * 2;
    const unsigned ldsw = (unsigned)wid * 1024u;
    const int aoff = lds_byte(wr * 64 + fr, fq * 8), boff = lds_byte(wc * 32 + fr, fq * 8);
#define PG8_SA(b, h) (((b) * 2 + (h)) * HTB)
#define PG8_SB(b, h) ((4 + (b) * 2 + (h)) * HTB)
#define PG8_STAGE(bufoff, gbase, voff) do { _Pragma("unroll") for (int _i = 0; _i < 2; ++_i) \
        __builtin_amdgcn_global_load_lds((const unsigned*)((const char*)(gbase) + (voff)[_i]), (LAS unsigned*)(lds + (bufoff) + ldsw + _i * 8192), 16, 0, 0); } while (0)
#define PG8_LDA(dst, b, h) do { _Pragma("unroll") for (int m = 0; m < 4; ++m) _Pragma("unroll") for (int k = 0; k < 2; ++k) dst[m][k] = *(const LAS bf16x8*)(lds + PG8_SA(b, h) + aoff + m * 2048 + k * 1024); } while (0)
#define PG8_LDB(dst, b, h) do { _Pragma("unroll") for (int n = 0; n < 2; ++n) _Pragma("unroll") for (int k = 0; k < 2; ++k) dst[n][k] = *(const LAS bf16x8*)(lds + PG8_SB(b, h) + boff + n * 2048 + k * 1024); } while (0)
#define PG8_MMA(ai, bj, At, Bt) do { __builtin_amdgcn_s_setprio(1); _Pragma("unroll") for (int m = 0; m < 4; ++m) _Pragma("unroll") for (int n = 0; n < 2; ++n) _Pragma("unroll") for (int k = 0; k < 2; ++k) \
        acc[ai][bj][m][n] = __builtin_amdgcn_mfma_f32_16x16x32_bf16(Bt[n][k], At[m][k], acc[ai][bj][m][n], 0, 0, 0); __builtin_amdgcn_s_setprio(0); } while (0)
#define PG8_WAIT_V(n) asm volatile("s_waitcnt vmcnt(" #n ")" ::: "memory")
#define PG8_WAIT_L(n) asm volatile("s_waitcnt lgkmcnt(" #n ")" ::: "memory")
#define PG8_BAR __builtin_amdgcn_s_barrier()
#define PG8_SCHED __builtin_amdgcn_sched_barrier(0)
    Unit cur, nxt; int ui = 0;
    if (!S.next(0, cur)) return;
    f32x4 acc[2][2][4][2];
#pragma unroll
    for (int a = 0; a < 2; ++a)
#pragma unroll
        for (int b = 0; b < 2; ++b)
#pragma unroll
            for (int m = 0; m < 4; ++m)
#pragma unroll
                for (int n = 0; n < 2; ++n) acc[a][b][m][n] = (f32x4){0.f, 0.f, 0.f, 0.f};
    bf16x8 At[4][2], B0[2][2], B1[2][2];
    const char* cA = (const char*)g.A + ((long)cur.pz * g.sAz + cur.arow * (long)g.lda) * 2;
    const char* cB = (const char*)g.Bt + ((long)cur.pz * g.sBz + cur.brow * (long)g.ldb) * 2;
    PG8_STAGE(PG8_SB(0, 0), cB, voffB); PG8_STAGE(PG8_SB(0, 1), cB + hstepB, voffB); PG8_STAGE(PG8_SA(0, 0), cA, voffA); PG8_STAGE(PG8_SA(0, 1), cA + hstepA, voffA);
    if (wr == 1) PG8_BAR;
    PG8_WAIT_V(2); PG8_BAR;
    PG8_STAGE(PG8_SB(1, 0), cB + kstep, voffB); PG8_STAGE(PG8_SA(1, 0), cA + kstep, voffA); PG8_STAGE(PG8_SB(1, 1), cB + hstepB + kstep, voffB);
    PG8_WAIT_V(6); PG8_BAR;
    for (;;) {
        const bool has_next = S.next(ui + 1, nxt);
        const char* nA = has_next ? (const char*)g.A + ((long)nxt.pz * g.sAz + nxt.arow * (long)g.lda) * 2 : cA;
        const char* nB = has_next ? (const char*)g.Bt + ((long)nxt.pz * g.sBz + nxt.brow * (long)g.ldb) * 2 : cB;
        for (int t = 0; t < nt; t += 2) {
            const bool last = (t == nt - 2);
            const char* a1 = cA + (size_t)(t + 1) * kstep;
            const char* a2 = last ? nA : cA + (size_t)(t + 2) * kstep; const char* b2 = last ? nB : cB + (size_t)(t + 2) * kstep;
            const char* a3 = a2 + kstep; const char* b3 = b2 + kstep;
            PG8_LDB(B0, 0, 0); PG8_LDB(B1, 0, 1); PG8_SCHED; PG8_LDA(At, 0, 0); PG8_STAGE(PG8_SA(1, 1), a1 + hstepA, voffA);
            PG8_WAIT_V(8); PG8_WAIT_L(0); PG8_BAR; PG8_MMA(0, 0, At, B0); PG8_MMA(0, 1, At, B1); PG8_BAR; PG8_SCHED;
            PG8_LDA(At, 0, 1); PG8_STAGE(PG8_SB(0, 0), b2, voffB); PG8_STAGE(PG8_SB(0, 1), b2 + hstepB, voffB); PG8_STAGE(PG8_SA(0, 0), a2, voffA);
            PG8_WAIT_V(8); PG8_WAIT_L(0); PG8_BAR; PG8_MMA(1, 0, At, B0); PG8_MMA(1, 1, At, B1); PG8_BAR; PG8_SCHED;
            PG8_LDB(B0, 1, 0); PG8_LDB(B1, 1, 1); PG8_SCHED; PG8_LDA(At, 1, 0); PG8_STAGE(PG8_SA(0, 1), a2 + hstepA, voffA);
            PG8_WAIT_V(8); PG8_WAIT_L(0); PG8_BAR; PG8_MMA(0, 0, At, B0); PG8_MMA(0, 1, At, B1); PG8_BAR; PG8_SCHED;
            PG8_LDA(At, 1, 1); PG8_STAGE(PG8_SB(1, 0), b3, voffB); PG8_STAGE(PG8_SB(1, 1), b3 + hstepB, voffB); PG8_STAGE(PG8_SA(1, 0), a3, voffA);
            PG8_WAIT_V(8); PG8_WAIT_L(0); PG8_BAR; PG8_MMA(1, 0, At, B0); PG8_MMA(1, 1, At, B1); PG8_BAR; PG8_SCHED;
        }
        if (wr == 0) PG8_BAR;
        E(acc, cur, wr, wc, fr, fq, lds + MISC_OFF);
        if (!has_next) break;
#pragma unroll
        for (int a = 0; a < 2; ++a)
#pragma unroll
            for (int b = 0; b < 2; ++b)
#pragma unroll
                for (int m = 0; m < 4; ++m)
#pragma unroll
                    for (int n = 0; n < 2; ++n) acc[a][b][m][n] = (f32x4){0.f, 0.f, 0.f, 0.f};
        cur = nxt; cA = nA; cB = nB; ++ui;
        if (wr == 1) PG8_BAR;
    }
    PG8_WAIT_V(0);
    PG8_BAR;
#undef PG8_SA
#undef PG8_SB
#undef PG8_STAGE
#undef PG8_LDA
#undef PG8_LDB
#undef PG8_MMA
}

typedef f32x4 Acc[2][2][4][2];

struct EpiG1 {
    static constexpr bool PERM = true;
    bf16_t* PQt; bf16_t* Ht; bf16_t* PQtc; bf16_t* Htc;
    DEV void operator()(const Acc& acc, const Unit& u, int wr, int wc, int fr, int fq, LAS unsigned char*) const {
        const bool isx = u.pn < 128; const int b = isx ? (u.pn >> 4) : (u.pn - 128); const int tb = isx ? ((u.pn & 15) * 256) : 0;
#pragma unroll
        for (int ai = 0; ai < 2; ++ai)
#pragma unroll
            for (int m = 0; m < 4; ++m) {
                const int mrow = u.pm * 256 + ai * 128 + wr * 64 + m * 16 + fr;
                bf16_t* rowp;
                if (mrow < 1024) { const int nf = mrow >> 1, part = mrow & 1;
                    rowp = isx ? PQt + ((size_t)(b * 512 + nf) * 8192 + part * 4096) : PQtc + ((size_t)(b * 512 + nf) * 512 + part * 256); }
                else { const int cp = mrow - 1024; rowp = isx ? Ht + (size_t)(b * 1536 + cp) * 4096 : Htc + (size_t)(b * 1536 + cp) * 256; }
#pragma unroll
                for (int bj = 0; bj < 2; ++bj) { const int t0 = tb + bj * 128 + wc * 32 + 8 * fq;
                    const f32x4 v0 = acc[ai][bj][m][0], v1 = acc[ai][bj][m][1]; u32x4 w;
                    w.x = cvt_pk_bf16(v0[0], v0[1]); w.y = cvt_pk_bf16(v0[2], v0[3]); w.z = cvt_pk_bf16(v1[0], v1[1]); w.w = cvt_pk_bf16(v1[2], v1[3]);
                    *(u32x4*)(rowp + t0) = w; }
                asm volatile("" ::: "memory");
            }
    }
};
struct EpiBf16 {
    static constexpr bool PERM = true;
    bf16_t* O0; bf16_t* O1; int ldc, split, rowbase, zrows; float scale; const float* rs; int rsi; float rsdiv;
    DEV void operator()(const Acc& acc, const Unit& u, int wr, int wc, int fr, int fq, LAS unsigned char*) const {
        asm volatile("" : "+v"(fr), "+v"(fq));
        int colt = u.pn * 256; bf16_t* base = O0; if (split && colt >= split) { base = O1; colt -= split; }
        const int row0 = rowbase + u.pz * zrows + u.pm * 256 + wr * 64 + fr, col0 = colt + wc * 32 + 8 * fq;
#pragma unroll
        for (int ai = 0; ai < 2; ++ai)
#pragma unroll
            for (int m = 0; m < 4; ++m) { const int row = row0 + ai * 128 + m * 16; bf16_t* rowp = base + (size_t)row * ldc + col0;
                const float sc = rs ? scale / sqrtf(rs[(size_t)row * 2 + rsi] * rsdiv + EPS) : scale;
#pragma unroll
                for (int bj = 0; bj < 2; ++bj) { const f32x4 v0 = acc[ai][bj][m][0] * sc, v1 = acc[ai][bj][m][1] * sc; u32x4 w;
                    w.x = cvt_pk_bf16(v0[0], v0[1]); w.y = cvt_pk_bf16(v0[2], v0[3]); w.z = cvt_pk_bf16(v1[0], v1[1]); w.w = cvt_pk_bf16(v1[2], v1[3]);
                    *(u32x4*)(rowp + bj * 128) = w; } }
    }
};
struct EpiF32 {
    static constexpr bool PERM = false;
    float* O; int ldc;
    DEV void operator()(const Acc& acc, const Unit& u, int wr, int wc, int fr, int fq, LAS unsigned char*) const {
        const int row0 = u.pm * 256 + wr * 64 + fr, col0 = u.pn * 256 + wc * 32 + 4 * fq;
#pragma unroll
        for (int ai = 0; ai < 2; ++ai)
#pragma unroll
            for (int m = 0; m < 4; ++m) { float* rowp = O + (size_t)(row0 + ai * 128 + m * 16) * ldc + col0;
#pragma unroll
                for (int bj = 0; bj < 2; ++bj)
#pragma unroll
                    for (int n = 0; n < 2; ++n) *(f32x4*)(rowp + bj * 128 + n * 16) = acc[ai][bj][m][n]; }
    }
};
struct EpiMla {
    static constexpr bool PERM = false;
    bf16_t* aqn; bf16_t* ckvn; float* kpe; float* ssq; const float* gq; const float* gk;
    DEV void operator()(const Acc& acc, const Unit& u, int wr, int wc, int fr, int fq, LAS unsigned char* misc) const {
        asm volatile("" : "+v"(fr), "+v"(fq));
        const int rt = u.pm * 256; const bool isq = (u.pn == 0);
#pragma unroll
        for (int ai = 0; ai < 2; ++ai)
#pragma unroll
            for (int m = 0; m < 4; ++m) { const int rl = ai * 128 + wr * 64 + m * 16 + fr, row = rt + rl; float sq = 0.f;
#pragma unroll
                for (int bj = 0; bj < 2; ++bj)
#pragma unroll
                    for (int n = 0; n < 2; ++n) { const int c = bj * 128 + wc * 32 + n * 16 + 4 * fq; const f32x4 a = acc[ai][bj][m][n];
                        if (isq) { sq += (a[0] * a[0] + a[1] * a[1]) + (a[2] * a[2] + a[3] * a[3]);
                            if (row < TX) { const f32x4 g = *(const f32x4*)(gq + c); u32x2 w; w.x = cvt_pk_bf16(a[0] * g[0], a[1] * g[1]); w.y = cvt_pk_bf16(a[2] * g[2], a[3] * g[3]); *(u32x2*)(aqn + (size_t)row * 256 + c) = w; } }
                        else if (bj == 0) { sq += (a[0] * a[0] + a[1] * a[1]) + (a[2] * a[2] + a[3] * a[3]);
                            const f32x4 g = *(const f32x4*)(gk + c); u32x2 w; w.x = cvt_pk_bf16(a[0] * g[0], a[1] * g[1]); w.y = cvt_pk_bf16(a[2] * g[2], a[3] * g[3]); *(u32x2*)(ckvn + (size_t)row * 128 + c) = w; }
                        else if (wc == 0) { *(f32x4*)(kpe + (size_t)row * 32 + n * 16 + 4 * fq) = a; } }
                sq += __shfl_xor(sq, 16); sq += __shfl_xor(sq, 32); if (fq == 0) ((LAS float*)misc)[rl * 4 + wc] = sq;
                if (m & 1) asm volatile("" ::: "memory"); }
        asm volatile("s_waitcnt lgkmcnt(0)" ::: "memory"); __builtin_amdgcn_s_barrier(); asm volatile("" ::: "memory");
        const int t_ = (wr * 4 + wc) * 64 + fq * 16 + fr;
        if (t_ < 256) { const f32x4 p4 = *(const LAS f32x4*)((LAS float*)misc + t_ * 4); ssq[(size_t)(rt + t_) * 2 + u.pn] = (p4[0] + p4[1]) + (p4[2] + p4[3]); }
        asm volatile("s_waitcnt lgkmcnt(0)" ::: "memory"); __builtin_amdgcn_s_barrier(); asm volatile("" ::: "memory");
    }
};
struct EpiRes {
    static constexpr bool PERM = false;
    const float* baseX; const float* baseC; float* outX; float* outC; const float* gate;
    DEV void operator()(const Acc& acc, const Unit& u, int wr, int wc, int fr, int fq, LAS unsigned char*) const {
        asm volatile("" : "+v"(fr), "+v"(fq));
        const int rt = u.pm * 256; const bool isx = rt < TX; const int mr = isx ? (rt >> 12) : 8;
        const float* bp = isx ? baseX + (size_t)rt * DM : baseC + (size_t)(rt - TX) * DM;
        float* op = isx ? outX + (size_t)rt * DM : outC + (size_t)(rt - TX) * DM;
        const int col0 = u.pn * 256 + wc * 32 + 4 * fq; const float* gp = gate + (size_t)mr * 6144 + col0;
        f32x4 gv[2][2];
#pragma unroll
        for (int bj = 0; bj < 2; ++bj)
#pragma unroll
            for (int n = 0; n < 2; ++n) gv[bj][n] = *(const f32x4*)(gp + bj * 128 + n * 16);
#pragma unroll
        for (int ai = 0; ai < 2; ++ai)
#pragma unroll
            for (int m = 0; m < 4; ++m) { const size_t off = (size_t)(ai * 128 + wr * 64 + m * 16 + fr) * DM + col0;
#pragma unroll
                for (int bj = 0; bj < 2; ++bj)
#pragma unroll
                    for (int n = 0; n < 2; ++n) { const f32x4 bs = *(const f32x4*)(bp + off + bj * 128 + n * 16);
                        *(f32x4*)(op + off + bj * 128 + n * 16) = bs + gv[bj][n] * acc[ai][bj][m][n]; }
                if (m & 1) asm volatile("" ::: "memory"); }
    }
};
struct EpiHF {
    static constexpr bool PERM = false;
    bf16_t* Yt; const float* KF; const float* l1inv; int Nh;
    DEV void operator()(const Acc& acc, const Unit& u, int wr, int wc, int fr, int fq, LAS unsigned char*) const {
        const int ldk = 2 * Nh; const float wN = 1.0f / (float)(2 * Nh);
#pragma unroll
        for (int ai = 0; ai < 2; ++ai)
#pragma unroll
            for (int m = 0; m < 4; ++m) { const int r = u.pm * 256 + ai * 128 + wr * 64 + m * 16 + fr, c = r & 511; const float s = l1inv[c] * wN;
                const float* k1p = KF + (size_t)c * ldk; const float* k2p = KF + (size_t)(512 + c) * ldk; bf16_t* yp = Yt + (size_t)r * ldk;
#pragma unroll
                for (int bj = 0; bj < 2; ++bj)
#pragma unroll
                    for (int n = 0; n < 2; ++n) { const int c0 = u.pn * 256 + bj * 128 + wc * 32 + n * 16 + 4 * fq, f0 = c0 >> 1;
                        const f32x4 k1 = *(const f32x4*)(k1p + c0), k2 = *(const f32x4*)(k2p + c0), a = acc[ai][bj][m][n];
                        const float kr0 = k1[0] + k2[0], ki0 = k1[1] - k2[1], kr1 = k1[2] + k2[2], ki1 = k1[3] - k2[3];
                        const float w0 = (c0 == 0) ? s : 2.f * s, w1 = 2.f * s;
                        const float yr0 = (a[0] * kr0 - a[1] * ki0) * w0, yi0 = (a[0] * ki0 + a[1] * kr0) * w0;
                        const float yr1 = (a[2] * kr1 - a[3] * ki1) * w1, yi1 = (a[2] * ki1 + a[3] * kr1) * w1;
                        *(unsigned*)(yp + f0) = cvt_pk_bf16(yr0, yr1); *(unsigned*)(yp + Nh + f0) = cvt_pk_bf16(yi0, yi1); }
                asm volatile("" ::: "memory"); }
    }
};
struct EpiHI {
    static constexpr bool PERM = false;
    bf16_t* ycat; const bf16_t* Wt; const bf16_t* x0c; const float* ynq; const float* bias; int L, rowbase;
    DEV void operator()(const Acc& acc, const Unit& u, int wr, int wc, int fr, int fq, LAS unsigned char*) const {
#pragma unroll
        for (int ai = 0; ai < 2; ++ai)
#pragma unroll
            for (int m = 0; m < 4; ++m) { const int r = u.pm * 256 + ai * 128 + wr * 64 + m * 16 + fr, b = r >> 9, c = r & 511; const float ny = ynq[r], bs = bias[c];
                const bf16_t* wp = Wt + (size_t)r * L; const bf16_t* xp = x0c + (size_t)r * L;
                bf16_t* op = ycat + (size_t)(rowbase + b * L) * DM + 512 + c;
#pragma unroll
                for (int bj = 0; bj < 2; ++bj)
#pragma unroll
                    for (int n = 0; n < 2; ++n) { const int t0 = u.pn * 256 + bj * 128 + wc * 32 + n * 16 + 4 * fq;
                        const u32x2 wv = *(const u32x2*)(wp + t0), xv = *(const u32x2*)(xp + t0); const f32x4 a = acc[ai][bj][m][n];
                        const float w0 = __uint_as_float(wv.x << 16), w1 = __uint_as_float(wv.x & 0xffff0000u), w2 = __uint_as_float(wv.y << 16), w3 = __uint_as_float(wv.y & 0xffff0000u);
                        const float x0 = __uint_as_float(xv.x << 16), x1 = __uint_as_float(xv.x & 0xffff0000u), x2 = __uint_as_float(xv.y << 16), x3 = __uint_as_float(xv.y & 0xffff0000u);
                        const float y0 = x0 * (a[0] + ny + w0 * bs), y1 = x1 * (a[1] - ny + w1 * bs), y2 = x2 * (a[2] + ny + w2 * bs), y3 = x3 * (a[3] - ny + w3 * bs);
                        const unsigned p01 = cvt_pk_bf16(y0, y1), p23 = cvt_pk_bf16(y2, y3);
                        op[(size_t)(t0 + 0) * DM] = (bf16_t)(p01 & 0xffffu); op[(size_t)(t0 + 1) * DM] = (bf16_t)(p01 >> 16);
                        op[(size_t)(t0 + 2) * DM] = (bf16_t)(p23 & 0xffffu); op[(size_t)(t0 + 3) * DM] = (bf16_t)(p23 >> 16); }
                asm volatile("" ::: "memory"); }
    }
};
struct EpiFFN {
    static constexpr bool PERM = true;
    bf16_t* act; const float* cw; const float* cb; float* sb;
    DEV void operator()(const Acc& acc, const Unit& u, int wr, int wc, int fr, int fq, LAS unsigned char* misc) const {
        asm volatile("" : "+v"(fr), "+v"(fq));
        const int lane = fq * 16 + fr;
        const int sbase = u.pm * 256, s0 = 0;
        float* sbp = sb + (size_t)u.pm * 6 * DFF;
        LAS float* xl = (LAS float*)misc;
        LAS float* xf = xl + 512;
#pragma unroll
        for (int ai = 0; ai < 2; ++ai) { const int q = 2 * ai + wr;
#pragma unroll
            for (int n = 0; n < 2; ++n) { const int cc = wc * 32 + 8 * fq + 4 * n;
                if (fr == 15) *(LAS f32x4*)(xl + q * 128 + cc) = acc[ai][0][3][n];
                if (fr == 0) *(LAS f32x4*)(xf + q * 128 + cc) = acc[ai][0][0][n]; } }
        asm volatile("s_waitcnt lgkmcnt(0)" ::: "memory"); __builtin_amdgcn_s_barrier(); asm volatile("" ::: "memory");
#define ROR1(x) __int_as_float(__builtin_amdgcn_update_dpp(0, __float_as_int(x), 0x121, 0xf, 0xf, false))
#define ROR15(x) __int_as_float(__builtin_amdgcn_update_dpp(0, __float_as_int(x), 0x12F, 0xf, 0xf, false))
#pragma unroll
        for (int n = 0; n < 2; ++n) { const int cc = wc * 32 + 8 * fq + 4 * n, j = u.pn * 128 + cc;
            const f32x4 w0 = *(const f32x4*)(cw + j), w1 = *(const f32x4*)(cw + DFF + j), w2 = *(const f32x4*)(cw + 2 * DFF + j), bb = *(const f32x4*)(cb + j);
#pragma unroll
            for (int ai = 0; ai < 2; ++ai) { const int q = 2 * ai + wr;
                const f32x4 bup = (q > 0) ? *(LAS f32x4*)(xl + (q - 1) * 128 + cc) : (f32x4){0.f, 0.f, 0.f, 0.f};
                const f32x4 bdn = (q < 3) ? *(LAS f32x4*)(xf + (q + 1) * 128 + cc) : (f32x4){0.f, 0.f, 0.f, 0.f};
                f32x4 Rprev = bup, Dcur;
#pragma unroll
                for (int e = 0; e < 4; ++e) Dcur[e] = ROR15(acc[ai][0][0][n][e]);
#pragma unroll
                for (int m = 0; m < 4; ++m) {
                    f32x4 Rm, Dnext = bdn;
#pragma unroll
                    for (int e = 0; e < 4; ++e) { Rm[e] = ROR1(acc[ai][0][m][n][e]); if (m < 3) Dnext[e] = ROR15(acc[ai][0][m < 3 ? m + 1 : 3][n][e]); }
                    const f32x4 up = (fr > 0) ? Rm : Rprev;
                    const f32x4 dn = (fr < 15) ? Dcur : Dnext;
                    Rprev = Rm; Dcur = Dnext;
                    const int rr = q * 64 + m * 16 + fr, sq = s0 + rr;
                    const f32x4 g = acc[ai][0][m][n], v = acc[ai][1][m][n];
                    f32x4 o;
#pragma unroll
                    for (int e = 0; e < 4; ++e) { const float z = w0[e] * up[e] + w1[e] * g[e] + w2[e] * dn[e] + bb[e]; o[e] = z * __builtin_amdgcn_rcpf(1.f + __builtin_amdgcn_exp2f(-1.4426950408889634f * z)) * v[e]; }
                    if (rr >= 1 && rr <= 254) { u32x2 w; w.x = cvt_pk_bf16(o[0], o[1]); w.y = cvt_pk_bf16(o[2], o[3]);
                        *(u32x2*)(act + (size_t)(sbase + sq) * DFF + j) = w; }
                    if (rr < 2 || rr > 253) { const int rid = rr < 2 ? rr : rr - 252; *(f32x4*)(sbp + (size_t)rid * DFF + j) = g;
                        if (rr == 0 || rr == 255) *(f32x4*)(sbp + (size_t)(4 + (rr == 255)) * DFF + j) = v; }
                }
                asm volatile("" ::: "memory");
            } }
#undef ROR1
#undef ROR15
    }
};
}

namespace att {
constexpr int KST = 12288, VST = 8192, STG = KST + VST;
constexpr int OFF_WS = 2 * STG;
constexpr int NT = 68;
constexpr float QSCALE = 0.10206207261596577f * 1.4426950408889634f;
DEV int crow(int r, int hi) { return (r & 3) + 8 * (r >> 2) + 4 * hi; }
DEV unsigned cvtpk(float lo, float hi) { return cvt_pk_bf16(lo, hi); }
DEV void pv(f32x16* o, int vb, bf16x8 pa0, bf16x8 pa1, bf16x8 pa2, bf16x8 pa3) {
#pragma unroll
    for (int d0 = 0; d0 < 2; ++d0) { s16x4 lo[4], hi[4];
#pragma unroll
        for (int ks = 0; ks < 4; ++ks) {
            asm volatile("ds_read_b64_tr_b16 %0,%1 offset:%c2" : "=&v"(lo[ks]) : "v"(vb), "i"(d0 * 4096 + ks * 1024) : "memory");
            asm volatile("ds_read_b64_tr_b16 %0,%1 offset:%c2" : "=&v"(hi[ks]) : "v"(vb), "i"(d0 * 4096 + ks * 1024 + 512) : "memory"); }
        asm volatile("s_waitcnt lgkmcnt(0)" ::: "memory"); __builtin_amdgcn_sched_barrier(0);
#define PKV(k) (bf16x8){lo[k][0], lo[k][1], lo[k][2], lo[k][3], hi[k][0], hi[k][1], hi[k][2], hi[k][3]}
        o[d0] = __builtin_amdgcn_mfma_f32_32x32x16_bf16(pa0, PKV(0), o[d0], 0, 0, 0);
        o[d0] = __builtin_amdgcn_mfma_f32_32x32x16_bf16(pa1, PKV(1), o[d0], 0, 0, 0);
        o[d0] = __builtin_amdgcn_mfma_f32_32x32x16_bf16(pa2, PKV(2), o[d0], 0, 0, 0);
        o[d0] = __builtin_amdgcn_mfma_f32_32x32x16_bf16(pa3, PKV(3), o[d0], 0, 0, 0);
#undef PKV
    }
}
DEV void pvh(f32x16* o, int vb, bf16x8 pa, bf16x8 pb) {
    s16x4 lo[4], hi[4];
#pragma unroll
    for (int d0 = 0; d0 < 2; ++d0)
#pragma unroll
        for (int kk = 0; kk < 2; ++kk) {
            asm volatile("ds_read_b64_tr_b16 %0,%1 offset:%c2" : "=&v"(lo[d0 * 2 + kk]) : "v"(vb), "i"(d0 * 4096 + kk * 1024) : "memory");
            asm volatile("ds_read_b64_tr_b16 %0,%1 offset:%c2" : "=&v"(hi[d0 * 2 + kk]) : "v"(vb), "i"(d0 * 4096 + kk * 1024 + 512) : "memory"); }
    asm volatile("s_waitcnt lgkmcnt(0)" ::: "memory"); __builtin_amdgcn_sched_barrier(0);
#define PKV(k) (bf16x8){lo[k][0], lo[k][1], lo[k][2], lo[k][3], hi[k][0], hi[k][1], hi[k][2], hi[k][3]}
    o[0] = __builtin_amdgcn_mfma_f32_32x32x16_bf16(pa, PKV(0), o[0], 0, 0, 0);
    o[1] = __builtin_amdgcn_mfma_f32_32x32x16_bf16(pa, PKV(2), o[1], 0, 0, 0);
    o[0] = __builtin_amdgcn_mfma_f32_32x32x16_bf16(pb, PKV(1), o[0], 0, 0, 0);
    o[1] = __builtin_amdgcn_mfma_f32_32x32x16_bf16(pb, PKV(3), o[1], 0, 0, 0);
#undef PKV
}
DEV float max3f(float a, float b, float c) { return fmaxf(fmaxf(a, b), c); }
DEV void attn_unit(int b, int h, int qb, const bf16_t* Q, const bf16_t* K, const bf16_t* V, bf16_t* O, LAS unsigned char* sh, const int tid, const float* qgain) {
    const int lane = tid & 63, r32 = lane & 31, hi = lane >> 5; const int wid = __builtin_amdgcn_readfirstlane(tid >> 6);
    const long qrow0 = (long)b * SEQ + qb * 256 + wid * 32;
    const bf16_t* Qw = Q + qrow0 * 1536 + h * 96;
    const unsigned lds0 = (unsigned)(uintptr_t)sh;
    LAS float* wsf = (LAS float*)(sh + OFF_WS) + wid * 64;
    bf16x8 qr[6];
#pragma unroll
    for (int d0 = 0; d0 < 6; ++d0) qr[d0] = *(const bf16x8*)(Qw + (long)r32 * 1536 + d0 * 16 + hi * 8);
    {
        float qv[6][8]; float ss = 0.f;
#pragma unroll
        for (int d0 = 0; d0 < 6; ++d0) { const u32x4 raw = __builtin_bit_cast(u32x4, qr[d0]);
            qv[d0][0] = __uint_as_float(raw.x << 16); qv[d0][1] = __uint_as_float(raw.x & 0xffff0000u); qv[d0][2] = __uint_as_float(raw.y << 16); qv[d0][3] = __uint_as_float(raw.y & 0xffff0000u);
            qv[d0][4] = __uint_as_float(raw.z << 16); qv[d0][5] = __uint_as_float(raw.z & 0xffff0000u); qv[d0][6] = __uint_as_float(raw.w << 16); qv[d0][7] = __uint_as_float(raw.w & 0xffff0000u);
#pragma unroll
            for (int e = 0; e < 8; ++e) ss += qv[d0][e] * qv[d0][e]; }
        ss += __shfl_xor(ss, 32);
        const float rstd = 1.0f / sqrtf(ss * (1.f / 96.f) + EPS);
#pragma unroll
        for (int d0 = 0; d0 < 6; ++d0) { const f32x4 g0 = *(const f32x4*)(qgain + d0 * 16 + hi * 8), g1 = *(const f32x4*)(qgain + d0 * 16 + hi * 8 + 4);
#pragma unroll
            for (int e = 0; e < 4; ++e) { qv[d0][e] *= rstd * g0[e]; qv[d0][4 + e] *= rstd * g1[e]; } }
        const int tq = qb * 256 + wid * 32 + r32; const float pr = (float)(tq >> 6), pc = (float)(tq & 63);
#pragma unroll
        for (int e = 0; e < 8; ++e) { const float invf = exp2f(-(float)e * (13.287712379549449f / 8.f));
            const float rr_ = pr * invf * 0.15915494309189535f, rc_ = pc * invf * 0.15915494309189535f;
            const float sr = __builtin_amdgcn_sinf(rr_), cr = __builtin_amdgcn_cosf(rr_), sc_ = __builtin_amdgcn_sinf(rc_), cc = __builtin_amdgcn_cosf(rc_);
            const float o4 = qv[4][e], o5 = qv[5][e], p4 = __shfl_xor(o4, 32), p5 = __shfl_xor(o5, 32);
            qv[4][e] = hi ? (p4 * sr + o4 * cr) : (o4 * cr - p4 * sr);
            qv[5][e] = hi ? (p5 * sc_ + o5 * cc) : (o5 * cc - p5 * sc_); }
#pragma unroll
        for (int d0 = 0; d0 < 6; ++d0) { u32x4 w; w.x = cvt_pk_bf16(qv[d0][0] * QSCALE, qv[d0][1] * QSCALE); w.y = cvt_pk_bf16(qv[d0][2] * QSCALE, qv[d0][3] * QSCALE);
            w.z = cvt_pk_bf16(qv[d0][4] * QSCALE, qv[d0][5] * QSCALE); w.w = cvt_pk_bf16(qv[d0][6] * QSCALE, qv[d0][7] * QSCALE); qr[d0] = __builtin_bit_cast(bf16x8, w); }
    }
    u32x4 kreg0, kreg1, vreg;
    const bool k2 = wid < 4;
#define KBASE(t) ((t) < 64 ? (long)b * SEQ + (t) * 64 : (long)TX + b * CTXL + ((t) - 64) * 64)
#define LOADT(t) do { const long kb_ = KBASE(t); \
        kreg0 = *(const u32x4*)(K + (kb_ + lane) * 1536 + h * 96 + wid * 8); \
        if (k2) kreg1 = *(const u32x4*)(K + (kb_ + lane) * 1536 + h * 96 + (8 + wid) * 8); \
        vreg = *(const u32x4*)(V + (kb_ + 16 * (wid & 3) + (lane >> 2)) * 1024 + h * 64 + (wid >> 2) * 32 + (lane & 3) * 8); } while (0)
#define STORET(s) do { LAS unsigned char* st_ = sh + (s) * STG; \
        *(LAS u32x4*)(st_ + wid * 1024 + lane * 16) = kreg0; if (k2) *(LAS u32x4*)(st_ + (8 + wid) * 1024 + lane * 16) = kreg1; \
        *(LAS u32x4*)(st_ + KST + wid * 1024 + lane * 16) = vreg; } while (0)
    float mrun = 0.f, lsum = 0.f; f32x16 o[2]; o[0] = f32x16{}; o[1] = f32x16{}; const f32x16 zero16 = f32x16{};
#define LOADK(t) do { const long kb_ = KBASE(t); kreg0 = *(const u32x4*)(K + (kb_ + lane) * 1536 + h * 96 + wid * 8); \
        if (k2) kreg1 = *(const u32x4*)(K + (kb_ + lane) * 1536 + h * 96 + (8 + wid) * 8); } while (0)
#define LOADV(t) do { const long kb_ = KBASE(t); vreg = *(const u32x4*)(V + (kb_ + 16 * (wid & 3) + (lane >> 2)) * 1024 + h * 64 + (wid >> 2) * 32 + (lane & 3) * 8); } while (0)
#define STOREK(s) do { LAS unsigned char* st_ = sh + (s) * STG; *(LAS u32x4*)(st_ + wid * 1024 + lane * 16) = kreg0; if (k2) *(LAS u32x4*)(st_ + (8 + wid) * 1024 + lane * 16) = kreg1; } while (0)
#define STOREV(s) do { LAS unsigned char* st_ = sh + (s) * STG; *(LAS u32x4*)(st_ + KST + wid * 1024 + lane * 16) = vreg; } while (0)
#define QKT(P0, P1, s) do { LAS unsigned char* kb = sh + (s) * STG + hi * 1024 + r32 * 16; \
        _Pragma("unroll") for (int d0 = 0; d0 < 6; ++d0) { \
            const bf16x8 b0 = *(const LAS bf16x8*)(kb + d0 * 2048), b1 = *(const LAS bf16x8*)(kb + d0 * 2048 + 512); \
            P0 = __builtin_amdgcn_mfma_f32_32x32x16_bf16(b0, qr[d0], d0 == 0 ? zero16 : P0, 0, 0, 0); \
            P1 = __builtin_amdgcn_mfma_f32_32x32x16_bf16(b1, qr[d0], d0 == 0 ? zero16 : P1, 0, 0, 0); } } while (0)
#define SOFTPAIR(P, r) do { mx = max3f(mx, P[r], P[r + 1]); f32x2 v_ = (f32x2){P[r], P[r + 1]} - m2; v_.x = __builtin_amdgcn_exp2f(v_.x); v_.y = __builtin_amdgcn_exp2f(v_.y); P[r] = v_.x; P[r + 1] = v_.y; sum2 += v_; } while (0)
#define STEP(PA0, PA1, PB0, PB1, t, HASQK) do { const int s = (t) & 1; const bool more1 = (t) + 1 < NT, more2 = (t) + 2 < NT; \
        if (more2) LOADK((t) + 2); if (more1) LOADV((t) + 1); \
        if (HASQK) QKT(PB0, PB1, s ^ 1); \
        float mx = PA0[0]; f32x2 sum2 = (f32x2){0.f, 0.f}; const f32x2 m2 = (f32x2){mrun, mrun}; \
        _Pragma("unroll") for (int r = 0; r < 16; r += 2) { SOFTPAIR(PA0, r); } \
        u32x4 pw0, pw1, pw2, pw3; \
        pw0 = (u32x4){cvtpk(PA0[0], PA0[1]), cvtpk(PA0[2], PA0[3]), cvtpk(PA0[4], PA0[5]), cvtpk(PA0[6], PA0[7])}; \
        pw1 = (u32x4){cvtpk(PA0[8], PA0[9]), cvtpk(PA0[10], PA0[11]), cvtpk(PA0[12], PA0[13]), cvtpk(PA0[14], PA0[15])}; \
        if (HASQK) { __builtin_amdgcn_sched_group_barrier(0x100, 3, 0); \
            _Pragma("unroll") for (int i_ = 0; i_ < 12; ++i_) { __builtin_amdgcn_sched_group_barrier(0x008, 1, 0); __builtin_amdgcn_sched_group_barrier(0x100, 1, 0); __builtin_amdgcn_sched_group_barrier(0x002, 5, 0); } } \
        __builtin_amdgcn_sched_barrier(0); \
        const int vb = (int)(lds0 + s * STG + KST) + ((lane >> 4) & 1) * 32 + (lane & 3) * 8 + (4 * hi + ((lane & 15) >> 2)) * 64; \
        pvh(o, vb, __builtin_bit_cast(bf16x8, pw0), __builtin_bit_cast(bf16x8, pw1)); \
        _Pragma("unroll") for (int r = 0; r < 16; r += 2) { SOFTPAIR(PA1, r); } \
        pw2 = (u32x4){cvtpk(PA1[0], PA1[1]), cvtpk(PA1[2], PA1[3]), cvtpk(PA1[4], PA1[5]), cvtpk(PA1[6], PA1[7])}; \
        pw3 = (u32x4){cvtpk(PA1[8], PA1[9]), cvtpk(PA1[10], PA1[11]), cvtpk(PA1[12], PA1[13]), cvtpk(PA1[14], PA1[15])}; \
        __builtin_amdgcn_sched_barrier(0); \
        pvh(o, vb + 2048, __builtin_bit_cast(bf16x8, pw2), __builtin_bit_cast(bf16x8, pw3)); \
        lsum += sum2.x + sum2.y; \
        float rm = fmaxf(mx, __shfl_xor(mx, 32)); \
        if (__any(rm - mrun > 8.0f)) { const float dl = fmaxf(rm - mrun, 0.f); mrun += dl; \
            const float f = __builtin_amdgcn_exp2f(-dl); lsum *= f; \
            if (hi == 0) wsf[r32] = f; \
            asm volatile("s_waitcnt lgkmcnt(0)" ::: "memory"); \
            _Pragma("unroll") for (int r = 0; r < 16; ++r) { const float fr_ = wsf[crow(r, hi)]; o[0][r] *= fr_; o[1][r] *= fr_; } } \
        if (more2) STOREK(s); if (more1) STOREV(s ^ 1); \
        __syncthreads(); } while (0)
    LOADK(0); LOADV(0); STOREK(0); STOREV(0); LOADK(1); STOREK(1); __syncthreads();
    f32x16 pA0, pA1, pB0 = f32x16{}, pB1 = f32x16{};
    QKT(pA0, pA1, 0);
    { float m0 = pA0[0];
#pragma unroll
        for (int r = 0; r < 16; ++r) m0 = max3f(m0, pA0[r], pA1[r]);
        mrun = fmaxf(m0, __shfl_xor(m0, 32)); }
    for (int t = 0; t < NT - 2; t += 2) {
        STEP(pA0, pA1, pB0, pB1, t, true);
        STEP(pB0, pB1, pA0, pA1, t + 1, true);
    }
    STEP(pA0, pA1, pB0, pB1, NT - 2, true);
    STEP(pB0, pB1, pA0, pA1, NT - 1, false);
#undef SOFTPAIR
#undef LOADK
#undef LOADV
#undef STOREK
#undef STOREV
#undef QKT
#undef STEP
#undef LOADT
#undef STORET
#undef KBASE
    lsum += __shfl_xor(lsum, 32);
    if (hi == 0) wsf[r32] = 1.0f / lsum;
    asm volatile("s_waitcnt lgkmcnt(0)" ::: "memory");
    bf16_t* Ow = O + qrow0 * 1024 + h * 64;
#pragma unroll
    for (int r = 0; r < 16; ++r) { const int q = crow(r, hi); const float f = wsf[q];
        const unsigned a = cvt_pk_bf16(o[0][r] * f, o[1][r] * f);
        Ow[(long)q * 1024 + r32] = (bf16_t)(a & 0xffffu); Ow[(long)q * 1024 + 32 + r32] = (bf16_t)(a >> 16); }
    __syncthreads();
}
}

namespace fftl {
constexpr float W16C[8] = {1.f, 0.923879533f, 0.707106781f, 0.382683432f, 0.f, -0.382683432f, -0.707106781f, -0.923879533f};
constexpr float W16S[8] = {0.f, 0.382683432f, 0.707106781f, 0.923879533f, 1.f, 0.923879533f, 0.707106781f, 0.382683432f};
DEV int padi(int n) { return n + ((n >> 5) << 2); }
template <bool INV> DEV void bfly(float& xr, float& xi, float& yr, float& yi, const float c, const float s) {
    if (!INV) { const float dr = xr - yr, di = xi - yi; xr += yr; xi += yi; yr = dr * c + di * s; yi = di * c - dr * s; }
    else { const float tr = yr * c - yi * s, ti = yr * s + yi * c; yr = xr - tr; yi = xi - ti; xr += tr; xi += ti; }
}
template <int LR, bool INV, bool PRUNE = false> DEV void pass_strided(LAS float* re, LAS float* im, const int N, const int s, const int tid, const int ncol, const int cstride) {
    constexpr int R = 1 << LR; const int h2 = N >> (s + LR), ngr = N / R; const float invN = 1.f / (float)N;
    const bool lin = (h2 & 31) == 0; const int ph2 = h2 + ((h2 >> 5) << 2);
    for (int w = tid; w < ngr * ncol; w += NTHREADS) {
        const int col = w >> __builtin_ctz(ngr), g = w & (ngr - 1);
        const int j = g & (h2 - 1), base = (g - j) * R + j, pbase = padi(base);
        float twc[LR][R / 2], tws[LR][R / 2];
        { const float rev = (float)(j << s) * invN; float c = __builtin_amdgcn_cosf(rev), sn = __builtin_amdgcn_sinf(rev);
#pragma unroll
            for (int k = 0; k < LR; ++k) { const int dk = R >> (k + 1);
#pragma unroll
                for (int mm = 0; mm < R / 2; ++mm) { float cc = 0.f, ss = 0.f;
                    if (mm < dk) { const int e8 = mm * (4 / dk);
                        if (e8 == 0) { cc = c; ss = sn; } else if (e8 == 1) { cc = (c - sn) * 0.70710678f; ss = (sn + c) * 0.70710678f; } else if (e8 == 2) { cc = -sn; ss = c; } else { cc = (-c - sn) * 0.70710678f; ss = (c - sn) * 0.70710678f; } }
                    twc[k][mm] = cc; tws[k][mm] = ss; }
                const float c2 = c * c - sn * sn, s2 = 2.f * c * sn; c = c2; sn = s2; } }
        LAS float* r_ = re + col * cstride; LAS float* i_ = im + col * cstride;
        float xr[R], xi[R];
#pragma unroll
        for (int m = 0; m < R; ++m) { if (PRUNE && !INV && m >= R / 2) { xr[m] = 0.f; xi[m] = 0.f; } else { const int p = lin ? pbase + m * ph2 : padi(base + m * h2); xr[m] = r_[p]; xi[m] = i_[p]; } }
#pragma unroll
        for (int kk = 0; kk < LR; ++kk) { const int k = INV ? LR - 1 - kk : kk; const int dk = R >> (k + 1);
#pragma unroll
            for (int m = 0; m < R; ++m) if ((m & dk) == 0) bfly<INV>(xr[m], xi[m], xr[m + dk], xi[m + dk], twc[k][m & (dk - 1)], tws[k][m & (dk - 1)]); }
#pragma unroll
        for (int m = 0; m < R; ++m) { if (!(PRUNE && INV && m >= R / 2)) { const int p = lin ? pbase + m * ph2 : padi(base + m * h2); r_[p] = xr[m]; i_[p] = xi[m]; } }
    }
}
template <bool INV> DEV void pass_final16(LAS float* re, LAS float* im, const int N, const int tid, const int ncol, const int cstride) {
    const int ng = N >> 4;
    for (int w = tid; w < ng * ncol; w += NTHREADS) { const int col = w >> __builtin_ctz(ng), g = w & (ng - 1); const int p0 = padi(16 * g);
        LAS float* r_ = re + col * cstride + p0; LAS float* i_ = im + col * cstride + p0;
        float xr[16], xi[16];
#pragma unroll
        for (int m = 0; m < 16; ++m) { xr[m] = r_[m]; xi[m] = i_[m]; }
#pragma unroll
        for (int kk = 0; kk < 4; ++kk) { const int k = INV ? 3 - kk : kk; const int dk = 8 >> k;
#pragma unroll
            for (int m = 0; m < 16; ++m) if ((m & dk) == 0) bfly<INV>(xr[m], xi[m], xr[m + dk], xi[m + dk], W16C[(m & (dk - 1)) << k], W16S[(m & (dk - 1)) << k]); }
#pragma unroll
        for (int m = 0; m < 16; ++m) { r_[m] = xr[m]; i_[m] = xi[m]; }
    }
}
template <bool INV> DEV void pass_any(const int LR, LAS float* re, LAS float* im, const int N, const int s, const int tid, const int ncol, const int cstride) {
    if (LR == 3) pass_strided<3, INV>(re, im, N, s, tid, ncol, cstride);
    else if (LR == 2) pass_strided<2, INV>(re, im, N, s, tid, ncol, cstride);
    else pass_strided<1, INV>(re, im, N, s, tid, ncol, cstride);
}
template <bool INV, bool PRUNE = false> DEV void run(LAS float* re, LAS float* im, const int logN, const int tid_in, const int ncol, const int cstride) {
    int tid = tid_in; asm volatile("" : "+v"(tid));
    const int N = 1 << logN, front = logN - 4;
    if (!INV) {
        if (PRUNE) pass_strided<3, false, true>(re, im, N, 0, tid, ncol, cstride); else pass_strided<3, false, false>(re, im, N, 0, tid, ncol, cstride);
        __syncthreads();
        for (int s = 3; s < front;) { const int LR = (front - s >= 3) ? 3 : front - s; pass_any<false>(LR, re, im, N, s, tid, ncol, cstride); __syncthreads(); s += LR; }
        pass_final16<false>(re, im, N, tid, ncol, cstride); __syncthreads();
    } else {
        pass_final16<true>(re, im, N, tid, ncol, cstride); __syncthreads();
        int s = front; const int rem = front % 3;
        if (rem) { s -= rem; pass_any<true>(rem, re, im, N, s, tid, ncol, cstride); __syncthreads(); }
        while (s > 3) { s -= 3; pass_any<true>(3, re, im, N, s, tid, ncol, cstride); __syncthreads(); }
        if (PRUNE) pass_strided<3, true, true>(re, im, N, 0, tid, ncol, cstride); else pass_strided<3, true, false>(re, im, N, 0, tid, ncol, cstride);
        __syncthreads();
    }
}
}

struct Args { const float* in[33]; float* out; unsigned char* ws; int ph_lo, ph_hi; };
enum { I_X = 0, I_C, I_CTX, I_CCTX, I_NORM1, I_NORM2, I_WMOD, I_BMOD, I_FUP, I_FCW, I_FCB, I_FDOWN, I_FHIN, I_FHOUT, I_HCW, I_HCB,
       I_HW1, I_HB1, I_HW2, I_HB2, I_HW3, I_HB3, I_HW4, I_HFREQ, I_HBIAS, I_MIN, I_MQAN, I_MUQ, I_MKVAN, I_MUKV, I_MQN, I_MKN, I_MWO };

struct Op {
    int type; const bf16_t* A; const bf16_t* Bt; int lda, ldb, K; long sAz, sBz; int nM, nN, nZ, mode, rot;
    void* o0; void* o1; const void* p0; const void* p1; const void* p2; const void* p3; void* x0; void* x1;
    int i0, i1, i2, i3, i4; float f0, f1;
};
enum { T_G1 = 0, T_BF16, T_F32, T_RES, T_HF, T_HI, T_FFN, T_MLA };

typedef const __attribute__((address_space(4))) unsigned char* kptr_t;
#define KIN(i) (((const float* const __attribute__((address_space(4)))*)kp)[i])
#define KOUT (*(float* const __attribute__((address_space(4)))*)(kp + 264))
#define KWS (*(unsigned char* const __attribute__((address_space(4)))*)(kp + 272))
DEV bool get_op(kptr_t kp, int ph, int idx, Op& o) {
    unsigned char* ws = KWS;
#define BF(off) ((bf16_t*)(ws + (off)))
#define FP(off) ((float*)(ws + (off)))
    o.sAz = 0; o.sBz = 0; o.nZ = 1; o.mode = 0; o.rot = 0; o.o1 = nullptr; o.p0 = o.p1 = o.p2 = o.p3 = nullptr; o.x0 = o.x1 = nullptr; o.i0 = o.i1 = o.i2 = o.i3 = o.i4 = 0; o.f0 = 1.f; o.f1 = 0.f;
    float* mod = FP(WS_MOD);
    switch (ph) {
    case 2:
        if (idx == 0) { o.type = T_G1; o.A = BF(W_W1T); o.Bt = BF(WS_HX); o.lda = 1024; o.ldb = 1024; o.K = 1024; o.nM = 10; o.nN = 136; o.o0 = BF(WS_PQT); o.o1 = BF(WS_HT); o.p0 = BF(WS_PQTC); o.p1 = BF(WS_HTC); return true; }
        if (idx == 99) { o.type = T_F32; o.A = BF(WS_FILT); o.Bt = BF(WS_T1); o.lda = 4096; o.ldb = 4096; o.K = 4096; o.nM = 4; o.nN = 32; o.rot = 176; o.o0 = FP(WS_KF); o.i0 = 8192; return true; }
        if (idx == 98) { o.type = T_F32; o.A = BF(WS_FILTC); o.Bt = BF(WS_T1C); o.lda = 256; o.ldb = 256; o.K = 256; o.nM = 4; o.nN = 2; o.rot = 240; o.o0 = FP(WS_KFC); o.i0 = 512; return true; }
        return false;
    case 4:
        if (idx == 95) { o.type = T_BF16; o.A = BF(WS_T2); o.Bt = BF(WS_PQT); o.lda = 8192; o.ldb = 8192; o.K = 8192; o.sBz = 512L * 8192; o.nM = 16; o.nN = 2; o.nZ = 8; o.o0 = BF(WS_HX); o.i0 = 1024; o.i1 = 0; o.i2 = 0; o.i3 = 4096; o.f0 = 0.001381067932004975f; return true; }
        if (idx == 97) { o.type = T_HF; o.A = BF(WS_WT); o.Bt = BF(WS_T1); o.lda = 4096; o.ldb = 4096; o.K = 4096; o.nM = 16; o.nN = 32; o.o0 = BF(WS_YT); o.p0 = FP(WS_KF); o.p1 = FP(WS_SMALL); o.i0 = 4096; return true; }
        if (idx == 94) { o.type = T_BF16; o.A = BF(WS_CSC); o.Bt = BF(WS_PQTC); o.lda = 512; o.ldb = 512; o.K = 512; o.sBz = 512L * 512; o.nM = 1; o.nN = 2; o.nZ = 8; o.rot = 128; o.o0 = BF(WS_HX); o.i0 = 1024; o.i1 = 0; o.i2 = TX; o.i3 = 256; o.f0 = 0.005524271728019903f; return true; }
        if (idx == 96) { o.type = T_HF; o.A = BF(WS_WTC); o.Bt = BF(WS_T1C); o.lda = 256; o.ldb = 256; o.K = 256; o.nM = 16; o.nN = 2; o.rot = 160; o.o0 = BF(WS_YTC); o.p0 = FP(WS_KFC); o.p1 = FP(WS_SMALL + 4096); o.i0 = 256; return true; }
        return false;
    case 5:
        return false;
        if (idx == 0) { o.type = T_HI; o.A = BF(WS_YT); o.Bt = BF(WS_T1); o.lda = 8192; o.ldb = 8192; o.K = 8192; o.nM = 16; o.nN = 16; o.o0 = BF(WS_HX); o.p0 = BF(WS_WT); o.p1 = BF(WS_X0C); o.p2 = FP(WS_SMALL + 16384); o.p3 = KIN(I_HBIAS); o.i0 = 4096; o.i1 = 0; return true; }
        if (idx == 1) { o.type = T_HI; o.A = BF(WS_YTC); o.Bt = BF(WS_T1C); o.lda = 512; o.ldb = 512; o.K = 512; o.nM = 16; o.nN = 1; o.o0 = BF(WS_HX); o.p0 = BF(WS_WTC); o.p1 = BF(WS_X0CC); o.p2 = FP(WS_SMALL + 32768); o.p3 = KIN(I_HBIAS); o.i0 = 256; o.i1 = TX; return true; }
        return false;
    case 6:
        if (idx == 0) { o.type = T_RES; o.A = BF(WS_HX); o.Bt = BF(W_WOUT); o.lda = 1024; o.ldb = 1024; o.K = 1024; o.nM = 136; o.nN = 4; o.p0 = KIN(I_X); o.p1 = KIN(I_CTX); o.o0 = FP(WS_XR); o.o1 = FP(WS_XR) + (size_t)TX * DM; o.p2 = mod + 2 * 1024; return true; }
        return false;
    case 8:
        if (idx == 0) { o.type = T_FFN; o.A = BF(WS_HX); o.Bt = BF(W_WUP); o.lda = 1024; o.ldb = 1024; o.K = 1024; o.nM = 136; o.nN = 22; o.mode = 0; o.o0 = BF(WS_ACT); o.o1 = FP(WS_SB); o.p0 = KIN(I_FCW); o.p1 = KIN(I_FCB); return true; }
        return false;
    case 9:
        if (idx == 0) { o.type = T_RES; o.A = BF(WS_ACT); o.Bt = BF(W_WDOWN); o.lda = DFF; o.ldb = DFF; o.K = DFF; o.nM = 136; o.nN = 4; o.p0 = FP(WS_XR); o.p1 = FP(WS_XR) + (size_t)TX * DM; o.o0 = FP(WS_XR); o.o1 = FP(WS_XR) + (size_t)TX * DM; o.p2 = mod + 5 * 1024; return true; }
        return false;
    case 11:
        if (idx == 0) { o.type = T_MLA; o.A = BF(WS_HX); o.Bt = BF(W_MLAIN); o.lda = 1024; o.ldb = 1024; o.K = 1024; o.nM = 136; o.nN = 2; o.o0 = BF(WS_AQN); o.o1 = BF(WS_CKVN); o.x0 = FP(WS_KPE); o.x1 = FP(WS_SSQ2); o.p0 = KIN(I_MQAN); o.p1 = KIN(I_MKVAN); return true; }
        return false;
    case 13:
        if (idx == 0) { o.type = T_BF16; o.A = BF(WS_AQN); o.Bt = BF(W_WUQ); o.lda = 256; o.ldb = 256; o.K = 256; o.nM = 128; o.nN = 6; o.o0 = BF(WS_QB); o.i0 = 1536; o.i3 = 0; o.p0 = FP(WS_SSQ2); o.i4 = 0; o.f1 = 1.f / 256.f; return true; }
        if (idx == 1) { o.type = T_BF16; o.A = BF(WS_CKVN); o.Bt = BF(W_WUKV); o.lda = 128; o.ldb = 128; o.K = 128; o.nM = 136; o.nN = 8; o.o0 = BF(WS_KRAW); o.o1 = BF(WS_VB); o.i0 = 1024; o.i1 = 1024; o.p0 = FP(WS_SSQ2); o.i4 = 1; o.f1 = 1.f / 128.f; return true; }
        return false;
    case 16:
        if (idx == 0) { o.type = T_RES; o.A = BF(WS_OB); o.Bt = BF(W_WO); o.lda = 1024; o.ldb = 1024; o.K = 1024; o.nM = 128; o.nN = 4; o.p0 = FP(WS_XR); o.p1 = FP(WS_XR) + (size_t)TX * DM; o.o0 = FP(WS_XR); o.o1 = FP(WS_XR) + (size_t)TX * DM; o.p2 = mod + 9 * 6144 + 2 * 1024; return true; }
        return false;
    case 18:
        if (idx == 0) { o.type = T_FFN; o.A = BF(WS_HX); o.Bt = BF(W_WUP); o.lda = 1024; o.ldb = 1024; o.K = 1024; o.nM = 128; o.nN = 22; o.mode = 0; o.o0 = BF(WS_ACT); o.o1 = FP(WS_SB); o.p0 = KIN(I_FCW) + 3 * DFF; o.p1 = KIN(I_FCB) + DFF; return true; }
        return false;
    case 19:
        if (idx == 0) { o.type = T_RES; o.A = BF(WS_ACT); o.Bt = BF(W_WDOWN); o.lda = DFF; o.ldb = DFF; o.K = DFF; o.nM = 128; o.nN = 4; o.p0 = FP(WS_XR); o.p1 = FP(WS_XR) + (size_t)TX * DM; o.o0 = KOUT; o.o1 = KOUT; o.p2 = mod + 9 * 6144 + 5 * 1024; return true; }
        return false;
    default: return false;
    }
#undef BF
#undef FP
}

DEV void tr_item(const float* W, int ldw, int K, bf16_t* WT, int dst_n0, int src_n0, int k0, LAS float* scr, int lane) {
#pragma unroll 8
    for (int i = 0; i < 32; ++i) { const int kk = 2 * i + (lane >> 5); scr[kk * 33 + (lane & 31)] = (src_n0 >= 0) ? __builtin_nontemporal_load(W + (size_t)(k0 + kk) * ldw + src_n0 + (lane & 31)) : 0.f; }
    asm volatile("s_waitcnt lgkmcnt(0)" ::: "memory");
    const int c = lane & 7;
#pragma unroll
    for (int j = 0; j < 4; ++j) { const int n = (lane >> 3) + 8 * j; const LAS float* s = scr + (8 * c) * 33 + n;
        u32x4 o; o.x = cvt_pk_bf16(s[0 * 33], s[1 * 33]); o.y = cvt_pk_bf16(s[2 * 33], s[3 * 33]); o.z = cvt_pk_bf16(s[4 * 33], s[5 * 33]); o.w = cvt_pk_bf16(s[6 * 33], s[7 * 33]);
        *(u32x4*)(WT + (size_t)(dst_n0 + n) * K + k0 + 8 * c) = o; }
    asm volatile("s_waitcnt lgkmcnt(0)" ::: "memory");
}
DEV void tr_matrix(const float* W, int ldw, int K, int Ndst, bf16_t* WT, int map, int nvalid, int src_off, LAS float* scr, int gw, int NGW, int lane) {
    const int nblk = Ndst / 32, nit = (K / 64) * nblk;
    for (int it = gw; it < nit; it += NGW) { const int kb = it / nblk, nb = it % nblk, d0 = nb * 32; int s0 = d0;
        if (map == 1) { const int pn = d0 >> 8, wi = d0 & 255, bj = wi >> 7, jj = wi & 127; s0 = bj * DFF + 128 * pn + jj; }
        else if (map == 2) { if (d0 < 1024) s0 = (d0 >> 6) * 128 + (d0 & 63); else { const int n2 = d0 - 1024; s0 = (n2 >> 6) * 128 + 64 + (n2 & 63); } }
        else if (map == 3) { if (d0 >= nvalid) s0 = -1; }
        tr_item(W, ldw, K, WT, d0, s0 < 0 ? -1 : s0 + src_off, kb * 64, scr, lane); }
}
DEV void modnorm_rows(const float* srcX, const float* srcC, int nrows, const float* g, const float* shift, const float* scale, bf16_t* dst, int gw, int NGW, int lane) {
    for (int row0 = gw; row0 < nrows; row0 += 2 * NGW) {
        const int row1 = row0 + NGW; const bool has1 = row1 < nrows;
        const float* xr0 = (row0 < TX) ? srcX + (size_t)row0 * DM : srcC + (size_t)(row0 - TX) * DM;
        const float* xr1 = !has1 ? xr0 : ((row1 < TX) ? srcX + (size_t)row1 * DM : srcC + (size_t)(row1 - TX) * DM);
        f32x4 v0[4], v1[4]; float s0 = 0.f, s1 = 0.f;
#pragma unroll
        for (int j = 0; j < 4; ++j) { v0[j] = __builtin_nontemporal_load((const f32x4*)(xr0 + 256 * j + 4 * lane)); v1[j] = __builtin_nontemporal_load((const f32x4*)(xr1 + 256 * j + 4 * lane)); }
#pragma unroll
        for (int j = 0; j < 4; ++j) { s0 += (v0[j][0] * v0[j][0] + v0[j][1] * v0[j][1]) + (v0[j][2] * v0[j][2] + v0[j][3] * v0[j][3]); s1 += (v1[j][0] * v1[j][0] + v1[j][1] * v1[j][1]) + (v1[j][2] * v1[j][2] + v1[j][3] * v1[j][3]); }
        const float rstd0 = 1.0f / sqrtf(wave_sum(s0) * (1.f / DM) + EPS), rstd1 = 1.0f / sqrtf(wave_sum(s1) * (1.f / DM) + EPS);
        const int mr0 = (row0 < TX) ? (row0 >> 12) : 8, mr1 = (row1 < TX) ? (row1 >> 12) : 8;
#pragma unroll
        for (int j = 0; j < 4; ++j) { const int col = 256 * j + 4 * lane; const f32x4 gg = *(const f32x4*)(g + col);
            { const f32x4 sh = *(const f32x4*)(shift + (size_t)mr0 * 6144 + col), sc = *(const f32x4*)(scale + (size_t)mr0 * 6144 + col); f32x4 y;
#pragma unroll
                for (int e = 0; e < 4; ++e) y[e] = (v0[j][e] * rstd0 * gg[e]) * (1.f + sc[e]) + sh[e];
                u32x2 w; w.x = cvt_pk_bf16(y[0], y[1]); w.y = cvt_pk_bf16(y[2], y[3]); *(u32x2*)(dst + (size_t)row0 * DM + col) = w; }
            if (has1) { const f32x4 sh = *(const f32x4*)(shift + (size_t)mr1 * 6144 + col), sc = *(const f32x4*)(scale + (size_t)mr1 * 6144 + col); f32x4 y;
#pragma unroll
                for (int e = 0; e < 4; ++e) y[e] = (v1[j][e] * rstd1 * gg[e]) * (1.f + sc[e]) + sh[e];
                u32x2 w; w.x = cvt_pk_bf16(y[0], y[1]); w.y = cvt_pk_bf16(y[2], y[3]); *(u32x2*)(dst + (size_t)row1 * DM + col) = w; } }
    }
}

constexpr size_t WS_BAR = 3 * MiB;
DEV void grid_barrier(unsigned* cnt, const unsigned target, const int tid) {
    asm volatile("s_waitcnt vmcnt(0)" ::: "memory");
    __syncthreads();
    if (tid == 0) {
        __builtin_amdgcn_fence(__ATOMIC_RELEASE, "agent");
        __hip_atomic_fetch_add(cnt, 1u, __ATOMIC_RELAXED, __HIP_MEMORY_SCOPE_AGENT);
        while (__hip_atomic_load(cnt, __ATOMIC_RELAXED, __HIP_MEMORY_SCOPE_AGENT) < target) __builtin_amdgcn_s_sleep(2);
        __builtin_amdgcn_fence(__ATOMIC_ACQUIRE, "agent");
        asm volatile("s_waitcnt vmcnt(0)" ::: "memory");
    }
    __syncthreads();
}
DEV void ffn_fixup(const float* sb, bf16_t* act, const float* cw, const float* cb, const int nrt, const int gt, const int NGT) {
    const int per = DFF / 4;
    for (int i = gt; i < nrt * 2 * per; i += NGT) { const int pm = i / (2 * per), r2 = i - pm * 2 * per, e = r2 / per, j = (r2 - e * per) * 4;
        const bool isx = pm < 128; const bool first = isx ? ((pm & 15) == 0) : true, last = isx ? ((pm & 15) == 15) : true;
        const float* me = sb + (size_t)pm * 6 * DFF + j; const f32x4 z4 = (f32x4){0.f, 0.f, 0.f, 0.f};
        f32x4 up, g, dn, v;
        if (e == 0) { up = first ? z4 : *(const f32x4*)(me - (size_t)6 * DFF + (size_t)3 * DFF); g = *(const f32x4*)(me); dn = *(const f32x4*)(me + DFF); v = *(const f32x4*)(me + (size_t)4 * DFF); }
        else { up = *(const f32x4*)(me + (size_t)2 * DFF); g = *(const f32x4*)(me + (size_t)3 * DFF); dn = last ? z4 : *(const f32x4*)(me + (size_t)6 * DFF); v = *(const f32x4*)(me + (size_t)5 * DFF); }
        const f32x4 w0 = *(const f32x4*)(cw + j), w1 = *(const f32x4*)(cw + DFF + j), w2 = *(const f32x4*)(cw + 2 * DFF + j), bb = *(const f32x4*)(cb + j);
        f32x4 o;
#pragma unroll
        for (int q = 0; q < 4; ++q) { const float z = w0[q] * up[q] + w1[q] * g[q] + w2[q] * dn[q] + bb[q]; o[q] = z * __builtin_amdgcn_rcpf(1.f + __builtin_amdgcn_exp2f(-1.4426950408889634f * z)) * v[q]; }
        const int row = pm * 256 + (e ? 255 : 0);
        u32x2 w; w.x = cvt_pk_bf16(o[0], o[1]); w.y = cvt_pk_bf16(o[2], o[3]); *(u32x2*)(act + (size_t)row * DFF + j) = w; }
}
DEV void hy_conv8(const bf16_t* ht, const int b, const int c, const int L, const int t0, const bool act_, const float* cwp, const float* cbp, float (&x0o)[8], float (&wo)[8]) {
    float outv[3][8];
#pragma unroll
    for (int q = 0; q < 3; ++q) { const int cp = q * 512 + c; const bf16_t* src = ht + (size_t)(b * 1536 + cp) * L;
        const float w0 = cwp[cp], w1 = cwp[1536 + cp], w2 = cwp[3072 + cp], bq = cbp[cp];
        float x[10];
        if (act_) { const u32x4 raw = *(const u32x4*)(src + t0);
            x[1] = __uint_as_float(raw.x << 16); x[2] = __uint_as_float(raw.x & 0xffff0000u); x[3] = __uint_as_float(raw.y << 16); x[4] = __uint_as_float(raw.y & 0xffff0000u);
            x[5] = __uint_as_float(raw.z << 16); x[6] = __uint_as_float(raw.z & 0xffff0000u); x[7] = __uint_as_float(raw.w << 16); x[8] = __uint_as_float(raw.w & 0xffff0000u);
            x[0] = (t0 > 0) ? bf2f(src[t0 - 1]) : 0.f; x[9] = (t0 + 8 < L) ? bf2f(src[t0 + 8]) : 0.f; }
        else {
#pragma unroll
            for (int e = 0; e < 10; ++e) x[e] = 0.f; }
#pragma unroll
        for (int e = 0; e < 8; ++e) outv[q][e] = w0 * x[e] + w1 * x[e + 1] + w2 * x[e + 2] + bq; }
#pragma unroll
    for (int e = 0; e < 8; ++e) { x0o[e] = outv[0][e]; wo[e] = outv[2][e] * outv[1][e]; }
}
#define BF(off) ((bf16_t*)(ws + (off)))
#define FP(off) ((float*)(ws + (off)))
#define PHASE(k) ((LO) <= (k) && (k) < (HI) && ph == (k))
#ifndef DUP_PH
#define DUP_PH -1
#endif
template <int LO, int HI>
DEV void run_phases(LAS unsigned char* lds, const int ph_lo, const int ph_hi, const int G, const int wave0, unsigned& nbar) {
    int dup_left = 1;
    for (int ph = (ph_lo > LO ? ph_lo : LO); ph < (ph_hi < HI ? ph_hi : HI); ++ph) {
        if (ph == 3 || ph == 5 || ph == 12) continue;
        kptr_t kp = (kptr_t)__builtin_amdgcn_kernarg_segment_ptr(); asm volatile("" : "+s"(kp));
        int bid = blockIdx.x; asm volatile("" : "+s"(bid));
        const int NGW = G * 8, NGT = G * NTHREADS;
        unsigned char* ws = KWS;
        float* mod = FP(WS_MOD);
        {
        int tid; asm volatile("v_mbcnt_lo_u32_b32 %0, -1, 0\n\tv_mbcnt_hi_u32_b32 %0, -1, %0" : "=v"(tid)); tid += wave0 * 64; asm volatile("" : "+v"(tid));
        const int gt = bid * NTHREADS + tid;
        if (PHASE(9) || PHASE(19)) {
            const int l1_ = (ph == 19);
            ffn_fixup(FP(WS_SB), BF(WS_ACT), KIN(I_FCW) + l1_ * 3 * DFF, KIN(I_FCB) + l1_ * DFF, l1_ ? 128 : 136, gt, NGT);
            if (ph_lo < ph) { ++nbar; grid_barrier((unsigned*)(ws + WS_BAR), nbar * (unsigned)G, tid); }
        }
        {
            Op o;
            for (int idx = 0; get_op(kp, ph, idx, o); ++idx) {
                pg8::Gemm g{o.A, o.Bt, o.lda, o.ldb, o.K, o.sAz, o.sBz};
                pg8::Sched S{o.nM, o.nN, o.nZ, G, (bid + o.rot) % G, o.mode};
                int tid2 = tid; asm volatile("" : "+v"(tid2));
                switch (o.type) {
                case T_G1: if (LO <= 2 && 2 < HI) { pg8::EpiG1 E{(bf16_t*)o.o0, (bf16_t*)o.o1, (bf16_t*)o.p0, (bf16_t*)o.p1}; pg8::gemm_phase(lds, g, S, E, tid2); } break;
                case T_BF16: if (LO <= 13 && 13 < HI) { pg8::EpiBf16 E{(bf16_t*)o.o0, (bf16_t*)o.o1, o.i0, o.i1, o.i2, o.i3, o.f0, (const float*)o.p0, o.i4, o.f1}; pg8::gemm_phase(lds, g, S, E, tid2); } break;
                case T_F32: if (LO <= 11 && 11 < HI) { pg8::EpiF32 E{(float*)o.o0, o.i0}; pg8::gemm_phase(lds, g, S, E, tid2); } break;
                case T_RES: if (HI > 6) { pg8::EpiRes E{(const float*)o.p0, (const float*)o.p1, (float*)o.o0, (float*)o.o1, (const float*)o.p2}; pg8::gemm_phase(lds, g, S, E, tid2); } break;
                case T_FFN: if (HI > 8) { pg8::EpiFFN E{(bf16_t*)o.o0, (const float*)o.p0, (const float*)o.p1, (float*)o.o1}; pg8::gemm_phase(lds, g, S, E, tid2); } break;
                case T_MLA: if (LO <= 11 && 11 < HI) { pg8::EpiMla E{(bf16_t*)o.o0, (bf16_t*)o.o1, (float*)o.x0, (float*)o.x1, (const float*)o.p0, (const float*)o.p1}; pg8::gemm_phase(lds, g, S, E, tid2); } break;
                }
                __syncthreads();
            }
        }
        }
        int tid; asm volatile("v_mbcnt_lo_u32_b32 %0, -1, 0\n\tv_mbcnt_hi_u32_b32 %0, -1, %0" : "=v"(tid)); tid += wave0 * 64; asm volatile("" : "+v"(tid));
        const int lane = tid & 63, wave = __builtin_amdgcn_readfirstlane(tid >> 6);
        const int gw = bid * 8 + wave;
        const int gt = bid * NTHREADS + tid;
        if (PHASE(0)) {
            const bool bal0 = (G == 256); const int nrep0 = (bal0 && bid >= 192) ? 2 : 1, vNGW0 = bal0 ? 2560 : NGW;
            {
                LAS float* sl = (LAS float*)lds;
                LAS float* part = sl + 9 * 1024;
                bool loaded = false;
                for (int it = bid; it < 192; it += G) {
                    if (!loaded) { for (int i = tid; i < 9 * 1024; i += NTHREADS) { const float x = (i < 8192) ? KIN(I_C)[i] : KIN(I_CCTX)[i - 8192]; sl[i] = silu_f(x); } loaded = true; __syncthreads(); }
                    const int l = it / 96, n0 = (it % 96) * 64; const float* wm = KIN(I_WMOD) + (size_t)l * 1024 * 6144 + n0 + lane;
                    float acc9[9];
#pragma unroll
                    for (int r = 0; r < 9; ++r) acc9[r] = 0.f;
#pragma unroll 32
                    for (int k = wave * 128; k < wave * 128 + 128; ++k) { const float wv = wm[(size_t)k * 6144];
#pragma unroll
                        for (int r = 0; r < 9; ++r) acc9[r] += sl[r * 1024 + k] * wv; }
#pragma unroll
                    for (int r = 0; r < 9; ++r) part[(wave * 9 + r) * 64 + lane] = acc9[r];
                    __syncthreads();
                    for (int i = tid; i < 576; i += NTHREADS) { const int r = i >> 6, ln = i & 63; float s = 0.f;
#pragma unroll
                        for (int w = 0; w < 8; ++w) s += part[(w * 9 + r) * 64 + ln];
                        mod[(size_t)(l * 9 + r) * 6144 + n0 + ln] = s + KIN(I_BMOD)[l * 6144 + n0 + ln]; }
                    __syncthreads();
                }
                __syncthreads();
            }
            {
                LAS float* scr = (LAS float*)(lds + wave * 16384);
                for (int rep = 0; rep < nrep0; ++rep) { const int vgw = bal0 ? (bid < 192 ? gw : 1536 + (bid - 192) * 16 + rep * 8 + wave) : gw;
                    tr_matrix(KIN(I_FHIN), 2048, 1024, 1536, BF(W_W1T) + (size_t)1024 * 1024, 0, 0, 512, scr, vgw, vNGW0, lane);
                    tr_matrix(KIN(I_FHOUT), 1024, 1024, 1024, BF(W_WOUT), 0, 0, 0, scr, vgw, vNGW0, lane);
                    tr_matrix(KIN(I_FUP), 2 * DFF, 1024, 2 * DFF, BF(W_WUP), 1, 0, 0, scr, vgw, vNGW0, lane);
                    tr_matrix(KIN(I_FDOWN), 1024, DFF, 1024, BF(W_WDOWN), 0, 0, 0, scr, vgw, vNGW0, lane); }
                __syncthreads();
            }
            {
                LAS float* wt = (LAS float*)lds;
                LAS float* cs = wt + 16 * 128;
                if (tid < 128) { cs[tid] = __builtin_amdgcn_cosf((float)tid / 128.f); cs[128 + tid] = __builtin_amdgcn_sinf((float)tid / 128.f); }
                for (int it = bid; it < 256; it += G) { const int g = it >> 6, k0 = (it & 63) * 16;
                    __syncthreads();
                    for (int i = tid; i < 2048; i += NTHREADS) { const int kk = i >> 7, j = i & 127; wt[i] = KIN(I_FHIN)[(size_t)(k0 + kk) * 2048 + g * 128 + j]; }
                    __syncthreads();
                    const int rowi = tid >> 1, hh = tid & 1, m = rowi >> 1, part = rowi & 1;
                    float s[8];
#pragma unroll
                    for (int e = 0; e < 8; ++e) s[e] = 0.f;
                    for (int j = 0; j < 128; ++j) { const float tr = cs[part * 128 + ((j * m) & 127)];
#pragma unroll
                        for (int e = 0; e < 8; ++e) s[e] += wt[(hh * 8 + e) * 128 + j] * tr; }
                    u32x4 w; w.x = cvt_pk_bf16(s[0], s[1]); w.y = cvt_pk_bf16(s[2], s[3]); w.z = cvt_pk_bf16(s[4], s[5]); w.w = cvt_pk_bf16(s[6], s[7]);
                    *(u32x4*)(BF(W_W1T) + (size_t)(2 * (g * 128 + m) + part) * 1024 + k0 + hh * 8) = w;
                }
                __syncthreads();
            }
            for (int rep = 0; rep < nrep0; ++rep)
            for (int it = bal0 ? (bid < 192 ? gw : 1536 + (bid - 192) * 16 + rep * 8 + wave) : gw; it < 4096 + 256; it += vNGW0) {
                const bool isc = it >= 4096; const int L = isc ? 256 : 4096, pos = isc ? it - 4096 : it;
                const float t = (float)pos / (float)(L - 1);
                float z = 0.f;
                if (lane == 0) z = t;
                else if (lane < 33) { const int i = (lane - 1) & 15; const float band = 1e-4f + (float)i * ((15.0f - 1e-4f) / 15.0f);
                    const float ang = (6.283185307179586f / (float)L) * (float)pos * band; z = (lane <= 16) ? cosf(ang) : -sinf(ang); }
                const float fr_ = KIN(I_HFREQ)[lane];
                float h = KIN(I_HB1)[lane];
#pragma unroll 11
                for (int i = 0; i < 33; ++i) h += __shfl(z, i) * KIN(I_HW1)[i * 64 + lane];
                h = sinf(fr_ * h);
                float h2 = KIN(I_HB2)[lane];
#pragma unroll 16
                for (int i = 0; i < 64; ++i) h2 += __shfl(h, i) * KIN(I_HW2)[i * 64 + lane];
                h2 = sinf(fr_ * h2);
                float h3 = KIN(I_HB3)[lane];
#pragma unroll 16
                for (int i = 0; i < 64; ++i) h3 += __shfl(h2, i) * KIN(I_HW3)[i * 64 + lane];
                h3 = sinf(fr_ * h3);
                (isc ? FP(WS_H3C) : FP(WS_H3X))[(size_t)pos * 64 + lane] = h3;
            }
        }
        else if (PHASE(1)) {
            modnorm_rows(KIN(I_X), KIN(I_CTX), TT, KIN(I_NORM1), mod + 0 * 1024, mod + 1 * 1024, BF(WS_HX), gw, NGW, lane);
        }
        else if (PHASE(4)) {
            {
            LAS float* re = (LAS float*)lds; LAS float* im = re + 9216; LAS float* kre = re + 18432; LAS float* kim = kre + 8192;
            LAS float* w4 = kim + 8192; LAS float* red = w4 + 128;
            for (int it = bid; it < 1024; it += G) {
                const bool isc = it >= 512; const int c = (G == 256) ? ((((it >> 8) & 1) * 8 + (bid & 7)) * 32 + (bid >> 3)) : (it & 511), L = isc ? 256 : 4096, N = 2 * L, logN = isc ? 9 : 13;
                const float invN = 1.f / (float)N;
                const float* h3 = isc ? FP(WS_H3C) : FP(WS_H3X);
                __syncthreads();
                if (tid < 128) w4[tid] = KIN(I_HW4)[(size_t)(tid & 63) * 1024 + (tid >> 6) * 512 + c];
                __syncthreads();
                const float MIND = -15.350567286626973f, MAXD = -3.0701134573253946f;
                const float ad = fabsf(MIND + (float)c * ((MAXD - MIND) / 511.f));
                float l1 = 0.f;
                for (int p = tid; p < L; p += NTHREADS) { const float* hp = h3 + (size_t)p * 64; float sf = 0.f, sb = 0.f;
#pragma unroll
                    for (int j4 = 0; j4 < 16; ++j4) { const f32x4 hv = *(const f32x4*)(hp + 4 * j4);
#pragma unroll
                        for (int e = 0; e < 4; ++e) { sf += hv[e] * w4[4 * j4 + e]; sb += hv[e] * w4[64 + 4 * j4 + e]; } }
                    const float t = (float)p / (float)(L - 1), dec = expf(-t * ad); sf *= dec; sb = (p == 0) ? 0.f : sb * dec;
                    re[fftl::padi(p)] = sf; im[fftl::padi(p)] = 0.f; im[fftl::padi(p + L)] = 0.f;
                    if (p > 0) re[fftl::padi(N - p)] = sb; else re[fftl::padi(L)] = 0.f;
                    l1 += fabsf(sf) + fabsf(sb); }
                l1 = wave_sum(l1);
                if (lane == 0) red[wave] = l1;
                __syncthreads();
                float l1t = 0.f;
#pragma unroll
                for (int w = 0; w < 8; ++w) l1t += red[w];
                const float ksc = invN / l1t;
                fftl::run<false>(re, im, logN, tid, 1, 0);
                for (int i = tid; i < N; i += NTHREADS) { const int p = fftl::padi(i); kre[i] = re[p] * ksc; kim[i] = im[p] * ksc; }
                __syncthreads();
                const bf16_t* ht = isc ? BF(WS_HTC) : BF(WS_HT);
                const float* cwp = KIN(I_HCW); const float* cbp = KIN(I_HCB); const float hb_ = KIN(I_HBIAS)[c];
                const int npb = isc ? 4 : 1, cst = isc ? 576 : 0, cpp = L / 8;
                const int pl = tid >> __builtin_ctz(cpp), t0 = (tid & (cpp - 1)) * 8; const bool act_ = pl < npb; const int pt0 = pl * cst + fftl::padi(t0), pt1 = pl * cst + fftl::padi(L + t0);
                for (int bp0 = 0; bp0 < 4; bp0 += npb) { const int bp = bp0 + (act_ ? pl : 0);
                    float xk[2][8], wk[2][8];
                    hy_conv8(ht, 2 * bp, c, L, t0, act_, cwp, cbp, xk[0], wk[0]); hy_conv8(ht, 2 * bp + 1, c, L, t0, act_, cwp, cbp, xk[1], wk[1]);
                    if (act_) {
#pragma unroll
                        for (int e = 0; e < 8; ++e) { re[pt0 + e] = wk[0][e]; im[pt0 + e] = wk[1][e]; } }
                    __syncthreads();
                    fftl::run<false, true>(re, im, logN, tid, npb, cst);
                    for (int i = tid; i < N * npb; i += NTHREADS) { const int cl = i >> logN, ii = i & (N - 1); const int p = cl * cst + fftl::padi(ii); const float zr = re[p], zi = im[p], kr = kre[ii], ki = kim[ii]; re[p] = zr * kr - zi * ki; im[p] = zr * ki + zi * kr; }
                    __syncthreads();
                    fftl::run<true, true>(re, im, logN, tid, npb, cst);
                    if (act_) {
#pragma unroll
                        for (int bb = 0; bb < 2; ++bb) { const int b = 2 * bp + bb; bf16_t* op = BF(WS_HX) + (size_t)((isc ? TX : 0) + b * L + t0) * DM + 512 + c;
#pragma unroll
                            for (int e = 0; e < 8; e += 2) { const float y0 = (bb ? im[pt0 + e] : re[pt0 + e]), y1 = (bb ? im[pt0 + e + 1] : re[pt0 + e + 1]);
                                const unsigned pk = cvt_pk_bf16(xk[bb][e] * (y0 + wk[bb][e] * hb_), xk[bb][e + 1] * (y1 + wk[bb][e + 1] * hb_));
                                op[(size_t)e * DM] = (bf16_t)(pk & 0xffffu); op[(size_t)(e + 1) * DM] = (bf16_t)(pk >> 16); } } }
                    __syncthreads();
                }
            }
            __syncthreads();
            }
            {
                LAS float* fre = (LAS float*)lds; LAS float* fim = fre + 9216;
                u32x4 pfc[2], pfs[2];
#define FPRE(itn) do { if ((itn) < 4096) { const bool isc_ = (itn) >= 2048; const int L_ = isc_ ? 256 : 4096, b_ = ((itn) & 2047) >> 8, n_ = ((G == 256) ? ((bid & 7) * 32 + (bid >> 3)) : ((itn) & 255)) * 2; \
                        const bf16_t* src_ = (isc_ ? BF(WS_PQTC) : BF(WS_PQT)) + (size_t)(b_ * 512 + n_) * (2 * L_); \
                        _Pragma("unroll") for (int u_ = 0; u_ < 2; ++u_) { const int i_ = tid + u_ * NTHREADS; if (i_ < L_ / 4) { const int j_ = i_ / (L_ / 8), t_ = (i_ % (L_ / 8)) * 8; \
                            pfc[u_] = *(const u32x4*)(src_ + (size_t)j_ * 2 * L_ + t_); pfs[u_] = *(const u32x4*)(src_ + (size_t)j_ * 2 * L_ + L_ + t_); } } } } while (0)
                pfc[0] = pfc[1] = pfs[0] = pfs[1] = u32x4{};
                FPRE(bid);
                for (int it = bid; it < 4096; it += G) {
                    const bool isc = it >= 2048; const int L = isc ? 256 : 4096, logL = isc ? 8 : 12, b = (it & 2047) >> 8, n0 = ((G == 256) ? ((bid & 7) * 32 + (bid >> 3)) : (it & 255)) * 2;
                    const float oscale = isc ? 0.005524271728019903f : 0.001381067932004975f;
                    __syncthreads();
#pragma unroll
                    for (int u_ = 0; u_ < 2; ++u_) { const int i = tid + u_ * NTHREADS; if (i < L / 4) { const int j = i / (L / 8), t0 = (i % (L / 8)) * 8;
                        const u32x4 rc = pfc[u_], rs = pfs[u_];
                        LAS float* pr = fre + j * 4608 + fftl::padi(t0); LAS float* pi = fim + j * 4608 + fftl::padi(t0);
                        pr[0] = __uint_as_float(rc.x << 16); pr[1] = __uint_as_float(rc.x & 0xffff0000u); pr[2] = __uint_as_float(rc.y << 16); pr[3] = __uint_as_float(rc.y & 0xffff0000u);
                        pr[4] = __uint_as_float(rc.z << 16); pr[5] = __uint_as_float(rc.z & 0xffff0000u); pr[6] = __uint_as_float(rc.w << 16); pr[7] = __uint_as_float(rc.w & 0xffff0000u);
                        pi[0] = -__uint_as_float(rs.x << 16); pi[1] = -__uint_as_float(rs.x & 0xffff0000u); pi[2] = -__uint_as_float(rs.y << 16); pi[3] = -__uint_as_float(rs.y & 0xffff0000u);
                        pi[4] = -__uint_as_float(rs.z << 16); pi[5] = -__uint_as_float(rs.z & 0xffff0000u); pi[6] = -__uint_as_float(rs.w << 16); pi[7] = -__uint_as_float(rs.w & 0xffff0000u); } }
                    __syncthreads();
                    FPRE(it + G);
                    fftl::run<false>(fre, fim, logL, tid, 2, 4608);
                    bf16_t* yb = BF(WS_HX) + (size_t)((isc ? TX : 0) + b * L) * DM + n0;
                    for (int p = tid; p < L; p += NTHREADS) { const int k1 = (int)(__brev((unsigned)p) >> (32 - logL)); const int pp = fftl::padi(p);
                        *(unsigned*)(yb + (size_t)k1 * DM) = cvt_pk_bf16(fre[pp] * oscale, fre[4608 + pp] * oscale); }
                }
#undef FPRE
                __syncthreads();
            }
        }
        else if (PHASE(7)) {
            modnorm_rows(FP(WS_XR), FP(WS_XR) + (size_t)TX * DM, TT, KIN(I_NORM2), mod + 3 * 1024, mod + 4 * 1024, BF(WS_HX), gw, NGW, lane);
        }
        else if (PHASE(6)) {
            LAS float* scr = (LAS float*)(lds + wave * 16384);
            tr_matrix(KIN(I_MIN), 416, 1024, 512, BF(W_MLAIN), 3, 416, 0, scr, gw, NGW, lane);
            tr_matrix(KIN(I_MUQ), 1536, 256, 1536, BF(W_WUQ), 0, 0, 0, scr, gw, NGW, lane);
            tr_matrix(KIN(I_MUKV), 2048, 128, 2048, BF(W_WUKV), 2, 0, 0, scr, gw, NGW, lane);
            tr_matrix(KIN(I_MWO), 1024, 1024, 1024, BF(W_WO), 0, 0, 0, scr, gw, NGW, lane);
            __syncthreads();
        }
        else if (PHASE(9)) {
            LAS float* scr = (LAS float*)(lds + wave * 16384);
            tr_matrix(KIN(I_FUP) + (size_t)1024 * 2 * DFF, 2 * DFF, 1024, 2 * DFF, BF(W_WUP), 1, 0, 0, scr, gw, NGW, lane);
            __syncthreads();
        }
        else if (PHASE(10)) {
            modnorm_rows(FP(WS_XR), FP(WS_XR) + (size_t)TX * DM, TT, KIN(I_NORM1) + 1024, mod + 9 * 6144 + 0 * 1024, mod + 9 * 6144 + 1 * 1024, BF(WS_HX), gw, NGW, lane);
        }
        else if (PHASE(11)) {
            LAS float* scr = (LAS float*)(lds + wave * 16384);
            tr_matrix(KIN(I_FDOWN) + (size_t)DFF * 1024, 1024, DFF, 1024, BF(W_WDOWN), 0, 0, 0, scr, gw, NGW, lane);
            __syncthreads();
        }
        else if (PHASE(12)) {
            const float* ab = FP(WS_ABUF);
            for (int row = gw; row < TT; row += NGW) { const float* ar = ab + (size_t)row * 512;
                const f32x4 q = *(const f32x4*)(ar + 4 * lane); const f32x2 kv = *(const f32x2*)(ar + 256 + 2 * lane);
                const float sq = wave_sum((q[0] * q[0] + q[1] * q[1]) + (q[2] * q[2] + q[3] * q[3])), sk = wave_sum(kv[0] * kv[0] + kv[1] * kv[1]);
                const float rq = 1.0f / sqrtf(sq * (1.f / 256.f) + EPS), rk = 1.0f / sqrtf(sk * (1.f / 128.f) + EPS);
                if (row < TX) { const f32x4 gq = *(const f32x4*)(KIN(I_MQAN) + 4 * lane); u32x2 w; w.x = cvt_pk_bf16(q[0] * rq * gq[0], q[1] * rq * gq[1]); w.y = cvt_pk_bf16(q[2] * rq * gq[2], q[3] * rq * gq[3]);
                    *(u32x2*)(BF(WS_AQN) + (size_t)row * 256 + 4 * lane) = w; }
                const f32x2 gk = *(const f32x2*)(KIN(I_MKVAN) + 2 * lane);
                *(unsigned*)(BF(WS_CKVN) + (size_t)row * 128 + 2 * lane) = cvt_pk_bf16(kv[0] * rk * gk[0], kv[1] * rk * gk[1]);
                if (lane < 32) FP(WS_KPE)[(size_t)row * 32 + lane] = ar[384 + lane];
            }
        }
        else if (PHASE(14)) {
            const int h = lane >> 2, q = lane & 3;
            for (int it = TX + gw; it < TX + TT; it += NGW) {
                const bool isq = it < TX; const int row = isq ? it : it - TX;
                const bf16_t* bsrc = isq ? BF(WS_QB) + (size_t)row * 1536 + h * 96 : BF(WS_KRAW) + (size_t)row * 1024 + h * 64;
                const float* kper = FP(WS_KPE) + (size_t)row * 32;
                const float* gn = isq ? KIN(I_MQN) : KIN(I_MKN);
                float v[3][8]; float ss = 0.f;
#pragma unroll
                for (int j = 0; j < 3; ++j) { const int d0 = 8 * (3 * q + j); const bool frombf = isq || d0 < 64;
                    const int db = frombf ? d0 : 0, dk = frombf ? 0 : d0 - 64;
                    const u32x4 raw = __builtin_nontemporal_load((const u32x4*)(bsrc + db)); const f32x4 t0 = *(const f32x4*)(kper + dk), t1 = *(const f32x4*)(kper + dk + 4);
                    v[j][0] = frombf ? __uint_as_float(raw.x << 16) : t0[0]; v[j][1] = frombf ? __uint_as_float(raw.x & 0xffff0000u) : t0[1];
                    v[j][2] = frombf ? __uint_as_float(raw.y << 16) : t0[2]; v[j][3] = frombf ? __uint_as_float(raw.y & 0xffff0000u) : t0[3];
                    v[j][4] = frombf ? __uint_as_float(raw.z << 16) : t1[0]; v[j][5] = frombf ? __uint_as_float(raw.z & 0xffff0000u) : t1[1];
                    v[j][6] = frombf ? __uint_as_float(raw.w << 16) : t1[2]; v[j][7] = frombf ? __uint_as_float(raw.w & 0xffff0000u) : t1[3];
#pragma unroll
                    for (int e = 0; e < 8; ++e) ss += v[j][e] * v[j][e]; }
                ss += __shfl_xor(ss, 1); ss += __shfl_xor(ss, 2);
                const float rstd = 1.0f / sqrtf(ss * (1.f / 96.f) + EPS);
#pragma unroll
                for (int j = 0; j < 3; ++j) { const int d0 = 8 * (3 * q + j); const f32x4 g0 = *(const f32x4*)(gn + d0), g1 = *(const f32x4*)(gn + d0 + 4);
#pragma unroll
                    for (int e = 0; e < 4; ++e) { v[j][e] *= rstd * g0[e]; v[j][4 + e] *= rstd * g1[e]; } }
                if (row < TX) { const int t = row & 4095; const float pr = (float)(t >> 6), pc = (float)(t & 63);
#pragma unroll
                    for (int e = 0; e < 8; ++e) { const float invf = exp2f(-(float)e * (13.287712379549449f / 8.f));
                        const float rr_ = pr * invf * 0.15915494309189535f, rc_ = pc * invf * 0.15915494309189535f;
                        const float sr = __builtin_amdgcn_sinf(rr_), cr = __builtin_amdgcn_cosf(rr_), sc_ = __builtin_amdgcn_sinf(rc_), cc = __builtin_amdgcn_cosf(rc_);
                        const float send = (q == 2) ? v[2][e] : v[0][e]; const float recv = __shfl_xor(send, 1);
                        if (q == 2) v[2][e] = v[2][e] * cr - recv * sr;
                        if (q == 3) { v[0][e] = recv * sr + v[0][e] * cr; const float b1 = v[1][e], b2 = v[2][e]; v[1][e] = b1 * cc - b2 * sc_; v[2][e] = b1 * sc_ + b2 * cc; } } }
                const float osc = isq ? att::QSCALE : 1.f;
                bf16_t* dst = (isq ? BF(WS_QB) : BF(WS_KB)) + (size_t)row * 1536 + h * 96;
#pragma unroll
                for (int j = 0; j < 3; ++j) { const int d0 = 8 * (3 * q + j); u32x4 w; w.x = cvt_pk_bf16(v[j][0] * osc, v[j][1] * osc); w.y = cvt_pk_bf16(v[j][2] * osc, v[j][3] * osc);
                    w.z = cvt_pk_bf16(v[j][4] * osc, v[j][5] * osc); w.w = cvt_pk_bf16(v[j][6] * osc, v[j][7] * osc); *(u32x4*)(dst + d0) = w; }
            }
        }
        else if (PHASE(15)) {
            const int vcu = (G % 8 == 0) ? (bid % 8) * (G / 8) + bid / 8 : bid;
            const int per = (2048 + G - 1) / G;
            int tid3 = tid; asm volatile("" : "+v"(tid3));
            for (int k = 0; k < per; ++k) {
                int un = vcu * per + k;
                if (G == 256) {
                    const int xcd = vcu >> 5, loc = vcu & 31; un = ((xcd * 16 + 2 * k + (loc >> 4)) << 4) | (loc & 15); }
                if (un >= 2048) break;
                const int bh = un >> 4, qb = un & 15;
                att::attn_unit(bh >> 4, bh & 15, qb, BF(WS_QB), BF(WS_KB), BF(WS_VB), BF(WS_OB), lds, tid3, KIN(I_MQN)); }
        }
        else if (PHASE(17)) {
            modnorm_rows(FP(WS_XR), FP(WS_XR) + (size_t)TX * DM, TX, KIN(I_NORM2) + 1024, mod + 9 * 6144 + 3 * 1024, mod + 9 * 6144 + 4 * 1024, BF(WS_HX), gw, NGW, lane);
        }
        if (ph + 1 < ph_hi) { __syncthreads(); if (HI == 1) cg::this_grid().sync(); else { ++nbar; grid_barrier((unsigned*)(ws + WS_BAR), nbar * (unsigned)G, tid); } }
        if (DUP_PH >= 0 && ph == DUP_PH && dup_left > 0) { --dup_left; --ph; }
    }
}
#undef PHASE
#undef BF
#undef FP
__global__ void __launch_bounds__(NTHREADS, 2) mega(Args a) {
    extern __shared__ __attribute__((aligned(16))) unsigned char lds_raw[];
    LAS unsigned char* lds = (LAS unsigned char*)lds_raw;
    const int G = gridDim.x;
    const int ph_lo = a.ph_lo, ph_hi = a.ph_hi;
    const int wave0 = __builtin_amdgcn_readfirstlane((int)threadIdx.x >> 6);
    unsigned nbar = 0;
    run_phases<0, 1>(lds, ph_lo, ph_hi, G, wave0, nbar);
    run_phases<1, 10>(lds, ph_lo, ph_hi, G, wave0, nbar);
    run_phases<10, 20>(lds, ph_lo, ph_hi, G, wave0, nbar);
}

extern "C" void kernel_launch(void* const* d_in, const int* in_sizes, int n_in, void* d_out, int out_size, void* d_ws, size_t ws_size, hipStream_t stream) {
    static int grid = 0;
    if (grid == 0) {
        if (n_in != 33 || ws_size < WS_END) { fprintf(stderr, "kernel_launch: need 33 inputs and >= %zu bytes of workspace; got %d, %zu\n", (size_t)WS_END, n_in, ws_size); grid = -1; return; }
        int dev = 0, cus = 0, per_cu = 0;
        hipGetDevice(&dev); hipDeviceGetAttribute(&cus, hipDeviceAttributeMultiprocessorCount, dev);
        if (hipFuncSetAttribute((const void*)mega, hipFuncAttributeMaxDynamicSharedMemorySize, LDS_BYTES) != hipSuccess) { fprintf(stderr, "kernel_launch: hipFuncSetAttribute failed\n"); grid = -1; return; }
        hipOccupancyMaxActiveBlocksPerMultiprocessor(&per_cu, (const void*)mega, NTHREADS, LDS_BYTES);
        if (per_cu < 1) { fprintf(stderr, "kernel_launch: occupancy query says %d blocks per CU\n", per_cu); per_cu = 1; }
        (void)hipGetLastError();
        grid = cus;
    }
    if (grid < 0) return;
    Args a{};
    for (int i = 0; i < 33; ++i) a.in[i] = (const float*)d_in[i];
    a.out = (float*)d_out; a.ws = (unsigned char*)d_ws;
#if MK_COOP
    (void)hipMemsetAsync((char*)d_ws + WS_BAR, 0, 256, stream);
    a.ph_lo = 0; a.ph_hi = NPH;
    void* args[] = {&a};
    hipError_t e = hipLaunchCooperativeKernel((const void*)mega, dim3(grid), dim3(NTHREADS), args, LDS_BYTES, stream);
    if (e != hipSuccess) fprintf(stderr, "cooperative launch failed: %s (grid %d)\n", hipGetErrorString(e), grid);
#else
#ifndef NPH_RUN
#define NPH_RUN NPH
#endif
    for (int ph = 0; ph < NPH_RUN; ++ph) { a.ph_lo = ph; a.ph_hi = ph + 1;
        hipLaunchKernelGGL(mega, dim3(grid), dim3(NTHREADS), LDS_BYTES, stream, a); }
#endif
}
```

```cpp
#include <hip/hip_runtime.h>
#include <hip/hip_cooperative_groups.h>
#include <cstdio>
#include <cstdint>
namespace cg = cooperative_groups;

#ifndef MK_COOP
#define MK_COOP 1
#endif

#define LAS __attribute__((address_space(3)))
#define DEV __device__ __forceinline__
typedef unsigned short bf16_t;
typedef short bf16x8 __attribute__((ext_vector_type(8)));
typedef short s16x4 __attribute__((ext_vector_type(4)));
typedef float f32x4 __attribute__((ext_vector_type(4)));
typedef float f32x2 __attribute__((ext_vector_type(2)));
typedef float f32x16 __attribute__((ext_vector_type(16)));
typedef unsigned u32x4 __attribute__((ext_vector_type(4)));
typedef unsigned u32x2 __attribute__((ext_vector_type(2)));

constexpr int DM = 1024, NB = 8, SEQ = 4096, CTXL = 256;
constexpr int TX = NB * SEQ, TC = NB * CTXL, TT = TX + TC;
constexpr int DFF = 2816;
constexpr float EPS = 1e-6f;
constexpr int NPH = 20;
constexpr int NTHREADS = 512;
constexpr int RING_BYTES = 131072, MISC_OFF = RING_BYTES, LDS_BYTES = 147456;

constexpr size_t MiB = (size_t)1 << 20;
constexpr size_t WS_MOD = 0;
constexpr size_t WS_H3X = 1 * MiB, WS_H3C = 2 * MiB;
constexpr size_t WS_SMALL = 2 * MiB + 512 * 1024;
constexpr size_t WS_W = 4 * MiB;
constexpr size_t W_W1T = WS_W, W_WOUT = WS_W + 5 * MiB, W_WUP = WS_W + 7 * MiB, W_WDOWN = WS_W + 18 * MiB;
constexpr size_t W_MLAIN = WS_W, W_WUQ = WS_W + 1 * MiB, W_WUKV = WS_W + 2 * MiB, W_WO = WS_W + 3 * MiB;
constexpr size_t WS_XR = 28 * MiB;
constexpr size_t WS_PQT = 28 * MiB, WS_PQTC = 92 * MiB, WS_WT = 96 * MiB, WS_WTC = 128 * MiB, WS_X0C = 130 * MiB, WS_X0CC = 162 * MiB;
constexpr size_t WS_HX = 164 * MiB;
constexpr size_t WS_BIG = 232 * MiB;
constexpr size_t WS_T1 = 232 * MiB, WS_T2 = 296 * MiB, WS_HT = 360 * MiB, WS_HTC = 456 * MiB, WS_KF = 462 * MiB, WS_KFC = 494 * MiB;
constexpr size_t WS_FILT = 496 * MiB, WS_FILTC = 504 * MiB, WS_T1C = 505 * MiB, WS_CSC = 505 * MiB + 512 * 1024;
constexpr size_t WS_YT = WS_HT, WS_YTC = WS_HTC;
constexpr size_t WS_ACT = 232 * MiB;
constexpr size_t WS_SB = 420 * MiB;
constexpr size_t WS_SSQ2 = 2 * MiB + 512 * 1024;
constexpr size_t WS_ABUF = 232 * MiB, WS_KRAW = 232 * MiB, WS_OB = 232 * MiB, WS_AQN = 300 * MiB, WS_CKVN = 316 * MiB, WS_KB = 300 * MiB, WS_KPE = 402 * MiB, WS_QB = 416 * MiB;
constexpr size_t WS_VB = WS_HX;
constexpr size_t WS_END = 512 * MiB;

DEV unsigned cvt_pk_bf16(float lo, float hi) { unsigned r; asm volatile("v_cvt_pk_bf16_f32 %0, %1, %2" : "=v"(r) : "v"(lo), "v"(hi)); return r; }
DEV float bf2f(unsigned short h) { return __uint_as_float(((unsigned)h) << 16); }
DEV float wave_sum(float v) {
#pragma unroll
    for (int o = 1; o < 64; o <<= 1) v += __shfl_xor(v, o);
    return v;
}
DEV float silu_f(float x) { return x / (1.f + __expf(-x)); }

namespace pg8 {
constexpr int BM = 256, BK = 64, HALF = 128, HTB = HALF * BK * 2, STAGE_BYTES = 8 * HTB;
__host__ __device__ __forceinline__ int lds_byte(int r, int c) { const int st = (r >> 4) * 2 + (c >> 5), rr = r & 15, cc = c & 31, ob = rr * 64 + cc * 2; return st * 1024 + (ob ^ (((ob >> 9) & 1) << 5)); }
__host__ __device__ __forceinline__ void stage_rc(int b, int& R, int& C) { const int st = b / 1024, sb = b % 1024, swz = sb ^ (((sb >> 9) & 1) << 5); R = (st >> 1) * 16 + swz / 64; C = (st & 1) * 32 + (swz % 64) / 2; }
__host__ __device__ __forceinline__ int perm32(int rho) { const int n = rho >> 4, i = rho & 15; return 8 * (i >> 2) + 4 * n + (i & 3); }

struct Unit { int pm, pn, pz; long arow, brow; };
struct Gemm { const bf16_t* A; const bf16_t* Bt; int lda, ldb, K; long sAz, sBz; };

struct Sched {
    int nM, nN, nZ, G, c, mode;
    DEV bool next(int i, Unit& u) const {
        const long L = (long)i * G + c; const int per = nM * nN; if (L >= (long)per * nZ) return false;
        u.pz = (int)(L / per); int wgid = (int)(L % per);
        { const int q = per / 8, r = per % 8, xcd = wgid % 8, off = wgid / 8; wgid = (xcd < r ? xcd * (q + 1) : r * (q + 1) + (xcd - r) * q) + off; }
        const int nig = 8 * nN, gid = wgid / nig, fm = gid * 8, gsz = (nM - fm) < 8 ? (nM - fm) : 8;
        u.pm = fm + ((wgid % nig) % gsz); u.pn = (wgid % nig) / gsz;
        u.brow = (long)u.pn * 256;
        u.arow = (long)u.pm * 256;
        return true;
    }
};

template <class Epi>
DEV void gemm_phase(LAS unsigned char* lds, const Gemm g, const Sched& S, const Epi& E, const int tid) {
    const int wid = __builtin_amdgcn_readfirstlane(tid >> 6), lane = tid & 63, wr = wid >> 2, wc = wid & 3, fr = lane & 15, fq = lane >> 4;
    const int K = g.K, nt = K / BK;
    unsigned voffA[2], voffB[2];
#pragma unroll
    for (int i = 0; i < 2; ++i) { int R, C; stage_rc(tid * 16 + i * 8192, R, C); const int Rb = Epi::PERM ? ((R & ~31) + perm32(R & 31)) : R;
        voffA[i] = (unsigned)(R * g.lda + C) * 2u; voffB[i] = (unsigned)(Rb * g.ldb + C) * 2u; }
    const size_t kstep = (size_t)(BK * 2);
    const size_t hstepA = (size_t)HALF * g.lda * 2, hstepB = (size_t)HALF * g.ldb * 2;
    const unsigned ldsw = (unsigned)wid * 1024u;
    const int aoff = lds_byte(wr * 64 + fr, fq * 8), boff = lds_byte(wc * 32 + fr, fq * 8);
#define PG8_SA(b, h) (((b) * 2 + (h)) * HTB)
#define PG8_SB(b, h) ((4 + (b) * 2 + (h)) * HTB)
#define PG8_STAGE(bufoff, gbase, voff) do { _Pragma("unroll") for (int _i = 0; _i < 2; ++_i) \
        __builtin_amdgcn_global_load_lds((const unsigned*)((const char*)(gbase) + (voff)[_i]), (LAS unsigned*)(lds + (bufoff) + ldsw + _i * 8192), 16, 0, 0); } while (0)
#define PG8_LDA(dst, b, h) do { _Pragma("unroll") for (int m = 0; m < 4; ++m) _Pragma("unroll") for (int k = 0; k < 2; ++k) dst[m][k] = *(const LAS bf16x8*)(lds + PG8_SA(b, h) + aoff + m * 2048 + k * 1024); } while (0)
#define PG8_LDB(dst, b, h) do { _Pragma("unroll") for (int n = 0; n < 2; ++n) _Pragma("unroll") for (int k = 0; k < 2; ++k) dst[n][k] = *(const LAS bf16x8*)(lds + PG8_SB(b, h) + boff + n * 2048 + k * 1024); } while (0)
#define PG8_MMA(ai, bj, At, Bt) do { __builtin_amdgcn_s_setprio(1); _Pragma("unroll") for (int m = 0; m < 4; ++m) _Pragma("unroll") for (int n = 0; n < 2; ++n) _Pragma("unroll") for (int k = 0; k < 2; ++k) \
        acc[ai][bj][m][n] = __builtin_amdgcn_mfma_f32_16x16x32_bf16(Bt[n][k], At[m][k], acc[ai][bj][m][n], 0, 0, 0); __builtin_amdgcn_s_setprio(0); } while (0)
#define PG8_WAIT_V(n) asm volatile("s_waitcnt vmcnt(" #n ")" ::: "memory")
#define PG8_WAIT_L(n) asm volatile("s_waitcnt lgkmcnt(" #n ")" ::: "memory")
#define PG8_BAR __builtin_amdgcn_s_barrier()
#define PG8_SCHED __builtin_amdgcn_sched_barrier(0)
    Unit cur, nxt; int ui = 0;
    if (!S.next(0, cur)) return;
    f32x4 acc[2][2][4][2];
#pragma unroll
    for (int a = 0; a < 2; ++a)
#pragma unroll
        for (int b = 0; b < 2; ++b)
#pragma unroll
            for (int m = 0; m < 4; ++m)
#pragma unroll
                for (int n = 0; n < 2; ++n) acc[a][b][m][n] = (f32x4){0.f, 0.f, 0.f, 0.f};
    bf16x8 At[4][2], B0[2][2], B1[2][2];
    const char* cA = (const char*)g.A + ((long)cur.pz * g.sAz + cur.arow * (long)g.lda) * 2;
    const char* cB = (const char*)g.Bt + ((long)cur.pz * g.sBz + cur.brow * (long)g.ldb) * 2;
    PG8_STAGE(PG8_SB(0, 0), cB, voffB); PG8_STAGE(PG8_SB(0, 1), cB + hstepB, voffB); PG8_STAGE(PG8_SA(0, 0), cA, voffA); PG8_STAGE(PG8_SA(0, 1), cA + hstepA, voffA);
    if (wr == 1) PG8_BAR;
    PG8_WAIT_V(2); PG8_BAR;
    PG8_STAGE(PG8_SB(1, 0), cB + kstep, voffB); PG8_STAGE(PG8_SA(1, 0), cA + kstep, voffA); PG8_STAGE(PG8_SB(1, 1), cB + hstepB + kstep, voffB);
    PG8_WAIT_V(6); PG8_BAR;
    for (;;) {
        const bool has_next = S.next(ui + 1, nxt);
        const char* nA = has_next ? (const char*)g.A + ((long)nxt.pz * g.sAz + nxt.arow * (long)g.lda) * 2 : cA;
        const char* nB = has_next ? (const char*)g.Bt + ((long)nxt.pz * g.sBz + nxt.brow * (long)g.ldb) * 2 : cB;
        for (int t = 0; t < nt; t += 2) {
            const bool last = (t == nt - 2);
            const char* a1 = cA + (size_t)(t + 1) * kstep;
            const char* a2 = last ? nA : cA + (size_t)(t + 2) * kstep; const char* b2 = last ? nB : cB + (size_t)(t + 2) * kstep;
            const char* a3 = a2 + kstep; const char* b3 = b2 + kstep;
            PG8_LDB(B0, 0, 0); PG8_LDB(B1, 0, 1); PG8_SCHED; PG8_LDA(At, 0, 0); PG8_STAGE(PG8_SA(1, 1), a1 + hstepA, voffA);
            PG8_WAIT_V(8); PG8_WAIT_L(0); PG8_BAR; PG8_MMA(0, 0, At, B0); PG8_MMA(0, 1, At, B1); PG8_BAR; PG8_SCHED;
            PG8_LDA(At, 0, 1); PG8_STAGE(PG8_SB(0, 0), b2, voffB); PG8_STAGE(PG8_SB(0, 1), b2 + hstepB, voffB); PG8_STAGE(PG8_SA(0, 0), a2, voffA);
            PG8_WAIT_V(8); PG8_WAIT_L(0); PG8_BAR; PG8_MMA(1, 0, At, B0); PG8_MMA(1, 1, At, B1); PG8_BAR; PG8_SCHED;
            PG8_LDB(B0, 1, 0); PG8_LDB(B1, 1, 1); PG8_SCHED; PG8_LDA(At, 1, 0); PG8_STAGE(PG8_SA(0, 1), a2 + hstepA, voffA);
            PG8_WAIT_V(8); PG8_WAIT_L(0); PG8_BAR; PG8_MMA(0, 0, At, B0); PG8_MMA(0, 1, At, B1); PG8_BAR; PG8_SCHED;
            PG8_LDA(At, 1, 1); PG8_STAGE(PG8_SB(1, 0), b3, voffB); PG8_STAGE(PG8_SB(1, 1), b3 + hstepB, voffB); PG8_STAGE(PG8_SA(1, 0), a3, voffA);
            PG8_WAIT_V(8); PG8_WAIT_L(0); PG8_BAR; PG8_MMA(1, 0, At, B0); PG8_MMA(1, 1, At, B1); PG8_BAR; PG8_SCHED;
        }
        if (wr == 0) PG8_BAR;
        E(acc, cur, wr, wc, fr, fq, lds + MISC_OFF);
        if (!has_next) break;
#pragma unroll
        for (int a = 0; a < 2; ++a)
#pragma unroll
            for (int b = 0; b < 2; ++b)
#pragma unroll
                for (int m = 0; m < 4; ++m)
#pragma unroll
                    for (int n = 0; n < 2; ++n) acc[a][b][m][n] = (f32x4){0.f, 0.f, 0.f, 0.f};
        cur = nxt; cA = nA; cB = nB; ++ui;
        if (wr == 1) PG8_BAR;
    }
    PG8_WAIT_V(0);
    PG8_BAR;
#undef PG8_SA
#undef PG8_SB
#undef PG8_STAGE
#undef PG8_LDA
#undef PG8_LDB
#undef PG8_MMA
}

typedef f32x4 Acc[2][2][4][2];

struct EpiG1 {
    static constexpr bool PERM = true;
    bf16_t* PQt; bf16_t* Ht; bf16_t* PQtc; bf16_t* Htc;
    DEV void operator()(const Acc& acc, const Unit& u, int wr, int wc, int fr, int fq, LAS unsigned char*) const {
        const bool isx = u.pn < 128; const int b = isx ? (u.pn >> 4) : (u.pn - 128); const int tb = isx ? ((u.pn & 15) * 256) : 0;
#pragma unroll
        for (int ai = 0; ai < 2; ++ai)
#pragma unroll
            for (int m = 0; m < 4; ++m) {
                const int mrow = u.pm * 256 + ai * 128 + wr * 64 + m * 16 + fr;
                bf16_t* rowp;
                if (mrow < 1024) { const int nf = mrow >> 1, part = mrow & 1;
                    rowp = isx ? PQt + ((size_t)(b * 512 + nf) * 8192 + part * 4096) : PQtc + ((size_t)(b * 512 + nf) * 512 + part * 256); }
                else { const int cp = mrow - 1024; rowp = isx ? Ht + (size_t)(b * 1536 + cp) * 4096 : Htc + (size_t)(b * 1536 + cp) * 256; }
#pragma unroll
                for (int bj = 0; bj < 2; ++bj) { const int t0 = tb + bj * 128 + wc * 32 + 8 * fq;
                    const f32x4 v0 = acc[ai][bj][m][0], v1 = acc[ai][bj][m][1]; u32x4 w;
                    w.x = cvt_pk_bf16(v0[0], v0[1]); w.y = cvt_pk_bf16(v0[2], v0[3]); w.z = cvt_pk_bf16(v1[0], v1[1]); w.w = cvt_pk_bf16(v1[2], v1[3]);
                    *(u32x4*)(rowp + t0) = w; }
                asm volatile("" ::: "memory");
            }
    }
};
struct EpiBf16 {
    static constexpr bool PERM = true;
    bf16_t* O0; bf16_t* O1; int ldc, split, rowbase, zrows; float scale; const float* rs; int rsi; float rsdiv;
    DEV void operator()(const Acc& acc, const Unit& u, int wr, int wc, int fr, int fq, LAS unsigned char*) const {
        asm volatile("" : "+v"(fr), "+v"(fq));
        int colt = u.pn * 256; bf16_t* base = O0; if (split && colt >= split) { base = O1; colt -= split; }
        const int row0 = rowbase + u.pz * zrows + u.pm * 256 + wr * 64 + fr, col0 = colt + wc * 32 + 8 * fq;
#pragma unroll
        for (int ai = 0; ai < 2; ++ai)
#pragma unroll
            for (int m = 0; m < 4; ++m) { const int row = row0 + ai * 128 + m * 16; bf16_t* rowp = base + (size_t)row * ldc + col0;
                const float sc = rs ? scale / sqrtf(rs[(size_t)row * 2 + rsi] * rsdiv + EPS) : scale;
#pragma unroll
                for (int bj = 0; bj < 2; ++bj) { const f32x4 v0 = acc[ai][bj][m][0] * sc, v1 = acc[ai][bj][m][1] * sc; u32x4 w;
                    w.x = cvt_pk_bf16(v0[0], v0[1]); w.y = cvt_pk_bf16(v0[2], v0[3]); w.z = cvt_pk_bf16(v1[0], v1[1]); w.w = cvt_pk_bf16(v1[2], v1[3]);
                    *(u32x4*)(rowp + bj * 128) = w; } }
    }
};
struct EpiF32 {
    static constexpr bool PERM = false;
    float* O; int ldc;
    DEV void operator()(const Acc& acc, const Unit& u, int wr, int wc, int fr, int fq, LAS unsigned char*) const {
        const int row0 = u.pm * 256 + wr * 64 + fr, col0 = u.pn * 256 + wc * 32 + 4 * fq;
#pragma unroll
        for (int ai = 0; ai < 2; ++ai)
#pragma unroll
            for (int m = 0; m < 4; ++m) { float* rowp = O + (size_t)(row0 + ai * 128 + m * 16) * ldc + col0;
#pragma unroll
                for (int bj = 0; bj < 2; ++bj)
#pragma unroll
                    for (int n = 0; n < 2; ++n) *(f32x4*)(rowp + bj * 128 + n * 16) = acc[ai][bj][m][n]; }
    }
};
struct EpiMla {
    static constexpr bool PERM = false;
    bf16_t* aqn; bf16_t* ckvn; float* kpe; float* ssq; const float* gq; const float* gk;
    DEV void operator()(const Acc& acc, const Unit& u, int wr, int wc, int fr, int fq, LAS unsigned char* misc) const {
        asm volatile("" : "+v"(fr), "+v"(fq));
        const int rt = u.pm * 256; const bool isq = (u.pn == 0);
#pragma unroll
        for (int ai = 0; ai < 2; ++ai)
#pragma unroll
            for (int m = 0; m < 4; ++m) { const int rl = ai * 128 + wr * 64 + m * 16 + fr, row = rt + rl; float sq = 0.f;
#pragma unroll
                for (int bj = 0; bj < 2; ++bj)
#pragma unroll
                    for (int n = 0; n < 2; ++n) { const int c = bj * 128 + wc * 32 + n * 16 + 4 * fq; const f32x4 a = acc[ai][bj][m][n];
                        if (isq) { sq += (a[0] * a[0] + a[1] * a[1]) + (a[2] * a[2] + a[3] * a[3]);
                            if (row < TX) { const f32x4 g = *(const f32x4*)(gq + c); u32x2 w; w.x = cvt_pk_bf16(a[0] * g[0], a[1] * g[1]); w.y = cvt_pk_bf16(a[2] * g[2], a[3] * g[3]); *(u32x2*)(aqn + (size_t)row * 256 + c) = w; } }
                        else if (bj == 0) { sq += (a[0] * a[0] + a[1] * a[1]) + (a[2] * a[2] + a[3] * a[3]);
                            const f32x4 g = *(const f32x4*)(gk + c); u32x2 w; w.x = cvt_pk_bf16(a[0] * g[0], a[1] * g[1]); w.y = cvt_pk_bf16(a[2] * g[2], a[3] * g[3]); *(u32x2*)(ckvn + (size_t)row * 128 + c) = w; }
                        else if (wc == 0) { *(f32x4*)(kpe + (size_t)row * 32 + n * 16 + 4 * fq) = a; } }
                sq += __shfl_xor(sq, 16); sq += __shfl_xor(sq, 32); if (fq == 0) ((LAS float*)misc)[rl * 4 + wc] = sq;
                if (m & 1) asm volatile("" ::: "memory"); }
        asm volatile("s_waitcnt lgkmcnt(0)" ::: "memory"); __builtin_amdgcn_s_barrier(); asm volatile("" ::: "memory");
        const int t_ = (wr * 4 + wc) * 64 + fq * 16 + fr;
        if (t_ < 256) { const f32x4 p4 = *(const LAS f32x4*)((LAS float*)misc + t_ * 4); ssq[(size_t)(rt + t_) * 2 + u.pn] = (p4[0] + p4[1]) + (p4[2] + p4[3]); }
        asm volatile("s_waitcnt lgkmcnt(0)" ::: "memory"); __builtin_amdgcn_s_barrier(); asm volatile("" ::: "memory");
    }
};
struct EpiRes {
    static constexpr bool PERM = false;
    const float* baseX; const float* baseC; float* outX; float* outC; const float* gate;
    DEV void operator()(const Acc& acc, const Unit& u, int wr, int wc, int fr, int fq, LAS unsigned char*) const {
        asm volatile("" : "+v"(fr), "+v"(fq));
        const int rt = u.pm * 256; const bool isx = rt < TX; const int mr = isx ? (rt >> 12) : 8;
        const float* bp = isx ? baseX + (size_t)rt * DM : baseC + (size_t)(rt - TX) * DM;
        float* op = isx ? outX + (size_t)rt * DM : outC + (size_t)(rt - TX) * DM;
        const int col0 = u.pn * 256 + wc * 32 + 4 * fq; const float* gp = gate + (size_t)mr * 6144 + col0;
        f32x4 gv[2][2];
#pragma unroll
        for (int bj = 0; bj < 2; ++bj)
#pragma unroll
            for (int n = 0; n < 2; ++n) gv[bj][n] = *(const f32x4*)(gp + bj * 128 + n * 16);
#pragma unroll
        for (int ai = 0; ai < 2; ++ai)
#pragma unroll
            for (int m = 0; m < 4; ++m) { const size_t off = (size_t)(ai * 128 + wr * 64 + m * 16 + fr) * DM + col0;
#pragma unroll
                for (int bj = 0; bj < 2; ++bj)
#pragma unroll
                    for (int n = 0; n < 2; ++n) { const f32x4 bs = *(const f32x4*)(bp + off + bj * 128 + n * 16);
                        *(f32x4*)(op + off + bj * 128 + n * 16) = bs + gv[bj][n] * acc[ai][bj][m][n]; }
                if (m & 1) asm volatile("" ::: "memory"); }
    }
};
struct EpiHF {
    static constexpr bool PERM = false;
    bf16_t* Yt; const float* KF; const float* l1inv; int Nh;
    DEV void operator()(const Acc& acc, const Unit& u, int wr, int wc, int fr, int fq, LAS unsigned char*) const {
        const int ldk = 2 * Nh; const float wN = 1.0f / (float)(2 * Nh);
#pragma unroll
        for (int ai = 0; ai < 2; ++ai)
#pragma unroll
            for (int m = 0; m < 4; ++m) { const int r = u.pm * 256 + ai * 128 + wr * 64 + m * 16 + fr, c = r & 511; const float s = l1inv[c] * wN;
                const float* k1p = KF + (size_t)c * ldk; const float* k2p = KF + (size_t)(512 + c) * ldk; bf16_t* yp = Yt + (size_t)r * ldk;
#pragma unroll
                for (int bj = 0; bj < 2; ++bj)
#pragma unroll
                    for (int n = 0; n < 2; ++n) { const int c0 = u.pn * 256 + bj * 128 + wc * 32 + n * 16 + 4 * fq, f0 = c0 >> 1;
                        const f32x4 k1 = *(const f32x4*)(k1p + c0), k2 = *(const f32x4*)(k2p + c0), a = acc[ai][bj][m][n];
                        const float kr0 = k1[0] + k2[0], ki0 = k1[1] - k2[1], kr1 = k1[2] + k2[2], ki1 = k1[3] - k2[3];
                        const float w0 = (c0 == 0) ? s : 2.f * s, w1 = 2.f * s;
                        const float yr0 = (a[0] * kr0 - a[1] * ki0) * w0, yi0 = (a[0] * ki0 + a[1] * kr0) * w0;
                        const float yr1 = (a[2] * kr1 - a[3] * ki1) * w1, yi1 = (a[2] * ki1 + a[3] * kr1) * w1;
                        *(unsigned*)(yp + f0) = cvt_pk_bf16(yr0, yr1); *(unsigned*)(yp + Nh + f0) = cvt_pk_bf16(yi0, yi1); }
                asm volatile("" ::: "memory"); }
    }
};
struct EpiHI {
    static constexpr bool PERM = false;
    bf16_t* ycat; const bf16_t* Wt; const bf16_t* x0c; const float* ynq; const float* bias; int L, rowbase;
    DEV void operator()(const Acc& acc, const Unit& u, int wr, int wc, int fr, int fq, LAS unsigned char*) const {
#pragma unroll
        for (int ai = 0; ai < 2; ++ai)
#pragma unroll
            for (int m = 0; m < 4; ++m) { const int r = u.pm * 256 + ai * 128 + wr * 64 + m * 16 + fr, b = r >> 9, c = r & 511; const float ny = ynq[r], bs = bias[c];
                const bf16_t* wp = Wt + (size_t)r * L; const bf16_t* xp = x0c + (size_t)r * L;
                bf16_t* op = ycat + (size_t)(rowbase + b * L) * DM + 512 + c;
#pragma unroll
                for (int bj = 0; bj < 2; ++bj)
#pragma unroll
                    for (int n = 0; n < 2; ++n) { const int t0 = u.pn * 256 + bj * 128 + wc * 32 + n * 16 + 4 * fq;
                        const u32x2 wv = *(const u32x2*)(wp + t0), xv = *(const u32x2*)(xp + t0); const f32x4 a = acc[ai][bj][m][n];
                        const float w0 = __uint_as_float(wv.x << 16), w1 = __uint_as_float(wv.x & 0xffff0000u), w2 = __uint_as_float(wv.y << 16), w3 = __uint_as_float(wv.y & 0xffff0000u);
                        const float x0 = __uint_as_float(xv.x << 16), x1 = __uint_as_float(xv.x & 0xffff0000u), x2 = __uint_as_float(xv.y << 16), x3 = __uint_as_float(xv.y & 0xffff0000u);
                        const float y0 = x0 * (a[0] + ny + w0 * bs), y1 = x1 * (a[1] - ny + w1 * bs), y2 = x2 * (a[2] + ny + w2 * bs), y3 = x3 * (a[3] - ny + w3 * bs);
                        const unsigned p01 = cvt_pk_bf16(y0, y1), p23 = cvt_pk_bf16(y2, y3);
                        op[(size_t)(t0 + 0) * DM] = (bf16_t)(p01 & 0xffffu); op[(size_t)(t0 + 1) * DM] = (bf16_t)(p01 >> 16);
                        op[(size_t)(t0 + 2) * DM] = (bf16_t)(p23 & 0xffffu); op[(size_t)(t0 + 3) * DM] = (bf16_t)(p23 >> 16); }
                asm volatile("" ::: "memory"); }
    }
};
struct EpiFFN {
    static constexpr bool PERM = true;
    bf16_t* act; const float* cw; const float* cb; float* sb;
    DEV void operator()(const Acc& acc, const Unit& u, int wr, int wc, int fr, int fq, LAS unsigned char* misc) const {
        asm volatile("" : "+v"(fr), "+v"(fq));
        const int lane = fq * 16 + fr;
        const int sbase = u.pm * 256, s0 = 0;
        float* sbp = sb + (size_t)u.pm * 6 * DFF;
        LAS float* xl = (LAS float*)misc;
        LAS float* xf = xl + 512;
#pragma unroll
        for (int ai = 0; ai < 2; ++ai) { const int q = 2 * ai + wr;
#pragma unroll
            for (int n = 0; n < 2; ++n) { const int cc = wc * 32 + 8 * fq + 4 * n;
                if (fr == 15) *(LAS f32x4*)(xl + q * 128 + cc) = acc[ai][0][3][n];
                if (fr == 0) *(LAS f32x4*)(xf + q * 128 + cc) = acc[ai][0][0][n]; } }
        asm volatile("s_waitcnt lgkmcnt(0)" ::: "memory"); __builtin_amdgcn_s_barrier(); asm volatile("" ::: "memory");
#define ROR1(x) __int_as_float(__builtin_amdgcn_update_dpp(0, __float_as_int(x), 0x121, 0xf, 0xf, false))
#define ROR15(x) __int_as_float(__builtin_amdgcn_update_dpp(0, __float_as_int(x), 0x12F, 0xf, 0xf, false))
#pragma unroll
        for (int n = 0; n < 2; ++n) { const int cc = wc * 32 + 8 * fq + 4 * n, j = u.pn * 128 + cc;
            const f32x4 w0 = *(const f32x4*)(cw + j), w1 = *(const f32x4*)(cw + DFF + j), w2 = *(const f32x4*)(cw + 2 * DFF + j), bb = *(const f32x4*)(cb + j);
#pragma unroll
            for (int ai = 0; ai < 2; ++ai) { const int q = 2 * ai + wr;
                const f32x4 bup = (q > 0) ? *(LAS f32x4*)(xl + (q - 1) * 128 + cc) : (f32x4){0.f, 0.f, 0.f, 0.f};
                const f32x4 bdn = (q < 3) ? *(LAS f32x4*)(xf + (q + 1) * 128 + cc) : (f32x4){0.f, 0.f, 0.f, 0.f};
                f32x4 Rprev = bup, Dcur;
#pragma unroll
                for (int e = 0; e < 4; ++e) Dcur[e] = ROR15(acc[ai][0][0][n][e]);
#pragma unroll
                for (int m = 0; m < 4; ++m) {
                    f32x4 Rm, Dnext = bdn;
#pragma unroll
                    for (int e = 0; e < 4; ++e) { Rm[e] = ROR1(acc[ai][0][m][n][e]); if (m < 3) Dnext[e] = ROR15(acc[ai][0][m < 3 ? m + 1 : 3][n][e]); }
                    const f32x4 up = (fr > 0) ? Rm : Rprev;
                    const f32x4 dn = (fr < 15) ? Dcur : Dnext;
                    Rprev = Rm; Dcur = Dnext;
                    const int rr = q * 64 + m * 16 + fr, sq = s0 + rr;
                    const f32x4 g = acc[ai][0][m][n], v = acc[ai][1][m][n];
                    f32x4 o;
#pragma unroll
                    for (int e = 0; e < 4; ++e) { const float z = w0[e] * up[e] + w1[e] * g[e] + w2[e] * dn[e] + bb[e]; o[e] = z * __builtin_amdgcn_rcpf(1.f + __builtin_amdgcn_exp2f(-1.4426950408889634f * z)) * v[e]; }
                    if (rr >= 1 && rr <= 254) { u32x2 w; w.x = cvt_pk_bf16(o[0], o[1]); w.y = cvt_pk_bf16(o[2], o[3]);
                        *(u32x2*)(act + (size_t)(sbase + sq) * DFF + j) = w; }
                    if (rr < 2 || rr > 253) { const int rid = rr < 2 ? rr : rr - 252; *(f32x4*)(sbp + (size_t)rid * DFF + j) = g;
                        if (rr == 0 || rr == 255) *(f32x4*)(sbp + (size_t)(4 + (rr == 255)) * DFF + j) = v; }
                }
                asm volatile("" ::: "memory");
            } }
#undef ROR1
#undef ROR15
    }
};
}

namespace att {
constexpr int KST = 12288, VST = 8192, STG = KST + VST;
constexpr int OFF_WS = 2 * STG;
constexpr int NT = 68;
constexpr float QSCALE = 0.10206207261596577f * 1.4426950408889634f;
DEV int crow(int r, int hi) { return (r & 3) + 8 * (r >> 2) + 4 * hi; }
DEV unsigned cvtpk(float lo, float hi) { return cvt_pk_bf16(lo, hi); }
DEV void pv(f32x16* o, int vb, bf16x8 pa0, bf16x8 pa1, bf16x8 pa2, bf16x8 pa3) {
#pragma unroll
    for (int d0 = 0; d0 < 2; ++d0) { s16x4 lo[4], hi[4];
#pragma unroll
        for (int ks = 0; ks < 4; ++ks) {
            asm volatile("ds_read_b64_tr_b16 %0,%1 offset:%c2" : "=&v"(lo[ks]) : "v"(vb), "i"(d0 * 4096 + ks * 1024) : "memory");
            asm volatile("ds_read_b64_tr_b16 %0,%1 offset:%c2" : "=&v"(hi[ks]) : "v"(vb), "i"(d0 * 4096 + ks * 1024 + 512) : "memory"); }
        asm volatile("s_waitcnt lgkmcnt(0)" ::: "memory"); __builtin_amdgcn_sched_barrier(0);
#define PKV(k) (bf16x8){lo[k][0], lo[k][1], lo[k][2], lo[k][3], hi[k][0], hi[k][1], hi[k][2], hi[k][3]}
        o[d0] = __builtin_amdgcn_mfma_f32_32x32x16_bf16(pa0, PKV(0), o[d0], 0, 0, 0);
        o[d0] = __builtin_amdgcn_mfma_f32_32x32x16_bf16(pa1, PKV(1), o[d0], 0, 0, 0);
        o[d0] = __builtin_amdgcn_mfma_f32_32x32x16_bf16(pa2, PKV(2), o[d0], 0, 0, 0);
        o[d0] = __builtin_amdgcn_mfma_f32_32x32x16_bf16(pa3, PKV(3), o[d0], 0, 0, 0);
#undef PKV
    }
}
DEV void pvh(f32x16* o, int vb, bf16x8 pa, bf16x8 pb) {
    s16x4 lo[4], hi[4];
#pragma unroll
    for (int d0 = 0; d0 < 2; ++d0)
#pragma unroll
        for (int kk = 0; kk < 2; ++kk) {
            asm volatile("ds_read_b64_tr_b16 %0,%1 offset:%c2" : "=&v"(lo[d0 * 2 + kk]) : "v"(vb), "i"(d0 * 4096 + kk * 1024) : "memory");
            asm volatile("ds_read_b64_tr_b16 %0,%1 offset:%c2" : "=&v"(hi[d0 * 2 + kk]) : "v"(vb), "i"(d0 * 4096 + kk * 1024 + 512) : "memory"); }
    asm volatile("s_waitcnt lgkmcnt(0)" ::: "memory"); __builtin_amdgcn_sched_barrier(0);
#define PKV(k) (bf16x8){lo[k][0], lo[k][1], lo[k][2], lo[k][3], hi[k][0], hi[k][1], hi[k][2], hi[k][3]}
    o[0] = __builtin_amdgcn_mfma_f32_32x32x16_bf16(pa, PKV(0), o[0], 0, 0, 0);
    o[1] = __builtin_amdgcn_mfma_f32_32x32x16_bf16(pa, PKV(2), o[1], 0, 0, 0);
    o[0] = __builtin_amdgcn_mfma_f32_32x32x16_bf16(pb, PKV(1), o[0], 0, 0, 0);
    o[1] = __builtin_amdgcn_mfma_f32_32x32x16_bf16(pb, PKV(3), o[1], 0, 0, 0);
#undef PKV
}
DEV float max3f(float a, float b, float c) { return fmaxf(fmaxf(a, b), c); }
DEV void attn_unit(int b, int h, int qb, const bf16_t* Q, const bf16_t* K, const bf16_t* V, bf16_t* O, LAS unsigned char* sh, const int tid, const float* qgain) {
    const int lane = tid & 63, r32 = lane & 31, hi = lane >> 5; const int wid = __builtin_amdgcn_readfirstlane(tid >> 6);
    const long qrow0 = (long)b * SEQ + qb * 256 + wid * 32;
    const bf16_t* Qw = Q + qrow0 * 1536 + h * 96;
    const unsigned lds0 = (unsigned)(uintptr_t)sh;
    LAS float* wsf = (LAS float*)(sh + OFF_WS) + wid * 64;
    bf16x8 qr[6];
#pragma unroll
    for (int d0 = 0; d0 < 6; ++d0) qr[d0] = *(const bf16x8*)(Qw + (long)r32 * 1536 + d0 * 16 + hi * 8);
    {
        float qv[6][8]; float ss = 0.f;
#pragma unroll
        for (int d0 = 0; d0 < 6; ++d0) { const u32x4 raw = __builtin_bit_cast(u32x4, qr[d0]);
            qv[d0][0] = __uint_as_float(raw.x << 16); qv[d0][1] = __uint_as_float(raw.x & 0xffff0000u); qv[d0][2] = __uint_as_float(raw.y << 16); qv[d0][3] = __uint_as_float(raw.y & 0xffff0000u);
            qv[d0][4] = __uint_as_float(raw.z << 16); qv[d0][5] = __uint_as_float(raw.z & 0xffff0000u); qv[d0][6] = __uint_as_float(raw.w << 16); qv[d0][7] = __uint_as_float(raw.w & 0xffff0000u);
#pragma unroll
            for (int e = 0; e < 8; ++e) ss += qv[d0][e] * qv[d0][e]; }
        ss += __shfl_xor(ss, 32);
        const float rstd = 1.0f / sqrtf(ss * (1.f / 96.f) + EPS);
#pragma unroll
        for (int d0 = 0; d0 < 6; ++d0) { const f32x4 g0 = *(const f32x4*)(qgain + d0 * 16 + hi * 8), g1 = *(const f32x4*)(qgain + d0 * 16 + hi * 8 + 4);
#pragma unroll
            for (int e = 0; e < 4; ++e) { qv[d0][e] *= rstd * g0[e]; qv[d0][4 + e] *= rstd * g1[e]; } }
        const int tq = qb * 256 + wid * 32 + r32; const float pr = (float)(tq >> 6), pc = (float)(tq & 63);
#pragma unroll
        for (int e = 0; e < 8; ++e) { const float invf = exp2f(-(float)e * (13.287712379549449f / 8.f));
            const float rr_ = pr * invf * 0.15915494309189535f, rc_ = pc * invf * 0.15915494309189535f;
            const float sr = __builtin_amdgcn_sinf(rr_), cr = __builtin_amdgcn_cosf(rr_), sc_ = __builtin_amdgcn_sinf(rc_), cc = __builtin_amdgcn_cosf(rc_);
            const float o4 = qv[4][e], o5 = qv[5][e], p4 = __shfl_xor(o4, 32), p5 = __shfl_xor(o5, 32);
            qv[4][e] = hi ? (p4 * sr + o4 * cr) : (o4 * cr - p4 * sr);
            qv[5][e] = hi ? (p5 * sc_ + o5 * cc) : (o5 * cc - p5 * sc_); }
#pragma unroll
        for (int d0 = 0; d0 < 6; ++d0) { u32x4 w; w.x = cvt_pk_bf16(qv[d0][0] * QSCALE, qv[d0][1] * QSCALE); w.y = cvt_pk_bf16(qv[d0][2] * QSCALE, qv[d0][3] * QSCALE);
            w.z = cvt_pk_bf16(qv[d0][4] * QSCALE, qv[d0][5] * QSCALE); w.w = cvt_pk_bf16(qv[d0][6] * QSCALE, qv[d0][7] * QSCALE); qr[d0] = __builtin_bit_cast(bf16x8, w); }
    }
    u32x4 kreg0, kreg1, vreg;
    const bool k2 = wid < 4;
#define KBASE(t) ((t) < 64 ? (long)b * SEQ + (t) * 64 : (long)TX + b * CTXL + ((t) - 64) * 64)
#define LOADT(t) do { const long kb_ = KBASE(t); \
        kreg0 = *(const u32x4*)(K + (kb_ + lane) * 1536 + h * 96 + wid * 8); \
        if (k2) kreg1 = *(const u32x4*)(K + (kb_ + lane) * 1536 + h * 96 + (8 + wid) * 8); \
        vreg = *(const u32x4*)(V + (kb_ + 16 * (wid & 3) + (lane >> 2)) * 1024 + h * 64 + (wid >> 2) * 32 + (lane & 3) * 8); } while (0)
#define STORET(s) do { LAS unsigned char* st_ = sh + (s) * STG; \
        *(LAS u32x4*)(st_ + wid * 1024 + lane * 16) = kreg0; if (k2) *(LAS u32x4*)(st_ + (8 + wid) * 1024 + lane * 16) = kreg1; \
        *(LAS u32x4*)(st_ + KST + wid * 1024 + lane * 16) = vreg; } while (0)
    float mrun = 0.f, lsum = 0.f; f32x16 o[2]; o[0] = f32x16{}; o[1] = f32x16{}; const f32x16 zero16 = f32x16{};
#define LOADK(t) do { const long kb_ = KBASE(t); kreg0 = *(const u32x4*)(K + (kb_ + lane) * 1536 + h * 96 + wid * 8); \
        if (k2) kreg1 = *(const u32x4*)(K + (kb_ + lane) * 1536 + h * 96 + (8 + wid) * 8); } while (0)
#define LOADV(t) do { const long kb_ = KBASE(t); vreg = *(const u32x4*)(V + (kb_ + 16 * (wid & 3) + (lane >> 2)) * 1024 + h * 64 + (wid >> 2) * 32 + (lane & 3) * 8); } while (0)
#define STOREK(s) do { LAS unsigned char* st_ = sh + (s) * STG; *(LAS u32x4*)(st_ + wid * 1024 + lane * 16) = kreg0; if (k2) *(LAS u32x4*)(st_ + (8 + wid) * 1024 + lane * 16) = kreg1; } while (0)
#define STOREV(s) do { LAS unsigned char* st_ = sh + (s) * STG; *(LAS u32x4*)(st_ + KST + wid * 1024 + lane * 16) = vreg; } while (0)
#define QKT(P0, P1, s) do { LAS unsigned char* kb = sh + (s) * STG + hi * 1024 + r32 * 16; \
        _Pragma("unroll") for (int d0 = 0; d0 < 6; ++d0) { \
            const bf16x8 b0 = *(const LAS bf16x8*)(kb + d0 * 2048), b1 = *(const LAS bf16x8*)(kb + d0 * 2048 + 512); \
            P0 = __builtin_amdgcn_mfma_f32_32x32x16_bf16(b0, qr[d0], d0 == 0 ? zero16 : P0, 0, 0, 0); \
            P1 = __builtin_amdgcn_mfma_f32_32x32x16_bf16(b1, qr[d0], d0 == 0 ? zero16 : P1, 0, 0, 0); } } while (0)
#define SOFTPAIR(P, r) do { mx = max3f(mx, P[r], P[r + 1]); f32x2 v_ = (f32x2){P[r], P[r + 1]} - m2; v_.x = __builtin_amdgcn_exp2f(v_.x); v_.y = __builtin_amdgcn_exp2f(v_.y); P[r] = v_.x; P[r + 1] = v_.y; sum2 += v_; } while (0)
#define STEP(PA0, PA1, PB0, PB1, t, HASQK) do { const int s = (t) & 1; const bool more1 = (t) + 1 < NT, more2 = (t) + 2 < NT; \
        if (more2) LOADK((t) + 2); if (more1) LOADV((t) + 1); \
        if (HASQK) QKT(PB0, PB1, s ^ 1); \
        float mx = PA0[0]; f32x2 sum2 = (f32x2){0.f, 0.f}; const f32x2 m2 = (f32x2){mrun, mrun}; \
        _Pragma("unroll") for (int r = 0; r < 16; r += 2) { SOFTPAIR(PA0, r); } \
        u32x4 pw0, pw1, pw2, pw3; \
        pw0 = (u32x4){cvtpk(PA0[0], PA0[1]), cvtpk(PA0[2], PA0[3]), cvtpk(PA0[4], PA0[5]), cvtpk(PA0[6], PA0[7])}; \
        pw1 = (u32x4){cvtpk(PA0[8], PA0[9]), cvtpk(PA0[10], PA0[11]), cvtpk(PA0[12], PA0[13]), cvtpk(PA0[14], PA0[15])}; \
        if (HASQK) { __builtin_amdgcn_sched_group_barrier(0x100, 3, 0); \
            _Pragma("unroll") for (int i_ = 0; i_ < 12; ++i_) { __builtin_amdgcn_sched_group_barrier(0x008, 1, 0); __builtin_amdgcn_sched_group_barrier(0x100, 1, 0); __builtin_amdgcn_sched_group_barrier(0x002, 5, 0); } } \
        __builtin_amdgcn_sched_barrier(0); \
        const int vb = (int)(lds0 + s * STG + KST) + ((lane >> 4) & 1) * 32 + (lane & 3) * 8 + (4 * hi + ((lane & 15) >> 2)) * 64; \
        pvh(o, vb, __builtin_bit_cast(bf16x8, pw0), __builtin_bit_cast(bf16x8, pw1)); \
        _Pragma("unroll") for (int r = 0; r < 16; r += 2) { SOFTPAIR(PA1, r); } \
        pw2 = (u32x4){cvtpk(PA1[0], PA1[1]), cvtpk(PA1[2], PA1[3]), cvtpk(PA1[4], PA1[5]), cvtpk(PA1[6], PA1[7])}; \
        pw3 = (u32x4){cvtpk(PA1[8], PA1[9]), cvtpk(PA1[10], PA1[11]), cvtpk(PA1[12], PA1[13]), cvtpk(PA1[14], PA1[15])}; \
        __builtin_amdgcn_sched_barrier(0); \
        pvh(o, vb + 2048, __builtin_bit_cast(bf16x8, pw2), __builtin_bit_cast(bf16x8, pw3)); \
        lsum += sum2.x + sum2.y; \
        float rm = fmaxf(mx, __shfl_xor(mx, 32)); \
        if (__any(rm - mrun > 8.0f)) { const float dl = fmaxf(rm - mrun, 0.f); mrun += dl; \
            const float f = __builtin_amdgcn_exp2f(-dl); lsum *= f; \
            if (hi == 0) wsf[r32] = f; \
            asm volatile("s_waitcnt lgkmcnt(0)" ::: "memory"); \
            _Pragma("unroll") for (int r = 0; r < 16; ++r) { const float fr_ = wsf[crow(r, hi)]; o[0][r] *= fr_; o[1][r] *= fr_; } } \
        if (more2) STOREK(s); if (more1) STOREV(s ^ 1); \
        __syncthreads(); } while (0)
    LOADK(0); LOADV(0); STOREK(0); STOREV(0); LOADK(1); STOREK(1); __syncthreads();
    f32x16 pA0, pA1, pB0 = f32x16{}, pB1 = f32x16{};
    QKT(pA0, pA1, 0);
    { float m0 = pA0[0];
#pragma unroll
        for (int r = 0; r < 16; ++r) m0 = max3f(m0, pA0[r], pA1[r]);
        mrun = fmaxf(m0, __shfl_xor(m0, 32)); }
    for (int t = 0; t < NT - 2; t += 2) {
        STEP(pA0, pA1, pB0, pB1, t, true);
        STEP(pB0, pB1, pA0, pA1, t + 1, true);
    }
    STEP(pA0, pA1, pB0, pB1, NT - 2, true);
    STEP(pB0, pB1, pA0, pA1, NT - 1, false);
#undef SOFTPAIR
#undef LOADK
#undef LOADV
#undef STOREK
#undef STOREV
#undef QKT
#undef STEP
#undef LOADT
#undef STORET
#undef KBASE
    lsum += __shfl_xor(lsum, 32);
    if (hi == 0) wsf[r32] = 1.0f / lsum;
    asm volatile("s_waitcnt lgkmcnt(0)" ::: "memory");
    bf16_t* Ow = O + qrow0 * 1024 + h * 64;
#pragma unroll
    for (int r = 0; r < 16; ++r) { const int q = crow(r, hi); const float f = wsf[q];
        const unsigned a = cvt_pk_bf16(o[0][r] * f, o[1][r] * f);
        Ow[(long)q * 1024 + r32] = (bf16_t)(a & 0xffffu); Ow[(long)q * 1024 + 32 + r32] = (bf16_t)(a >> 16); }
    __syncthreads();
}
}

namespace fftl {
constexpr float W16C[8] = {1.f, 0.923879533f, 0.707106781f, 0.382683432f, 0.f, -0.382683432f, -0.707106781f, -0.923879533f};
constexpr float W16S[8] = {0.f, 0.382683432f, 0.707106781f, 0.923879533f, 1.f, 0.923879533f, 0.707106781f, 0.382683432f};
DEV int padi(int n) { return n + ((n >> 5) << 2); }
template <bool INV> DEV void bfly(float& xr, float& xi, float& yr, float& yi, const float c, const float s) {
    if (!INV) { const float dr = xr - yr, di = xi - yi; xr += yr; xi += yi; yr = dr * c + di * s; yi = di * c - dr * s; }
    else { const float tr = yr * c - yi * s, ti = yr * s + yi * c; yr = xr - tr; yi = xi - ti; xr += tr; xi += ti; }
}
template <int LR, bool INV, bool PRUNE = false> DEV void pass_strided(LAS float* re, LAS float* im, const int N, const int s, const int tid, const int ncol, const int cstride) {
    constexpr int R = 1 << LR; const int h2 = N >> (s + LR), ngr = N / R; const float invN = 1.f / (float)N;
    const bool lin = (h2 & 31) == 0; const int ph2 = h2 + ((h2 >> 5) << 2);
    for (int w = tid; w < ngr * ncol; w += NTHREADS) {
        const int col = w >> __builtin_ctz(ngr), g = w & (ngr - 1);
        const int j = g & (h2 - 1), base = (g - j) * R + j, pbase = padi(base);
        float twc[LR][R / 2], tws[LR][R / 2];
        { const float rev = (float)(j << s) * invN; float c = __builtin_amdgcn_cosf(rev), sn = __builtin_amdgcn_sinf(rev);
#pragma unroll
            for (int k = 0; k < LR; ++k) { const int dk = R >> (k + 1);
#pragma unroll
                for (int mm = 0; mm < R / 2; ++mm) { float cc = 0.f, ss = 0.f;
                    if (mm < dk) { const int e8 = mm * (4 / dk);
                        if (e8 == 0) { cc = c; ss = sn; } else if (e8 == 1) { cc = (c - sn) * 0.70710678f; ss = (sn + c) * 0.70710678f; } else if (e8 == 2) { cc = -sn; ss = c; } else { cc = (-c - sn) * 0.70710678f; ss = (c - sn) * 0.70710678f; } }
                    twc[k][mm] = cc; tws[k][mm] = ss; }
                const float c2 = c * c - sn * sn, s2 = 2.f * c * sn; c = c2; sn = s2; } }
        LAS float* r_ = re + col * cstride; LAS float* i_ = im + col * cstride;
        float xr[R], xi[R];
#pragma unroll
        for (int m = 0; m < R; ++m) { if (PRUNE && !INV && m >= R / 2) { xr[m] = 0.f; xi[m] = 0.f; } else { const int p = lin ? pbase + m * ph2 : padi(base + m * h2); xr[m] = r_[p]; xi[m] = i_[p]; } }
#pragma unroll
        for (int kk = 0; kk < LR; ++kk) { const int k = INV ? LR - 1 - kk : kk; const int dk = R >> (k + 1);
#pragma unroll
            for (int m = 0; m < R; ++m) if ((m & dk) == 0) bfly<INV>(xr[m], xi[m], xr[m + dk], xi[m + dk], twc[k][m & (dk - 1)], tws[k][m & (dk - 1)]); }
#pragma unroll
        for (int m = 0; m < R; ++m) { if (!(PRUNE && INV && m >= R / 2)) { const int p = lin ? pbase + m * ph2 : padi(base + m * h2); r_[p] = xr[m]; i_[p] = xi[m]; } }
    }
}
template <bool INV> DEV void pass_final16(LAS float* re, LAS float* im, const int N, const int tid, const int ncol, const int cstride) {
    const int ng = N >> 4;
    for (int w = tid; w < ng * ncol; w += NTHREADS) { const int col = w >> __builtin_ctz(ng), g = w & (ng - 1); const int p0 = padi(16 * g);
        LAS float* r_ = re + col * cstride + p0; LAS float* i_ = im + col * cstride + p0;
        float xr[16], xi[16];
#pragma unroll
        for (int m = 0; m < 16; ++m) { xr[m] = r_[m]; xi[m] = i_[m]; }
#pragma unroll
        for (int kk = 0; kk < 4; ++kk) { const int k = INV ? 3 - kk : kk; const int dk = 8 >> k;
#pragma unroll
            for (int m = 0; m < 16; ++m) if ((m & dk) == 0) bfly<INV>(xr[m], xi[m], xr[m + dk], xi[m + dk], W16C[(m & (dk - 1)) << k], W16S[(m & (dk - 1)) << k]); }
#pragma unroll
        for (int m = 0; m < 16; ++m) { r_[m] = xr[m]; i_[m] = xi[m]; }
    }
}
template <bool INV> DEV void pass_any(const int LR, LAS float* re, LAS float* im, const int N, const int s, const int tid, const int ncol, const int cstride) {
    if (LR == 3) pass_strided<3, INV>(re, im, N, s, tid, ncol, cstride);
    else if (LR == 2) pass_strided<2, INV>(re, im, N, s, tid, ncol, cstride);
    else pass_strided<1, INV>(re, im, N, s, tid, ncol, cstride);
}
template <bool INV, bool PRUNE = false> DEV void run(LAS float* re, LAS float* im, const int logN, const int tid_in, const int ncol, const int cstride) {
    int tid = tid_in; asm volatile("" : "+v"(tid));
    const int N = 1 << logN, front = logN - 4;
    if (!INV) {
        if (PRUNE) pass_strided<3, false, true>(re, im, N, 0, tid, ncol, cstride); else pass_strided<3, false, false>(re, im, N, 0, tid, ncol, cstride);
        __syncthreads();
        for (int s = 3; s < front;) { const int LR = (front - s >= 3) ? 3 : front - s; pass_any<false>(LR, re, im, N, s, tid, ncol, cstride); __syncthreads(); s += LR; }
        pass_final16<false>(re, im, N, tid, ncol, cstride); __syncthreads();
    } else {
        pass_final16<true>(re, im, N, tid, ncol, cstride); __syncthreads();
        int s = front; const int rem = front % 3;
        if (rem) { s -= rem; pass_any<true>(rem, re, im, N, s, tid, ncol, cstride); __syncthreads(); }
        while (s > 3) { s -= 3; pass_any<true>(3, re, im, N, s, tid, ncol, cstride); __syncthreads(); }
        if (PRUNE) pass_strided<3, true, true>(re, im, N, 0, tid, ncol, cstride); else pass_strided<3, true, false>(re, im, N, 0, tid, ncol, cstride);
        __syncthreads();
    }
}
}

struct Args { const float* in[33]; float* out; unsigned char* ws; int ph_lo, ph_hi; };
enum { I_X = 0, I_C, I_CTX, I_CCTX, I_NORM1, I_NORM2, I_WMOD, I_BMOD, I_FUP, I_FCW, I_FCB, I_FDOWN, I_FHIN, I_FHOUT, I_HCW, I_HCB,
       I_HW1, I_HB1, I_HW2, I_HB2, I_HW3, I_HB3, I_HW4, I_HFREQ, I_HBIAS, I_MIN, I_MQAN, I_MUQ, I_MKVAN, I_MUKV, I_MQN, I_MKN, I_MWO };

struct Op {
    int type; const bf16_t* A; const bf16_t* Bt; int lda, ldb, K; long sAz, sBz; int nM, nN, nZ, mode, rot;
    void* o0; void* o1; const void* p0; const void* p1; const void* p2; const void* p3; void* x0; void* x1;
    int i0, i1, i2, i3, i4; float f0, f1;
};
enum { T_G1 = 0, T_BF16, T_F32, T_RES, T_HF, T_HI, T_FFN, T_MLA };

typedef const __attribute__((address_space(4))) unsigned char* kptr_t;
#define KIN(i) (((const float* const __attribute__((address_space(4)))*)kp)[i])
#define KOUT (*(float* const __attribute__((address_space(4)))*)(kp + 264))
#define KWS (*(unsigned char* const __attribute__((address_space(4)))*)(kp + 272))
DEV bool get_op(kptr_t kp, int ph, int idx, Op& o) {
    unsigned char* ws = KWS;
#define BF(off) ((bf16_t*)(ws + (off)))
#define FP(off) ((float*)(ws + (off)))
    o.sAz = 0; o.sBz = 0; o.nZ = 1; o.mode = 0; o.rot = 0; o.o1 = nullptr; o.p0 = o.p1 = o.p2 = o.p3 = nullptr; o.x0 = o.x1 = nullptr; o.i0 = o.i1 = o.i2 = o.i3 = o.i4 = 0; o.f0 = 1.f; o.f1 = 0.f;
    float* mod = FP(WS_MOD);
    switch (ph) {
    case 2:
        if (idx == 0) { o.type = T_G1; o.A = BF(W_W1T); o.Bt = BF(WS_HX); o.lda = 1024; o.ldb = 1024; o.K = 1024; o.nM = 10; o.nN = 136; o.o0 = BF(WS_PQT); o.o1 = BF(WS_HT); o.p0 = BF(WS_PQTC); o.p1 = BF(WS_HTC); return true; }
        if (idx == 99) { o.type = T_F32; o.A = BF(WS_FILT); o.Bt = BF(WS_T1); o.lda = 4096; o.ldb = 4096; o.K = 4096; o.nM = 4; o.nN = 32; o.rot = 176; o.o0 = FP(WS_KF); o.i0 = 8192; return true; }
        if (idx == 98) { o.type = T_F32; o.A = BF(WS_FILTC); o.Bt = BF(WS_T1C); o.lda = 256; o.ldb = 256; o.K = 256; o.nM = 4; o.nN = 2; o.rot = 240; o.o0 = FP(WS_KFC); o.i0 = 512; return true; }
        return false;
    case 4:
        if (idx == 95) { o.type = T_BF16; o.A = BF(WS_T2); o.Bt = BF(WS_PQT); o.lda = 8192; o.ldb = 8192; o.K = 8192; o.sBz = 512L * 8192; o.nM = 16; o.nN = 2; o.nZ = 8; o.o0 = BF(WS_HX); o.i0 = 1024; o.i1 = 0; o.i2 = 0; o.i3 = 4096; o.f0 = 0.001381067932004975f; return true; }
        if (idx == 97) { o.type = T_HF; o.A = BF(WS_WT); o.Bt = BF(WS_T1); o.lda = 4096; o.ldb = 4096; o.K = 4096; o.nM = 16; o.nN = 32; o.o0 = BF(WS_YT); o.p0 = FP(WS_KF); o.p1 = FP(WS_SMALL); o.i0 = 4096; return true; }
        if (idx == 94) { o.type = T_BF16; o.A = BF(WS_CSC); o.Bt = BF(WS_PQTC); o.lda = 512; o.ldb = 512; o.K = 512; o.sBz = 512L * 512; o.nM = 1; o.nN = 2; o.nZ = 8; o.rot = 128; o.o0 = BF(WS_HX); o.i0 = 1024; o.i1 = 0; o.i2 = TX; o.i3 = 256; o.f0 = 0.005524271728019903f; return true; }
        if (idx == 96) { o.type = T_HF; o.A = BF(WS_WTC); o.Bt = BF(WS_T1C); o.lda = 256; o.ldb = 256; o.K = 256; o.nM = 16; o.nN = 2; o.rot = 160; o.o0 = BF(WS_YTC); o.p0 = FP(WS_KFC); o.p1 = FP(WS_SMALL + 4096); o.i0 = 256; return true; }
        return false;
    case 5:
        return false;
        if (idx == 0) { o.type = T_HI; o.A = BF(WS_YT); o.Bt = BF(WS_T1); o.lda = 8192; o.ldb = 8192; o.K = 8192; o.nM = 16; o.nN = 16; o.o0 = BF(WS_HX); o.p0 = BF(WS_WT); o.p1 = BF(WS_X0C); o.p2 = FP(WS_SMALL + 16384); o.p3 = KIN(I_HBIAS); o.i0 = 4096; o.i1 = 0; return true; }
        if (idx == 1) { o.type = T_HI; o.A = BF(WS_YTC); o.Bt = BF(WS_T1C); o.lda = 512; o.ldb = 512; o.K = 512; o.nM = 16; o.nN = 1; o.o0 = BF(WS_HX); o.p0 = BF(WS_WTC); o.p1 = BF(WS_X0CC); o.p2 = FP(WS_SMALL + 32768); o.p3 = KIN(I_HBIAS); o.i0 = 256; o.i1 = TX; return true; }
        return false;
    case 6:
        if (idx == 0) { o.type = T_RES; o.A = BF(WS_HX); o.Bt = BF(W_WOUT); o.lda = 1024; o.ldb = 1024; o.K = 1024; o.nM = 136; o.nN = 4; o.p0 = KIN(I_X); o.p1 = KIN(I_CTX); o.o0 = FP(WS_XR); o.o1 = FP(WS_XR) + (size_t)TX * DM; o.p2 = mod + 2 * 1024; return true; }
        return false;
    case 8:
        if (idx == 0) { o.type = T_FFN; o.A = BF(WS_HX); o.Bt = BF(W_WUP); o.lda = 1024; o.ldb = 1024; o.K = 1024; o.nM = 136; o.nN = 22; o.mode = 0; o.o0 = BF(WS_ACT); o.o1 = FP(WS_SB); o.p0 = KIN(I_FCW); o.p1 = KIN(I_FCB); return true; }
        return false;
    case 9:
        if (idx == 0) { o.type = T_RES; o.A = BF(WS_ACT); o.Bt = BF(W_WDOWN); o.lda = DFF; o.ldb = DFF; o.K = DFF; o.nM = 136; o.nN = 4; o.p0 = FP(WS_XR); o.p1 = FP(WS_XR) + (size_t)TX * DM; o.o0 = FP(WS_XR); o.o1 = FP(WS_XR) + (size_t)TX * DM; o.p2 = mod + 5 * 1024; return true; }
        return false;
    case 11:
        if (idx == 0) { o.type = T_MLA; o.A = BF(WS_HX); o.Bt = BF(W_MLAIN); o.lda = 1024; o.ldb = 1024; o.K = 1024; o.nM = 136; o.nN = 2; o.o0 = BF(WS_AQN); o.o1 = BF(WS_CKVN); o.x0 = FP(WS_KPE); o.x1 = FP(WS_SSQ2); o.p0 = KIN(I_MQAN); o.p1 = KIN(I_MKVAN); return true; }
        return false;
    case 13:
        if (idx == 0) { o.type = T_BF16; o.A = BF(WS_AQN); o.Bt = BF(W_WUQ); o.lda = 256; o.ldb = 256; o.K = 256; o.nM = 128; o.nN = 6; o.o0 = BF(WS_QB); o.i0 = 1536; o.i3 = 0; o.p0 = FP(WS_SSQ2); o.i4 = 0; o.f1 = 1.f / 256.f; return true; }
        if (idx == 1) { o.type = T_BF16; o.A = BF(WS_CKVN); o.Bt = BF(W_WUKV); o.lda = 128; o.ldb = 128; o.K = 128; o.nM = 136; o.nN = 8; o.o0 = BF(WS_KRAW); o.o1 = BF(WS_VB); o.i0 = 1024; o.i1 = 1024; o.p0 = FP(WS_SSQ2); o.i4 = 1; o.f1 = 1.f / 128.f; return true; }
        return false;
    case 16:
        if (idx == 0) { o.type = T_RES; o.A = BF(WS_OB); o.Bt = BF(W_WO); o.lda = 1024; o.ldb = 1024; o.K = 1024; o.nM = 128; o.nN = 4; o.p0 = FP(WS_XR); o.p1 = FP(WS_XR) + (size_t)TX * DM; o.o0 = FP(WS_XR); o.o1 = FP(WS_XR) + (size_t)TX * DM; o.p2 = mod + 9 * 6144 + 2 * 1024; return true; }
        return false;
    case 18:
        if (idx == 0) { o.type = T_FFN; o.A = BF(WS_HX); o.Bt = BF(W_WUP); o.lda = 1024; o.ldb = 1024; o.K = 1024; o.nM = 128; o.nN = 22; o.mode = 0; o.o0 = BF(WS_ACT); o.o1 = FP(WS_SB); o.p0 = KIN(I_FCW) + 3 * DFF; o.p1 = KIN(I_FCB) + DFF; return true; }
        return false;
    case 19:
        if (idx == 0) { o.type = T_RES; o.A = BF(WS_ACT); o.Bt = BF(W_WDOWN); o.lda = DFF; o.ldb = DFF; o.K = DFF; o.nM = 128; o.nN = 4; o.p0 = FP(WS_XR); o.p1 = FP(WS_XR) + (size_t)TX * DM; o.o0 = KOUT; o.o1 = KOUT; o.p2 = mod + 9 * 6144 + 5 * 1024; return true; }
        return false;
    default: return false;
    }
#undef BF
#undef FP
}

DEV void tr_item(const float* W, int ldw, int K, bf16_t* WT, int dst_n0, int src_n0, int k0, LAS float* scr, int lane) {
#pragma unroll 8
    for (int i = 0; i < 32; ++i) { const int kk = 2 * i + (lane >> 5); scr[kk * 33 + (lane & 31)] = (src_n0 >= 0) ? W[(size_t)(k0 + kk) * ldw + src_n0 + (lane & 31)] : 0.f; }
    asm volatile("s_waitcnt lgkmcnt(0)" ::: "memory");
    const int c = lane & 7;
#pragma unroll
    for (int j = 0; j < 4; ++j) { const int n = (lane >> 3) + 8 * j; const LAS float* s = scr + (8 * c) * 33 + n;
        u32x4 o; o.x = cvt_pk_bf16(s[0 * 33], s[1 * 33]); o.y = cvt_pk_bf16(s[2 * 33], s[3 * 33]); o.z = cvt_pk_bf16(s[4 * 33], s[5 * 33]); o.w = cvt_pk_bf16(s[6 * 33], s[7 * 33]);
        *(u32x4*)(WT + (size_t)(dst_n0 + n) * K + k0 + 8 * c) = o; }
    asm volatile("s_waitcnt lgkmcnt(0)" ::: "memory");
}
DEV void tr_matrix(const float* W, int ldw, int K, int Ndst, bf16_t* WT, int map, int nvalid, int src_off, LAS float* scr, int gw, int NGW, int lane) {
    const int nblk = Ndst / 32, nit = (K / 64) * nblk;
    for (int it = gw; it < nit; it += NGW) { const int kb = it / nblk, nb = it % nblk, d0 = nb * 32; int s0 = d0;
        if (map == 1) { const int pn = d0 >> 8, wi = d0 & 255, bj = wi >> 7, jj = wi & 127; s0 = bj * DFF + 128 * pn + jj; }
        else if (map == 2) { if (d0 < 1024) s0 = (d0 >> 6) * 128 + (d0 & 63); else { const int n2 = d0 - 1024; s0 = (n2 >> 6) * 128 + 64 + (n2 & 63); } }
        else if (map == 3) { if (d0 >= nvalid) s0 = -1; }
        tr_item(W, ldw, K, WT, d0, s0 < 0 ? -1 : s0 + src_off, kb * 64, scr, lane); }
}
DEV void modnorm_rows(const float* srcX, const float* srcC, int nrows, const float* g, const float* shift, const float* scale, bf16_t* dst, int gw, int NGW, int lane) {
    for (int row0 = gw; row0 < nrows; row0 += 2 * NGW) {
        const int row1 = row0 + NGW; const bool has1 = row1 < nrows;
        const float* xr0 = (row0 < TX) ? srcX + (size_t)row0 * DM : srcC + (size_t)(row0 - TX) * DM;
        const float* xr1 = !has1 ? xr0 : ((row1 < TX) ? srcX + (size_t)row1 * DM : srcC + (size_t)(row1 - TX) * DM);
        f32x4 v0[4], v1[4]; float s0 = 0.f, s1 = 0.f;
#pragma unroll
        for (int j = 0; j < 4; ++j) { v0[j] = __builtin_nontemporal_load((const f32x4*)(xr0 + 256 * j + 4 * lane)); v1[j] = __builtin_nontemporal_load((const f32x4*)(xr1 + 256 * j + 4 * lane)); }
#pragma unroll
        for (int j = 0; j < 4; ++j) { s0 += (v0[j][0] * v0[j][0] + v0[j][1] * v0[j][1]) + (v0[j][2] * v0[j][2] + v0[j][3] * v0[j][3]); s1 += (v1[j][0] * v1[j][0] + v1[j][1] * v1[j][1]) + (v1[j][2] * v1[j][2] + v1[j][3] * v1[j][3]); }
        const float rstd0 = 1.0f / sqrtf(wave_sum(s0) * (1.f / DM) + EPS), rstd1 = 1.0f / sqrtf(wave_sum(s1) * (1.f / DM) + EPS);
        const int mr0 = (row0 < TX) ? (row0 >> 12) : 8, mr1 = (row1 < TX) ? (row1 >> 12) : 8;
#pragma unroll
        for (int j = 0; j < 4; ++j) { const int col = 256 * j + 4 * lane; const f32x4 gg = *(const f32x4*)(g + col);
            { const f32x4 sh = *(const f32x4*)(shift + (size_t)mr0 * 6144 + col), sc = *(const f32x4*)(scale + (size_t)mr0 * 6144 + col); f32x4 y;
#pragma unroll
                for (int e = 0; e < 4; ++e) y[e] = (v0[j][e] * rstd0 * gg[e]) * (1.f + sc[e]) + sh[e];
                u32x2 w; w.x = cvt_pk_bf16(y[0], y[1]); w.y = cvt_pk_bf16(y[2], y[3]); *(u32x2*)(dst + (size_t)row0 * DM + col) = w; }
            if (has1) { const f32x4 sh = *(const f32x4*)(shift + (size_t)mr1 * 6144 + col), sc = *(const f32x4*)(scale + (size_t)mr1 * 6144 + col); f32x4 y;
#pragma unroll
                for (int e = 0; e < 4; ++e) y[e] = (v1[j][e] * rstd1 * gg[e]) * (1.f + sc[e]) + sh[e];
                u32x2 w; w.x = cvt_pk_bf16(y[0], y[1]); w.y = cvt_pk_bf16(y[2], y[3]); *(u32x2*)(dst + (size_t)row1 * DM + col) = w; } }
    }
}

constexpr size_t WS_BAR = 3 * MiB;
DEV void grid_barrier(unsigned* cnt, const unsigned target, const int tid) {
    asm volatile("s_waitcnt vmcnt(0)" ::: "memory");
    __syncthreads();
    if (tid == 0) {
        __builtin_amdgcn_fence(__ATOMIC_RELEASE, "agent");
        __hip_atomic_fetch_add(cnt, 1u, __ATOMIC_RELAXED, __HIP_MEMORY_SCOPE_AGENT);
        while (__hip_atomic_load(cnt, __ATOMIC_RELAXED, __HIP_MEMORY_SCOPE_AGENT) < target) __builtin_amdgcn_s_sleep(8);
        __builtin_amdgcn_fence(__ATOMIC_ACQUIRE, "agent");
        asm volatile("s_waitcnt vmcnt(0)" ::: "memory");
    }
    __syncthreads();
}
DEV void ffn_fixup(const float* sb, bf16_t* act, const float* cw, const float* cb, const int nrt, const int gt, const int NGT) {
    const int per = DFF / 4;
    for (int i = gt; i < nrt * 2 * per; i += NGT) { const int pm = i / (2 * per), r2 = i - pm * 2 * per, e = r2 / per, j = (r2 - e * per) * 4;
        const bool isx = pm < 128; const bool first = isx ? ((pm & 15) == 0) : true, last = isx ? ((pm & 15) == 15) : true;
        const float* me = sb + (size_t)pm * 6 * DFF + j; const f32x4 z4 = (f32x4){0.f, 0.f, 0.f, 0.f};
        f32x4 up, g, dn, v;
        if (e == 0) { up = first ? z4 : *(const f32x4*)(me - (size_t)6 * DFF + (size_t)3 * DFF); g = *(const f32x4*)(me); dn = *(const f32x4*)(me + DFF); v = *(const f32x4*)(me + (size_t)4 * DFF); }
        else { up = *(const f32x4*)(me + (size_t)2 * DFF); g = *(const f32x4*)(me + (size_t)3 * DFF); dn = last ? z4 : *(const f32x4*)(me + (size_t)6 * DFF); v = *(const f32x4*)(me + (size_t)5 * DFF); }
        const f32x4 w0 = *(const f32x4*)(cw + j), w1 = *(const f32x4*)(cw + DFF + j), w2 = *(const f32x4*)(cw + 2 * DFF + j), bb = *(const f32x4*)(cb + j);
        f32x4 o;
#pragma unroll
        for (int q = 0; q < 4; ++q) { const float z = w0[q] * up[q] + w1[q] * g[q] + w2[q] * dn[q] + bb[q]; o[q] = z * __builtin_amdgcn_rcpf(1.f + __builtin_amdgcn_exp2f(-1.4426950408889634f * z)) * v[q]; }
        const int row = pm * 256 + (e ? 255 : 0);
        u32x2 w; w.x = cvt_pk_bf16(o[0], o[1]); w.y = cvt_pk_bf16(o[2], o[3]); *(u32x2*)(act + (size_t)row * DFF + j) = w; }
}
DEV void hy_conv8(const bf16_t* ht, const int b, const int c, const int L, const int t0, const bool act_, const float* cwp, const float* cbp, float (&x0o)[8], float (&wo)[8]) {
    float outv[3][8];
#pragma unroll
    for (int q = 0; q < 3; ++q) { const int cp = q * 512 + c; const bf16_t* src = ht + (size_t)(b * 1536 + cp) * L;
        const float w0 = cwp[cp], w1 = cwp[1536 + cp], w2 = cwp[3072 + cp], bq = cbp[cp];
        float x[10];
        if (act_) { const u32x4 raw = *(const u32x4*)(src + t0);
            x[1] = __uint_as_float(raw.x << 16); x[2] = __uint_as_float(raw.x & 0xffff0000u); x[3] = __uint_as_float(raw.y << 16); x[4] = __uint_as_float(raw.y & 0xffff0000u);
            x[5] = __uint_as_float(raw.z << 16); x[6] = __uint_as_float(raw.z & 0xffff0000u); x[7] = __uint_as_float(raw.w << 16); x[8] = __uint_as_float(raw.w & 0xffff0000u);
            x[0] = (t0 > 0) ? bf2f(src[t0 - 1]) : 0.f; x[9] = (t0 + 8 < L) ? bf2f(src[t0 + 8]) : 0.f; }
        else {
#pragma unroll
            for (int e = 0; e < 10; ++e) x[e] = 0.f; }
#pragma unroll
        for (int e = 0; e < 8; ++e) outv[q][e] = w0 * x[e] + w1 * x[e + 1] + w2 * x[e + 2] + bq; }
#pragma unroll
    for (int e = 0; e < 8; ++e) { x0o[e] = outv[0][e]; wo[e] = outv[2][e] * outv[1][e]; }
}
#define BF(off) ((bf16_t*)(ws + (off)))
#define FP(off) ((float*)(ws + (off)))
#define PHASE(k) ((LO) <= (k) && (k) < (HI) && ph == (k))
#ifndef DUP_PH
#define DUP_PH -1
#endif
template <int LO, int HI>
DEV void run_phases(LAS unsigned char* lds, const int ph_lo, const int ph_hi, const int G, const int wave0, unsigned& nbar) {
    int dup_left = 1;
    for (int ph = (ph_lo > LO ? ph_lo : LO); ph < (ph_hi < HI ? ph_hi : HI); ++ph) {
        if (ph == 3 || ph == 5 || ph == 12) continue;
        kptr_t kp = (kptr_t)__builtin_amdgcn_kernarg_segment_ptr(); asm volatile("" : "+s"(kp));
        int bid = blockIdx.x; asm volatile("" : "+s"(bid));
        const int NGW = G * 8, NGT = G * NTHREADS;
        unsigned char* ws = KWS;
        float* mod = FP(WS_MOD);
        {
        int tid; asm volatile("v_mbcnt_lo_u32_b32 %0, -1, 0\n\tv_mbcnt_hi_u32_b32 %0, -1, %0" : "=v"(tid)); tid += wave0 * 64; asm volatile("" : "+v"(tid));
        const int gt = bid * NTHREADS + tid;
        if (PHASE(9) || PHASE(19)) {
            const int l1_ = (ph == 19);
            ffn_fixup(FP(WS_SB), BF(WS_ACT), KIN(I_FCW) + l1_ * 3 * DFF, KIN(I_FCB) + l1_ * DFF, l1_ ? 128 : 136, gt, NGT);
            if (ph_lo < ph) { ++nbar; grid_barrier((unsigned*)(ws + WS_BAR), nbar * (unsigned)G, tid); }
        }
        {
            Op o;
            for (int idx = 0; get_op(kp, ph, idx, o); ++idx) {
                pg8::Gemm g{o.A, o.Bt, o.lda, o.ldb, o.K, o.sAz, o.sBz};
                pg8::Sched S{o.nM, o.nN, o.nZ, G, (bid + o.rot) % G, o.mode};
                int tid2 = tid; asm volatile("" : "+v"(tid2));
                switch (o.type) {
                case T_G1: if (LO <= 2 && 2 < HI) { pg8::EpiG1 E{(bf16_t*)o.o0, (bf16_t*)o.o1, (bf16_t*)o.p0, (bf16_t*)o.p1}; pg8::gemm_phase(lds, g, S, E, tid2); } break;
                case T_BF16: if (LO <= 13 && 13 < HI) { pg8::EpiBf16 E{(bf16_t*)o.o0, (bf16_t*)o.o1, o.i0, o.i1, o.i2, o.i3, o.f0, (const float*)o.p0, o.i4, o.f1}; pg8::gemm_phase(lds, g, S, E, tid2); } break;
                case T_F32: if (LO <= 11 && 11 < HI) { pg8::EpiF32 E{(float*)o.o0, o.i0}; pg8::gemm_phase(lds, g, S, E, tid2); } break;
                case T_RES: if (HI > 6) { pg8::EpiRes E{(const float*)o.p0, (const float*)o.p1, (float*)o.o0, (float*)o.o1, (const float*)o.p2}; pg8::gemm_phase(lds, g, S, E, tid2); } break;
                case T_FFN: if (HI > 8) { pg8::EpiFFN E{(bf16_t*)o.o0, (const float*)o.p0, (const float*)o.p1, (float*)o.o1}; pg8::gemm_phase(lds, g, S, E, tid2); } break;
                case T_MLA: if (LO <= 11 && 11 < HI) { pg8::EpiMla E{(bf16_t*)o.o0, (bf16_t*)o.o1, (float*)o.x0, (float*)o.x1, (const float*)o.p0, (const float*)o.p1}; pg8::gemm_phase(lds, g, S, E, tid2); } break;
                }
                __syncthreads();
            }
        }
        }
        int tid; asm volatile("v_mbcnt_lo_u32_b32 %0, -1, 0\n\tv_mbcnt_hi_u32_b32 %0, -1, %0" : "=v"(tid)); tid += wave0 * 64; asm volatile("" : "+v"(tid));
        const int lane = tid & 63, wave = __builtin_amdgcn_readfirstlane(tid >> 6);
        const int gw = bid * 8 + wave;
        const int gt = bid * NTHREADS + tid;
        if (PHASE(0)) {
            const bool bal0 = (G == 256); const int nrep0 = (bal0 && bid >= 192) ? 2 : 1, vNGW0 = bal0 ? 2560 : NGW;
            {
                LAS float* sl = (LAS float*)lds;
                LAS float* part = sl + 9 * 1024;
                bool loaded = false;
                for (int it = bid; it < 192; it += G) {
                    if (!loaded) { for (int i = tid; i < 9 * 1024; i += NTHREADS) { const float x = (i < 8192) ? KIN(I_C)[i] : KIN(I_CCTX)[i - 8192]; sl[i] = silu_f(x); } loaded = true; __syncthreads(); }
                    const int l = it / 96, n0 = (it % 96) * 64; const float* wm = KIN(I_WMOD) + (size_t)l * 1024 * 6144 + n0 + lane;
                    float acc9[9];
#pragma unroll
                    for (int r = 0; r < 9; ++r) acc9[r] = 0.f;
#pragma unroll 32
                    for (int k = wave * 128; k < wave * 128 + 128; ++k) { const float wv = wm[(size_t)k * 6144];
#pragma unroll
                        for (int r = 0; r < 9; ++r) acc9[r] += sl[r * 1024 + k] * wv; }
#pragma unroll
                    for (int r = 0; r < 9; ++r) part[(wave * 9 + r) * 64 + lane] = acc9[r];
                    __syncthreads();
                    for (int i = tid; i < 576; i += NTHREADS) { const int r = i >> 6, ln = i & 63; float s = 0.f;
#pragma unroll
                        for (int w = 0; w < 8; ++w) s += part[(w * 9 + r) * 64 + ln];
                        mod[(size_t)(l * 9 + r) * 6144 + n0 + ln] = s + KIN(I_BMOD)[l * 6144 + n0 + ln]; }
                    __syncthreads();
                }
                __syncthreads();
            }
            {
                LAS float* scr = (LAS float*)(lds + wave * 16384);
                for (int rep = 0; rep < nrep0; ++rep) { const int vgw = bal0 ? (bid < 192 ? gw : 1536 + (bid - 192) * 16 + rep * 8 + wave) : gw;
                    tr_matrix(KIN(I_FHIN), 2048, 1024, 1536, BF(W_W1T) + (size_t)1024 * 1024, 0, 0, 512, scr, vgw, vNGW0, lane);
                    tr_matrix(KIN(I_FHOUT), 1024, 1024, 1024, BF(W_WOUT), 0, 0, 0, scr, vgw, vNGW0, lane);
                    tr_matrix(KIN(I_FUP), 2 * DFF, 1024, 2 * DFF, BF(W_WUP), 1, 0, 0, scr, vgw, vNGW0, lane);
                    tr_matrix(KIN(I_FDOWN), 1024, DFF, 1024, BF(W_WDOWN), 0, 0, 0, scr, vgw, vNGW0, lane); }
                __syncthreads();
            }
            {
                LAS float* wt = (LAS float*)lds;
                LAS float* cs = wt + 16 * 128;
                if (tid < 128) { cs[tid] = __builtin_amdgcn_cosf((float)tid / 128.f); cs[128 + tid] = __builtin_amdgcn_sinf((float)tid / 128.f); }
                for (int it = bid; it < 256; it += G) { const int g = it >> 6, k0 = (it & 63) * 16;
                    __syncthreads();
                    for (int i = tid; i < 2048; i += NTHREADS) { const int kk = i >> 7, j = i & 127; wt[i] = KIN(I_FHIN)[(size_t)(k0 + kk) * 2048 + g * 128 + j]; }
                    __syncthreads();
                    const int rowi = tid >> 1, hh = tid & 1, m = rowi >> 1, part = rowi & 1;
                    float s[8];
#pragma unroll
                    for (int e = 0; e < 8; ++e) s[e] = 0.f;
                    for (int j = 0; j < 128; ++j) { const float tr = cs[part * 128 + ((j * m) & 127)];
#pragma unroll
                        for (int e = 0; e < 8; ++e) s[e] += wt[(hh * 8 + e) * 128 + j] * tr; }
                    u32x4 w; w.x = cvt_pk_bf16(s[0], s[1]); w.y = cvt_pk_bf16(s[2], s[3]); w.z = cvt_pk_bf16(s[4], s[5]); w.w = cvt_pk_bf16(s[6], s[7]);
                    *(u32x4*)(BF(W_W1T) + (size_t)(2 * (g * 128 + m) + part) * 1024 + k0 + hh * 8) = w;
                }
                __syncthreads();
            }
            for (int rep = 0; rep < nrep0; ++rep)
            for (int it = bal0 ? (bid < 192 ? gw : 1536 + (bid - 192) * 16 + rep * 8 + wave) : gw; it < 4096 + 256; it += vNGW0) {
                const bool isc = it >= 4096; const int L = isc ? 256 : 4096, pos = isc ? it - 4096 : it;
                const float t = (float)pos / (float)(L - 1);
                float z = 0.f;
                if (lane == 0) z = t;
                else if (lane < 33) { const int i = (lane - 1) & 15; const float band = 1e-4f + (float)i * ((15.0f - 1e-4f) / 15.0f);
                    const float ang = (6.283185307179586f / (float)L) * (float)pos * band; z = (lane <= 16) ? cosf(ang) : -sinf(ang); }
                const float fr_ = KIN(I_HFREQ)[lane];
                float h = KIN(I_HB1)[lane];
#pragma unroll 11
                for (int i = 0; i < 33; ++i) h += __shfl(z, i) * KIN(I_HW1)[i * 64 + lane];
                h = sinf(fr_ * h);
                float h2 = KIN(I_HB2)[lane];
#pragma unroll 16
                for (int i = 0; i < 64; ++i) h2 += __shfl(h, i) * KIN(I_HW2)[i * 64 + lane];
                h2 = sinf(fr_ * h2);
                float h3 = KIN(I_HB3)[lane];
#pragma unroll 16
                for (int i = 0; i < 64; ++i) h3 += __shfl(h2, i) * KIN(I_HW3)[i * 64 + lane];
                h3 = sinf(fr_ * h3);
                (isc ? FP(WS_H3C) : FP(WS_H3X))[(size_t)pos * 64 + lane] = h3;
            }
        }
        else if (PHASE(1)) {
            modnorm_rows(KIN(I_X), KIN(I_CTX), TT, KIN(I_NORM1), mod + 0 * 1024, mod + 1 * 1024, BF(WS_HX), gw, NGW, lane);
        }
        else if (PHASE(4)) {
            {
            LAS float* re = (LAS float*)lds; LAS float* im = re + 9216; LAS float* kre = re + 18432; LAS float* kim = kre + 8192;
            LAS float* w4 = kim + 8192; LAS float* red = w4 + 128;
            for (int it = bid; it < 1024; it += G) {
                const bool isc = it >= 512; const int c = (G == 256) ? ((((it >> 8) & 1) * 8 + (bid & 7)) * 32 + (bid >> 3)) : (it & 511), L = isc ? 256 : 4096, N = 2 * L, logN = isc ? 9 : 13;
                const float invN = 1.f / (float)N;
                const float* h3 = isc ? FP(WS_H3C) : FP(WS_H3X);
                __syncthreads();
                if (tid < 128) w4[tid] = KIN(I_HW4)[(size_t)(tid & 63) * 1024 + (tid >> 6) * 512 + c];
                __syncthreads();
                const float MIND = -15.350567286626973f, MAXD = -3.0701134573253946f;
                const float ad = fabsf(MIND + (float)c * ((MAXD - MIND) / 511.f));
                float l1 = 0.f;
                for (int p = tid; p < L; p += NTHREADS) { const float* hp = h3 + (size_t)p * 64; float sf = 0.f, sb = 0.f;
#pragma unroll
                    for (int j4 = 0; j4 < 16; ++j4) { const f32x4 hv = *(const f32x4*)(hp + 4 * j4);
#pragma unroll
                        for (int e = 0; e < 4; ++e) { sf += hv[e] * w4[4 * j4 + e]; sb += hv[e] * w4[64 + 4 * j4 + e]; } }
                    const float t = (float)p / (float)(L - 1), dec = expf(-t * ad); sf *= dec; sb = (p == 0) ? 0.f : sb * dec;
                    re[fftl::padi(p)] = sf; im[fftl::padi(p)] = 0.f; im[fftl::padi(p + L)] = 0.f;
                    if (p > 0) re[fftl::padi(N - p)] = sb; else re[fftl::padi(L)] = 0.f;
                    l1 += fabsf(sf) + fabsf(sb); }
                l1 = wave_sum(l1);
                if (lane == 0) red[wave] = l1;
                __syncthreads();
                float l1t = 0.f;
#pragma unroll
                for (int w = 0; w < 8; ++w) l1t += red[w];
                const float ksc = invN / l1t;
                fftl::run<false>(re, im, logN, tid, 1, 0);
                for (int i = tid; i < N; i += NTHREADS) { const int p = fftl::padi(i); kre[i] = re[p] * ksc; kim[i] = im[p] * ksc; }
                __syncthreads();
                const bf16_t* ht = isc ? BF(WS_HTC) : BF(WS_HT);
                const float* cwp = KIN(I_HCW); const float* cbp = KIN(I_HCB); const float hb_ = KIN(I_HBIAS)[c];
                const int npb = isc ? 4 : 1, cst = isc ? 576 : 0, cpp = L / 8;
                const int pl = tid >> __builtin_ctz(cpp), t0 = (tid & (cpp - 1)) * 8; const bool act_ = pl < npb; const int pt0 = pl * cst + fftl::padi(t0), pt1 = pl * cst + fftl::padi(L + t0);
                for (int bp0 = 0; bp0 < 4; bp0 += npb) { const int bp = bp0 + (act_ ? pl : 0);
                    float xk[2][8], wk[2][8];
                    hy_conv8(ht, 2 * bp, c, L, t0, act_, cwp, cbp, xk[0], wk[0]); hy_conv8(ht, 2 * bp + 1, c, L, t0, act_, cwp, cbp, xk[1], wk[1]);
                    if (act_) {
#pragma unroll
                        for (int e = 0; e < 8; ++e) { re[pt0 + e] = wk[0][e]; im[pt0 + e] = wk[1][e]; } }
                    __syncthreads();
                    fftl::run<false, true>(re, im, logN, tid, npb, cst);
                    for (int i = tid; i < N * npb; i += NTHREADS) { const int cl = i >> logN, ii = i & (N - 1); const int p = cl * cst + fftl::padi(ii); const float zr = re[p], zi = im[p], kr = kre[ii], ki = kim[ii]; re[p] = zr * kr - zi * ki; im[p] = zr * ki + zi * kr; }
                    __syncthreads();
                    fftl::run<true, true>(re, im, logN, tid, npb, cst);
                    if (act_) {
#pragma unroll
                        for (int bb = 0; bb < 2; ++bb) { const int b = 2 * bp + bb; bf16_t* op = BF(WS_HX) + (size_t)((isc ? TX : 0) + b * L + t0) * DM + 512 + c;
#pragma unroll
                            for (int e = 0; e < 8; e += 2) { const float y0 = (bb ? im[pt0 + e] : re[pt0 + e]), y1 = (bb ? im[pt0 + e + 1] : re[pt0 + e + 1]);
                                const unsigned pk = cvt_pk_bf16(xk[bb][e] * (y0 + wk[bb][e] * hb_), xk[bb][e + 1] * (y1 + wk[bb][e + 1] * hb_));
                                op[(size_t)e * DM] = (bf16_t)(pk & 0xffffu); op[(size_t)(e + 1) * DM] = (bf16_t)(pk >> 16); } } }
                    __syncthreads();
                }
            }
            __syncthreads();
            }
            {
                LAS float* fre = (LAS float*)lds; LAS float* fim = fre + 9216;
                u32x4 pfc[2], pfs[2];
#define FPRE(itn) do { if ((itn) < 4096) { const bool isc_ = (itn) >= 2048; const int L_ = isc_ ? 256 : 4096, b_ = ((itn) & 2047) >> 8, n_ = ((G == 256) ? ((bid & 7) * 32 + (bid >> 3)) : ((itn) & 255)) * 2; \
                        const bf16_t* src_ = (isc_ ? BF(WS_PQTC) : BF(WS_PQT)) + (size_t)(b_ * 512 + n_) * (2 * L_); \
                        _Pragma("unroll") for (int u_ = 0; u_ < 2; ++u_) { const int i_ = tid + u_ * NTHREADS; if (i_ < L_ / 4) { const int j_ = i_ / (L_ / 8), t_ = (i_ % (L_ / 8)) * 8; \
                            pfc[u_] = *(const u32x4*)(src_ + (size_t)j_ * 2 * L_ + t_); pfs[u_] = *(const u32x4*)(src_ + (size_t)j_ * 2 * L_ + L_ + t_); } } } } while (0)
                pfc[0] = pfc[1] = pfs[0] = pfs[1] = u32x4{};
                FPRE(bid);
                for (int it = bid; it < 4096; it += G) {
                    const bool isc = it >= 2048; const int L = isc ? 256 : 4096, logL = isc ? 8 : 12, b = (it & 2047) >> 8, n0 = ((G == 256) ? ((bid & 7) * 32 + (bid >> 3)) : (it & 255)) * 2;
                    const float oscale = isc ? 0.005524271728019903f : 0.001381067932004975f;
                    __syncthreads();
#pragma unroll
                    for (int u_ = 0; u_ < 2; ++u_) { const int i = tid + u_ * NTHREADS; if (i < L / 4) { const int j = i / (L / 8), t0 = (i % (L / 8)) * 8;
                        const u32x4 rc = pfc[u_], rs = pfs[u_];
                        LAS float* pr = fre + j * 4608 + fftl::padi(t0); LAS float* pi = fim + j * 4608 + fftl::padi(t0);
                        pr[0] = __uint_as_float(rc.x << 16); pr[1] = __uint_as_float(rc.x & 0xffff0000u); pr[2] = __uint_as_float(rc.y << 16); pr[3] = __uint_as_float(rc.y & 0xffff0000u);
                        pr[4] = __uint_as_float(rc.z << 16); pr[5] = __uint_as_float(rc.z & 0xffff0000u); pr[6] = __uint_as_float(rc.w << 16); pr[7] = __uint_as_float(rc.w & 0xffff0000u);
                        pi[0] = -__uint_as_float(rs.x << 16); pi[1] = -__uint_as_float(rs.x & 0xffff0000u); pi[2] = -__uint_as_float(rs.y << 16); pi[3] = -__uint_as_float(rs.y & 0xffff0000u);
                        pi[4] = -__uint_as_float(rs.z << 16); pi[5] = -__uint_as_float(rs.z & 0xffff0000u); pi[6] = -__uint_as_float(rs.w << 16); pi[7] = -__uint_as_float(rs.w & 0xffff0000u); } }
                    __syncthreads();
                    FPRE(it + G);
                    fftl::run<false>(fre, fim, logL, tid, 2, 4608);
                    bf16_t* yb = BF(WS_HX) + (size_t)((isc ? TX : 0) + b * L) * DM + n0;
                    for (int p = tid; p < L; p += NTHREADS) { const int k1 = (int)(__brev((unsigned)p) >> (32 - logL)); const int pp = fftl::padi(p);
                        *(unsigned*)(yb + (size_t)k1 * DM) = cvt_pk_bf16(fre[pp] * oscale, fre[4608 + pp] * oscale); }
                }
#undef FPRE
                __syncthreads();
            }
        }
        else if (PHASE(7)) {
            modnorm_rows(FP(WS_XR), FP(WS_XR) + (size_t)TX * DM, TT, KIN(I_NORM2), mod + 3 * 1024, mod + 4 * 1024, BF(WS_HX), gw, NGW, lane);
        }
        else if (PHASE(6)) {
            LAS float* scr = (LAS float*)(lds + wave * 16384);
            tr_matrix(KIN(I_MIN), 416, 1024, 512, BF(W_MLAIN), 3, 416, 0, scr, gw, NGW, lane);
            tr_matrix(KIN(I_MUQ), 1536, 256, 1536, BF(W_WUQ), 0, 0, 0, scr, gw, NGW, lane);
            tr_matrix(KIN(I_MUKV), 2048, 128, 2048, BF(W_WUKV), 2, 0, 0, scr, gw, NGW, lane);
            tr_matrix(KIN(I_MWO), 1024, 1024, 1024, BF(W_WO), 0, 0, 0, scr, gw, NGW, lane);
            __syncthreads();
        }
        else if (PHASE(9)) {
            LAS float* scr = (LAS float*)(lds + wave * 16384);
            tr_matrix(KIN(I_FUP) + (size_t)1024 * 2 * DFF, 2 * DFF, 1024, 2 * DFF, BF(W_WUP), 1, 0, 0, scr, gw, NGW, lane);
            __syncthreads();
        }
        else if (PHASE(10)) {
            modnorm_rows(FP(WS_XR), FP(WS_XR) + (size_t)TX * DM, TT, KIN(I_NORM1) + 1024, mod + 9 * 6144 + 0 * 1024, mod + 9 * 6144 + 1 * 1024, BF(WS_HX), gw, NGW, lane);
        }
        else if (PHASE(11)) {
            LAS float* scr = (LAS float*)(lds + wave * 16384);
            tr_matrix(KIN(I_FDOWN) + (size_t)DFF * 1024, 1024, DFF, 1024, BF(W_WDOWN), 0, 0, 0, scr, gw, NGW, lane);
            __syncthreads();
        }
        else if (PHASE(12)) {
            const float* ab = FP(WS_ABUF);
            for (int row = gw; row < TT; row += NGW) { const float* ar = ab + (size_t)row * 512;
                const f32x4 q = *(const f32x4*)(ar + 4 * lane); const f32x2 kv = *(const f32x2*)(ar + 256 + 2 * lane);
                const float sq = wave_sum((q[0] * q[0] + q[1] * q[1]) + (q[2] * q[2] + q[3] * q[3])), sk = wave_sum(kv[0] * kv[0] + kv[1] * kv[1]);
                const float rq = 1.0f / sqrtf(sq * (1.f / 256.f) + EPS), rk = 1.0f / sqrtf(sk * (1.f / 128.f) + EPS);
                if (row < TX) { const f32x4 gq = *(const f32x4*)(KIN(I_MQAN) + 4 * lane); u32x2 w; w.x = cvt_pk_bf16(q[0] * rq * gq[0], q[1] * rq * gq[1]); w.y = cvt_pk_bf16(q[2] * rq * gq[2], q[3] * rq * gq[3]);
                    *(u32x2*)(BF(WS_AQN) + (size_t)row * 256 + 4 * lane) = w; }
                const f32x2 gk = *(const f32x2*)(KIN(I_MKVAN) + 2 * lane);
                *(unsigned*)(BF(WS_CKVN) + (size_t)row * 128 + 2 * lane) = cvt_pk_bf16(kv[0] * rk * gk[0], kv[1] * rk * gk[1]);
                if (lane < 32) FP(WS_KPE)[(size_t)row * 32 + lane] = ar[384 + lane];
            }
        }
        else if (PHASE(14)) {
            const int h = lane >> 2, q = lane & 3;
            for (int it = TX + gw; it < TX + TT; it += NGW) {
                const bool isq = it < TX; const int row = isq ? it : it - TX;
                const bf16_t* bsrc = isq ? BF(WS_QB) + (size_t)row * 1536 + h * 96 : BF(WS_KRAW) + (size_t)row * 1024 + h * 64;
                const float* kper = FP(WS_KPE) + (size_t)row * 32;
                const float* gn = isq ? KIN(I_MQN) : KIN(I_MKN);
                float v[3][8]; float ss = 0.f;
#pragma unroll
                for (int j = 0; j < 3; ++j) { const int d0 = 8 * (3 * q + j); const bool frombf = isq || d0 < 64;
                    const int db = frombf ? d0 : 0, dk = frombf ? 0 : d0 - 64;
                    const u32x4 raw = *(const u32x4*)(bsrc + db); const f32x4 t0 = *(const f32x4*)(kper + dk), t1 = *(const f32x4*)(kper + dk + 4);
                    v[j][0] = frombf ? __uint_as_float(raw.x << 16) : t0[0]; v[j][1] = frombf ? __uint_as_float(raw.x & 0xffff0000u) : t0[1];
                    v[j][2] = frombf ? __uint_as_float(raw.y << 16) : t0[2]; v[j][3] = frombf ? __uint_as_float(raw.y & 0xffff0000u) : t0[3];
                    v[j][4] = frombf ? __uint_as_float(raw.z << 16) : t1[0]; v[j][5] = frombf ? __uint_as_float(raw.z & 0xffff0000u) : t1[1];
                    v[j][6] = frombf ? __uint_as_float(raw.w << 16) : t1[2]; v[j][7] = frombf ? __uint_as_float(raw.w & 0xffff0000u) : t1[3];
#pragma unroll
                    for (int e = 0; e < 8; ++e) ss += v[j][e] * v[j][e]; }
                ss += __shfl_xor(ss, 1); ss += __shfl_xor(ss, 2);
                const float rstd = 1.0f / sqrtf(ss * (1.f / 96.f) + EPS);
#pragma unroll
                for (int j = 0; j < 3; ++j) { const int d0 = 8 * (3 * q + j); const f32x4 g0 = *(const f32x4*)(gn + d0), g1 = *(const f32x4*)(gn + d0 + 4);
#pragma unroll
                    for (int e = 0; e < 4; ++e) { v[j][e] *= rstd * g0[e]; v[j][4 + e] *= rstd * g1[e]; } }
                if (row < TX) { const int t = row & 4095; const float pr = (float)(t >> 6), pc = (float)(t & 63);
#pragma unroll
                    for (int e = 0; e < 8; ++e) { const float invf = exp2f(-(float)e * (13.287712379549449f / 8.f));
                        const float rr_ = pr * invf * 0.15915494309189535f, rc_ = pc * invf * 0.15915494309189535f;
                        const float sr = __builtin_amdgcn_sinf(rr_), cr = __builtin_amdgcn_cosf(rr_), sc_ = __builtin_amdgcn_sinf(rc_), cc = __builtin_amdgcn_cosf(rc_);
                        const float send = (q == 2) ? v[2][e] : v[0][e]; const float recv = __shfl_xor(send, 1);
                        if (q == 2) v[2][e] = v[2][e] * cr - recv * sr;
                        if (q == 3) { v[0][e] = recv * sr + v[0][e] * cr; const float b1 = v[1][e], b2 = v[2][e]; v[1][e] = b1 * cc - b2 * sc_; v[2][e] = b1 * sc_ + b2 * cc; } } }
                const float osc = isq ? att::QSCALE : 1.f;
                bf16_t* dst = (isq ? BF(WS_QB) : BF(WS_KB)) + (size_t)row * 1536 + h * 96;
#pragma unroll
                for (int j = 0; j < 3; ++j) { const int d0 = 8 * (3 * q + j); u32x4 w; w.x = cvt_pk_bf16(v[j][0] * osc, v[j][1] * osc); w.y = cvt_pk_bf16(v[j][2] * osc, v[j][3] * osc);
                    w.z = cvt_pk_bf16(v[j][4] * osc, v[j][5] * osc); w.w = cvt_pk_bf16(v[j][6] * osc, v[j][7] * osc); *(u32x4*)(dst + d0) = w; }
            }
        }
        else if (PHASE(15)) {
            const int vcu = (G % 8 == 0) ? (bid % 8) * (G / 8) + bid / 8 : bid;
            const int per = (2048 + G - 1) / G;
            int tid3 = tid; asm volatile("" : "+v"(tid3));
            for (int k = 0; k < per; ++k) {
                int un = vcu * per + k;
                if (G == 256) {
                    const int xcd = vcu >> 5, loc = vcu & 31; un = ((xcd * 16 + 2 * k + (loc >> 4)) << 4) | (loc & 15); }
                if (un >= 2048) break;
                const int bh = un >> 4, qb = un & 15;
                att::attn_unit(bh >> 4, bh & 15, qb, BF(WS_QB), BF(WS_KB), BF(WS_VB), BF(WS_OB), lds, tid3, KIN(I_MQN)); }
        }
        else if (PHASE(17)) {
            modnorm_rows(FP(WS_XR), FP(WS_XR) + (size_t)TX * DM, TX, KIN(I_NORM2) + 1024, mod + 9 * 6144 + 3 * 1024, mod + 9 * 6144 + 4 * 1024, BF(WS_HX), gw, NGW, lane);
        }
        if (ph + 1 < ph_hi) { __syncthreads(); if (HI == 1) cg::this_grid().sync(); else { ++nbar; grid_barrier((unsigned*)(ws + WS_BAR), nbar * (unsigned)G, tid); } }
        if (DUP_PH >= 0 && ph == DUP_PH && dup_left > 0) { --dup_left; --ph; }
    }
}
#undef PHASE
#undef BF
#undef FP
__global__ void __launch_bounds__(NTHREADS, 2) mega(Args a) {
    extern __shared__ __attribute__((aligned(16))) unsigned char lds_raw[];
    LAS unsigned char* lds = (LAS unsigned char*)lds_raw;
    const int G = gridDim.x;
    const int ph_lo = a.ph_lo, ph_hi = a.ph_hi;
    const int wave0 = __builtin_amdgcn_readfirstlane((int)threadIdx.x >> 6);
    unsigned nbar = 0;
    run_phases<0, 1>(lds, ph_lo, ph_hi, G, wave0, nbar);
    run_phases<1, 10>(lds, ph_lo, ph_hi, G, wave0, nbar);
    run_phases<10, 20>(lds, ph_lo, ph_hi, G, wave0, nbar);
}

extern "C" void kernel_launch(void* const* d_in, const int* in_sizes, int n_in, void* d_out, int out_size, void* d_ws, size_t ws_size, hipStream_t stream) {
    static int grid = 0;
    if (grid == 0) {
        if (n_in != 33 || ws_size < WS_END) { fprintf(stderr, "kernel_launch: need 33 inputs and >= %zu bytes of workspace; got %d, %zu\n", (size_t)WS_END, n_in, ws_size); grid = -1; return; }
        int dev = 0, cus = 0, per_cu = 0;
        hipGetDevice(&dev); hipDeviceGetAttribute(&cus, hipDeviceAttributeMultiprocessorCount, dev);
        if (hipFuncSetAttribute((const void*)mega, hipFuncAttributeMaxDynamicSharedMemorySize, LDS_BYTES) != hipSuccess) { fprintf(stderr, "kernel_launch: hipFuncSetAttribute failed\n"); grid = -1; return; }
        hipOccupancyMaxActiveBlocksPerMultiprocessor(&per_cu, (const void*)mega, NTHREADS, LDS_BYTES);
        if (per_cu < 1) { fprintf(stderr, "kernel_launch: occupancy query says %d blocks per CU\n", per_cu); per_cu = 1; }
        (void)hipGetLastError();
        grid = cus;
    }
    if (grid < 0) return;
    Args a{};
    for (int i = 0; i < 33; ++i) a.in[i] = (const float*)d_in[i];
    a.out = (float*)d_out; a.ws = (unsigned char*)d_ws;
#if MK_COOP
    (void)hipMemsetAsync((char*)d_ws + WS_BAR, 0, 256, stream);
    a.ph_lo = 0; a.ph_hi = NPH;
    void* args[] = {&a};
    hipError_t e = hipLaunchCooperativeKernel((const void*)mega, dim3(grid), dim3(NTHREADS), args, LDS_BYTES, stream);
    if (e != hipSuccess) fprintf(stderr, "cooperative launch failed: %s (grid %d)\n", hipGetErrorString(e), grid);
#else
#ifndef NPH_RUN
#define NPH_RUN NPH
#endif
    for (int ph = 0; ph < NPH_RUN; ++ph) { a.ph_lo = ph; a.ph_hi = ph + 1;
        hipLaunchKernelGGL(mega, dim3(grid), dim3(NTHREADS), LDS_BYTES, stream, a); }
#endif
}
```

```cpp
#include <hip/hip_runtime.h>
#include <hip/hip_cooperative_groups.h>
#include <cstdio>
#include <cstdint>
namespace cg = cooperative_groups;

#ifndef MK_COOP
#define MK_COOP 1
#endif

#define LAS __attribute__((address_space(3)))
#define DEV __device__ __forceinline__
typedef unsigned short bf16_t;
typedef short bf16x8 __attribute__((ext_vector_type(8)));
typedef short s16x4 __attribute__((ext_vector_type(4)));
typedef float f32x4 __attribute__((ext_vector_type(4)));
typedef float f32x2 __attribute__((ext_vector_type(2)));
typedef float f32x16 __attribute__((ext_vector_type(16)));
typedef unsigned u32x4 __attribute__((ext_vector_type(4)));
typedef unsigned u32x2 __attribute__((ext_vector_type(2)));

constexpr int DM = 1024, NB = 8, SEQ = 4096, CTXL = 256;
constexpr int TX = NB * SEQ, TC = NB * CTXL, TT = TX + TC;
constexpr int DFF = 2816;
constexpr float EPS = 1e-6f;
constexpr int NPH = 20;
constexpr int NTHREADS = 512;
constexpr int RING_BYTES = 131072, MISC_OFF = RING_BYTES, LDS_BYTES = 147456;

constexpr size_t MiB = (size_t)1 << 20;
constexpr size_t WS_MOD = 0;
constexpr size_t WS_H3X = 1 * MiB, WS_H3C = 2 * MiB;
constexpr size_t WS_SMALL = 2 * MiB + 512 * 1024;
constexpr size_t WS_W = 4 * MiB;
constexpr size_t W_W1T = WS_W, W_WOUT = WS_W + 5 * MiB, W_WUP = WS_W + 7 * MiB, W_WDOWN = WS_W + 18 * MiB;
constexpr size_t W_MLAIN = WS_W, W_WUQ = WS_W + 1 * MiB, W_WUKV = WS_W + 2 * MiB, W_WO = WS_W + 3 * MiB;
constexpr size_t WS_XR = 28 * MiB;
constexpr size_t WS_PQT = 28 * MiB, WS_PQTC = 92 * MiB, WS_WT = 96 * MiB, WS_WTC = 128 * MiB, WS_X0C = 130 * MiB, WS_X0CC = 162 * MiB;
constexpr size_t WS_HX = 164 * MiB;
constexpr size_t WS_BIG = 232 * MiB;
constexpr size_t WS_T1 = 232 * MiB, WS_T2 = 296 * MiB, WS_HT = 360 * MiB, WS_HTC = 456 * MiB, WS_KF = 462 * MiB, WS_KFC = 494 * MiB;
constexpr size_t WS_FILT = 496 * MiB, WS_FILTC = 504 * MiB, WS_T1C = 505 * MiB, WS_CSC = 505 * MiB + 512 * 1024;
constexpr size_t WS_YT = WS_HT, WS_YTC = WS_HTC;
constexpr size_t WS_ACT = 232 * MiB;
constexpr size_t WS_SB = 420 * MiB;
constexpr size_t WS_SSQ2 = 2 * MiB + 512 * 1024;
constexpr size_t WS_ABUF = 232 * MiB, WS_KRAW = 232 * MiB, WS_OB = 232 * MiB, WS_AQN = 300 * MiB, WS_CKVN = 316 * MiB, WS_KB = 300 * MiB, WS_KPE = 402 * MiB, WS_QB = 416 * MiB;
constexpr size_t WS_VB = WS_HX;
constexpr size_t WS_END = 512 * MiB;

DEV unsigned cvt_pk_bf16(float lo, float hi) { unsigned r; asm volatile("v_cvt_pk_bf16_f32 %0, %1, %2" : "=v"(r) : "v"(lo), "v"(hi)); return r; }
DEV float bf2f(unsigned short h) { return __uint_as_float(((unsigned)h) << 16); }
DEV float wave_sum(float v) {
#pragma unroll
    for (int o = 1; o < 64; o <<= 1) v += __shfl_xor(v, o);
    return v;
}
DEV float silu_f(float x) { return x / (1.f + __expf(-x)); }

namespace pg8 {
constexpr int BM = 256, BK = 64, HALF = 128, HTB = HALF * BK * 2, STAGE_BYTES = 8 * HTB;
__host__ __device__ __forceinline__ int lds_byte(int r, int c) { const int st = (r >> 4) * 2 + (c >> 5), rr = r & 15, cc = c & 31, ob = rr * 64 + cc * 2; return st * 1024 + (ob ^ (((ob >> 9) & 1) << 5)); }
__host__ __device__ __forceinline__ void stage_rc(int b, int& R, int& C) { const int st = b / 1024, sb = b % 1024, swz = sb ^ (((sb >> 9) & 1) << 5); R = (st >> 1) * 16 + swz / 64; C = (st & 1) * 32 + (swz % 64) / 2; }
__host__ __device__ __forceinline__ int perm32(int rho) { const int n = rho >> 4, i = rho & 15; return 8 * (i >> 2) + 4 * n + (i & 3); }

struct Unit { int pm, pn, pz; long arow, brow; };
struct Gemm { const bf16_t* A; const bf16_t* Bt; int lda, ldb, K; long sAz, sBz; };

struct Sched {
    int nM, nN, nZ, G, c, mode;
    DEV bool next(int i, Unit& u) const {
        const long L = (long)i * G + c; const int per = nM * nN; if (L >= (long)per * nZ) return false;
        u.pz = (int)(L / per); int wgid = (int)(L % per);
        { const int q = per / 8, r = per % 8, xcd = wgid % 8, off = wgid / 8; wgid = (xcd < r ? xcd * (q + 1) : r * (q + 1) + (xcd - r) * q) + off; }
        const int nig = 8 * nN, gid = wgid / nig, fm = gid * 8, gsz = (nM - fm) < 8 ? (nM - fm) : 8;
        u.pm = fm + ((wgid % nig) % gsz); u.pn = (wgid % nig) / gsz;
        u.brow = (long)u.pn * 256;
        u.arow = (long)u.pm * 256;
        return true;
    }
};

template <class Epi>
DEV void gemm_phase(LAS unsigned char* lds, const Gemm g, const Sched& S, const Epi& E, const int tid) {
    const int wid = __builtin_amdgcn_readfirstlane(tid >> 6), lane = tid & 63, wr = wid >> 2, wc = wid & 3, fr = lane & 15, fq = lane >> 4;
    const int K = g.K, nt = K / BK;
    unsigned voffA[2], voffB[2];
#pragma unroll
    for (int i = 0; i < 2; ++i) { int R, C; stage_rc(tid * 16 + i * 8192, R, C); const int Rb = Epi::PERM ? ((R & ~31) + perm32(R & 31)) : R;
        voffA[i] = (unsigned)(R * g.lda + C) * 2u; voffB[i] = (unsigned)(Rb * g.ldb + C) * 2u; }
    const size_t kstep = (size_t)(BK * 2);
    const size_t hstepA = (size_t)HALF * g.lda * 2, hstepB = (size_t)HALF * g.ldb * 2;
    const unsigned ldsw = (unsigned)wid * 1024u;
    const int aoff = lds_byte(wr * 64 + fr, fq * 8), boff = lds_byte(wc * 32 + fr, fq * 8);
#define PG8_SA(b, h) (((b) * 2 + (h)) * HTB)
#define PG8_SB(b, h) ((4 + (b) * 2 + (h)) * HTB)
#define PG8_STAGE(bufoff, gbase, voff) do { _Pragma("unroll") for (int _i = 0; _i < 2; ++_i) \
        __builtin_amdgcn_global_load_lds((const unsigned*)((const char*)(gbase) + (voff)[_i]), (LAS unsigned*)(lds + (bufoff) + ldsw + _i * 8192), 16, 0, 0); } while (0)
#define PG8_LDA(dst, b, h) do { _Pragma("unroll") for (int m = 0; m < 4; ++m) _Pragma("unroll") for (int k = 0; k < 2; ++k) dst[m][k] = *(const LAS bf16x8*)(lds + PG8_SA(b, h) + aoff + m * 2048 + k * 1024); } while (0)
#define PG8_LDB(dst, b, h) do { _Pragma("unroll") for (int n = 0; n < 2; ++n) _Pragma("unroll") for (int k = 0; k < 2; ++k) dst[n][k] = *(const LAS bf16x8*)(lds + PG8_SB(b, h) + boff + n * 2048 + k * 1024); } while (0)
#define PG8_MMA(ai, bj, At, Bt) do { __builtin_amdgcn_s_setprio(1); _Pragma("unroll") for (int m = 0; m < 4; ++m) _Pragma("unroll") for (int n = 0; n < 2; ++n) _Pragma("unroll") for (int k = 0; k < 2; ++k) \
        acc[ai][bj][m][n] = __builtin_amdgcn_mfma_f32_16x16x32_bf16(Bt[n][k], At[m][k], acc[ai][bj][m][n], 0, 0, 0); __builtin_amdgcn_s_setprio(0); } while (0)
#define PG8_WAIT_V(n) asm volatile("s_waitcnt vmcnt(" #n ")" ::: "memory")
#define PG8_WAIT_L(n) asm volatile("s_waitcnt lgkmcnt(" #n ")" ::: "memory")
#define PG8_BAR __builtin_amdgcn_s_barrier()
#define PG8_SCHED __builtin_amdgcn_sched_barrier(0)
    Unit cur, nxt; int ui = 0;
    if (!S.next(0, cur)) return;
    f32x4 acc[2][2][4][2];
#pragma unroll
    for (int a = 0; a < 2; ++a)
#pragma unroll
        for (int b = 0; b < 2; ++b)
#pragma unroll
            for (int m = 0; m < 4; ++m)
#pragma unroll
                for (int n = 0; n < 2; ++n) acc[a][b][m][n] = (f32x4){0.f, 0.f, 0.f, 0.f};
    bf16x8 At[4][2], B0[2][2], B1[2][2];
    const char* cA = (const char*)g.A + ((long)cur.pz * g.sAz + cur.arow * (long)g.lda) * 2;
    const char* cB = (const char*)g.Bt + ((long)cur.pz * g.sBz + cur.brow * (long)g.ldb) * 2;
    PG8_STAGE(PG8_SB(0, 0), cB, voffB); PG8_STAGE(PG8_SB(0, 1), cB + hstepB, voffB); PG8_STAGE(PG8_SA(0, 0), cA, voffA); PG8_STAGE(PG8_SA(0, 1), cA + hstepA, voffA);
    if (wr == 1) PG8_BAR;
    PG8_WAIT_V(2); PG8_BAR;
    PG8_STAGE(PG8_SB(1, 0), cB + kstep, voffB); PG8_STAGE(PG8_SA(1, 0), cA + kstep, voffA); PG8_STAGE(PG8_SB(1, 1), cB + hstepB + kstep, voffB);
    PG8_WAIT_V(6); PG8_BAR;
    for (;;) {
        const bool has_next = S.next(ui + 1, nxt);
        const char* nA = has_next ? (const char*)g.A + ((long)nxt.pz * g.sAz + nxt.arow * (long)g.lda) * 2 : cA;
        const char* nB = has_next ? (const char*)g.Bt + ((long)nxt.pz * g.sBz + nxt.brow * (long)g.ldb) * 2 : cB;
        for (int t = 0; t < nt; t += 2) {
            const bool last = (t == nt - 2);
            const char* a1 = cA + (size_t)(t + 1) * kstep;
            const char* a2 = last ? nA : cA + (size_t)(t + 2) * kstep; const char* b2 = last ? nB : cB + (size_t)(t + 2) * kstep;
            const char* a3 = a2 + kstep; const char* b3 = b2 + kstep;
            PG8_LDB(B0, 0, 0); PG8_LDB(B1, 0, 1); PG8_SCHED; PG8_LDA(At, 0, 0); PG8_STAGE(PG8_SA(1, 1), a1 + hstepA, voffA);
            PG8_WAIT_V(8); PG8_WAIT_L(0); PG8_BAR; PG8_MMA(0, 0, At, B0); PG8_MMA(0, 1, At, B1); PG8_BAR; PG8_SCHED;
            PG8_LDA(At, 0, 1); PG8_STAGE(PG8_SB(0, 0), b2, voffB); PG8_STAGE(PG8_SB(0, 1), b2 + hstepB, voffB); PG8_STAGE(PG8_SA(0, 0), a2, voffA);
            PG8_WAIT_V(8); PG8_WAIT_L(0); PG8_BAR; PG8_MMA(1, 0, At, B0); PG8_MMA(1, 1, At, B1); PG8_BAR; PG8_SCHED;
            PG8_LDB(B0, 1, 0); PG8_LDB(B1, 1, 1); PG8_SCHED; PG8_LDA(At, 1, 0); PG8_STAGE(PG8_SA(0, 1), a2 + hstepA, voffA);
            PG8_WAIT_V(8); PG8_WAIT_L(0); PG8_BAR; PG8_MMA(0, 0, At, B0); PG8_MMA(0, 1, At, B1); PG8_BAR; PG8_SCHED;
            PG8_LDA(At, 1, 1); PG8_STAGE(PG8_SB(1, 0), b3, voffB); PG8_STAGE(PG8_SB(1, 1), b3 + hstepB, voffB); PG8_STAGE(PG8_SA(1, 0), a3, voffA);
            PG8_WAIT_V(8); PG8_WAIT_L(0); PG8_BAR; PG8_MMA(1, 0, At, B0); PG8_MMA(1, 1, At, B1); PG8_BAR; PG8_SCHED;
        }
        if (wr == 0) PG8_BAR;
        E(acc, cur, wr, wc, fr, fq, lds + MISC_OFF);
        if (!has_next) break;
#pragma unroll
        for (int a = 0; a < 2; ++a)
#pragma unroll
            for (int b = 0; b < 2; ++b)
#pragma unroll
                for (int m = 0; m < 4; ++m)
#pragma unroll
                    for (int n = 0; n < 2; ++n) acc[a][b][m][n] = (f32x4){0.f, 0.f, 0.f, 0.f};
        cur = nxt; cA = nA; cB = nB; ++ui;
        if (wr == 1) PG8_BAR;
    }
    PG8_WAIT_V(0);
    PG8_BAR;
#undef PG8_SA
#undef PG8_SB
#undef PG8_STAGE
#undef PG8_LDA
#undef PG8_LDB
#undef PG8_MMA
}

typedef f32x4 Acc[2][2][4][2];

struct EpiG1 {
    static constexpr bool PERM = true;
    bf16_t* PQt; bf16_t* Ht; bf16_t* PQtc; bf16_t* Htc;
    DEV void operator()(const Acc& acc, const Unit& u, int wr, int wc, int fr, int fq, LAS unsigned char*) const {
        const bool isx = u.pn < 128; const int b = isx ? (u.pn >> 4) : (u.pn - 128); const int tb = isx ? ((u.pn & 15) * 256) : 0;
#pragma unroll
        for (int ai = 0; ai < 2; ++ai)
#pragma unroll
            for (int m = 0; m < 4; ++m) {
                const int mrow = u.pm * 256 + ai * 128 + wr * 64 + m * 16 + fr;
                bf16_t* rowp;
                if (mrow < 1024) { const int nf = mrow >> 1, part = mrow & 1;
                    rowp = isx ? PQt + ((size_t)(b * 512 + nf) * 8192 + part * 4096) : PQtc + ((size_t)(b * 512 + nf) * 512 + part * 256); }
                else { const int cp = mrow - 1024; rowp = isx ? Ht + (size_t)(b * 1536 + cp) * 4096 : Htc + (size_t)(b * 1536 + cp) * 256; }
#pragma unroll
                for (int bj = 0; bj < 2; ++bj) { const int t0 = tb + bj * 128 + wc * 32 + 8 * fq;
                    const f32x4 v0 = acc[ai][bj][m][0], v1 = acc[ai][bj][m][1]; u32x4 w;
                    w.x = cvt_pk_bf16(v0[0], v0[1]); w.y = cvt_pk_bf16(v0[2], v0[3]); w.z = cvt_pk_bf16(v1[0], v1[1]); w.w = cvt_pk_bf16(v1[2], v1[3]);
                    *(u32x4*)(rowp + t0) = w; }
                asm volatile("" ::: "memory");
            }
    }
};
struct EpiBf16 {
    static constexpr bool PERM = true;
    bf16_t* O0; bf16_t* O1; int ldc, split, rowbase, zrows; float scale; const float* rs; int rsi; float rsdiv;
    DEV void operator()(const Acc& acc, const Unit& u, int wr, int wc, int fr, int fq, LAS unsigned char*) const {
        asm volatile("" : "+v"(fr), "+v"(fq));
        int colt = u.pn * 256; bf16_t* base = O0; if (split && colt >= split) { base = O1; colt -= split; }
        const int row0 = rowbase + u.pz * zrows + u.pm * 256 + wr * 64 + fr, col0 = colt + wc * 32 + 8 * fq;
#pragma unroll
        for (int ai = 0; ai < 2; ++ai)
#pragma unroll
            for (int m = 0; m < 4; ++m) { const int row = row0 + ai * 128 + m * 16; bf16_t* rowp = base + (size_t)row * ldc + col0;
                const float sc = rs ? scale / sqrtf(rs[(size_t)row * 2 + rsi] * rsdiv + EPS) : scale;
#pragma unroll
                for (int bj = 0; bj < 2; ++bj) { const f32x4 v0 = acc[ai][bj][m][0] * sc, v1 = acc[ai][bj][m][1] * sc; u32x4 w;
                    w.x = cvt_pk_bf16(v0[0], v0[1]); w.y = cvt_pk_bf16(v0[2], v0[3]); w.z = cvt_pk_bf16(v1[0], v1[1]); w.w = cvt_pk_bf16(v1[2], v1[3]);
                    *(u32x4*)(rowp + bj * 128) = w; } }
    }
};
struct EpiF32 {
    static constexpr bool PERM = false;
    float* O; int ldc;
    DEV void operator()(const Acc& acc, const Unit& u, int wr, int wc, int fr, int fq, LAS unsigned char*) const {
        const int row0 = u.pm * 256 + wr * 64 + fr, col0 = u.pn * 256 + wc * 32 + 4 * fq;
#pragma unroll
        for (int ai = 0; ai < 2; ++ai)
#pragma unroll
            for (int m = 0; m < 4; ++m) { float* rowp = O + (size_t)(row0 + ai * 128 + m * 16) * ldc + col0;
#pragma unroll
                for (int bj = 0; bj < 2; ++bj)
#pragma unroll
                    for (int n = 0; n < 2; ++n) *(f32x4*)(rowp + bj * 128 + n * 16) = acc[ai][bj][m][n]; }
    }
};
struct EpiMla {
    static constexpr bool PERM = false;
    bf16_t* aqn; bf16_t* ckvn; float* kpe; float* ssq; const float* gq; const float* gk;
    DEV void operator()(const Acc& acc, const Unit& u, int wr, int wc, int fr, int fq, LAS unsigned char* misc) const {
        asm volatile("" : "+v"(fr), "+v"(fq));
        const int rt = u.pm * 256; const bool isq = (u.pn == 0);
#pragma unroll
        for (int ai = 0; ai < 2; ++ai)
#pragma unroll
            for (int m = 0; m < 4; ++m) { const int rl = ai * 128 + wr * 64 + m * 16 + fr, row = rt + rl; float sq = 0.f;
#pragma unroll
                for (int bj = 0; bj < 2; ++bj)
#pragma unroll
                    for (int n = 0; n < 2; ++n) { const int c = bj * 128 + wc * 32 + n * 16 + 4 * fq; const f32x4 a = acc[ai][bj][m][n];
                        if (isq) { sq += (a[0] * a[0] + a[1] * a[1]) + (a[2] * a[2] + a[3] * a[3]);
                            if (row < TX) { const f32x4 g = *(const f32x4*)(gq + c); u32x2 w; w.x = cvt_pk_bf16(a[0] * g[0], a[1] * g[1]); w.y = cvt_pk_bf16(a[2] * g[2], a[3] * g[3]); *(u32x2*)(aqn + (size_t)row * 256 + c) = w; } }
                        else if (bj == 0) { sq += (a[0] * a[0] + a[1] * a[1]) + (a[2] * a[2] + a[3] * a[3]);
                            const f32x4 g = *(const f32x4*)(gk + c); u32x2 w; w.x = cvt_pk_bf16(a[0] * g[0], a[1] * g[1]); w.y = cvt_pk_bf16(a[2] * g[2], a[3] * g[3]); *(u32x2*)(ckvn + (size_t)row * 128 + c) = w; }
                        else if (wc == 0) { *(f32x4*)(kpe + (size_t)row * 32 + n * 16 + 4 * fq) = a; } }
                sq += __shfl_xor(sq, 16); sq += __shfl_xor(sq, 32); if (fq == 0) ((LAS float*)misc)[rl * 4 + wc] = sq;
                if (m & 1) asm volatile("" ::: "memory"); }
        asm volatile("s_waitcnt lgkmcnt(0)" ::: "memory"); __builtin_amdgcn_s_barrier(); asm volatile("" ::: "memory");
        const int t_ = (wr * 4 + wc) * 64 + fq * 16 + fr;
        if (t_ < 256) { const f32x4 p4 = *(const LAS f32x4*)((LAS float*)misc + t_ * 4); ssq[(size_t)(rt + t_) * 2 + u.pn] = (p4[0] + p4[1]) + (p4[2] + p4[3]); }
        asm volatile("s_waitcnt lgkmcnt(0)" ::: "memory"); __builtin_amdgcn_s_barrier(); asm volatile("" ::: "memory");
    }
};
struct EpiRes {
    static constexpr bool PERM = false;
    const float* baseX; const float* baseC; float* outX; float* outC; const float* gate;
    DEV void operator()(const Acc& acc, const Unit& u, int wr, int wc, int fr, int fq, LAS unsigned char*) const {
        asm volatile("" : "+v"(fr), "+v"(fq));
        const int rt = u.pm * 256; const bool isx = rt < TX; const int mr = isx ? (rt >> 12) : 8;
        const float* bp = isx ? baseX + (size_t)rt * DM : baseC + (size_t)(rt - TX) * DM;
        float* op = isx ? outX + (size_t)rt * DM : outC + (size_t)(rt - TX) * DM;
        const int col0 = u.pn * 256 + wc * 32 + 4 * fq; const float* gp = gate + (size_t)mr * 6144 + col0;
        f32x4 gv[2][2];
#pragma unroll
        for (int bj = 0; bj < 2; ++bj)
#pragma unroll
            for (int n = 0; n < 2; ++n) gv[bj][n] = *(const f32x4*)(gp + bj * 128 + n * 16);
#pragma unroll
        for (int ai = 0; ai < 2; ++ai)
#pragma unroll
            for (int m = 0; m < 4; ++m) { const size_t off = (size_t)(ai * 128 + wr * 64 + m * 16 + fr) * DM + col0;
#pragma unroll
                for (int bj = 0; bj < 2; ++bj)
#pragma unroll
                    for (int n = 0; n < 2; ++n) { const f32x4 bs = *(const f32x4*)(bp + off + bj * 128 + n * 16);
                        *(f32x4*)(op + off + bj * 128 + n * 16) = bs + gv[bj][n] * acc[ai][bj][m][n]; }
                if (m & 1) asm volatile("" ::: "memory"); }
    }
};
struct EpiHF {
    static constexpr bool PERM = false;
    bf16_t* Yt; const float* KF; const float* l1inv; int Nh;
    DEV void operator()(const Acc& acc, const Unit& u, int wr, int wc, int fr, int fq, LAS unsigned char*) const {
        const int ldk = 2 * Nh; const float wN = 1.0f / (float)(2 * Nh);
#pragma unroll
        for (int ai = 0; ai < 2; ++ai)
#pragma unroll
            for (int m = 0; m < 4; ++m) { const int r = u.pm * 256 + ai * 128 + wr * 64 + m * 16 + fr, c = r & 511; const float s = l1inv[c] * wN;
                const float* k1p = KF + (size_t)c * ldk; const float* k2p = KF + (size_t)(512 + c) * ldk; bf16_t* yp = Yt + (size_t)r * ldk;
#pragma unroll
                for (int bj = 0; bj < 2; ++bj)
#pragma unroll
                    for (int n = 0; n < 2; ++n) { const int c0 = u.pn * 256 + bj * 128 + wc * 32 + n * 16 + 4 * fq, f0 = c0 >> 1;
                        const f32x4 k1 = *(const f32x4*)(k1p + c0), k2 = *(const f32x4*)(k2p + c0), a = acc[ai][bj][m][n];
                        const float kr0 = k1[0] + k2[0], ki0 = k1[1] - k2[1], kr1 = k1[2] + k2[2], ki1 = k1[3] - k2[3];
                        const float w0 = (c0 == 0) ? s : 2.f * s, w1 = 2.f * s;
                        const float yr0 = (a[0] * kr0 - a[1] * ki0) * w0, yi0 = (a[0] * ki0 + a[1] * kr0) * w0;
                        const float yr1 = (a[2] * kr1 - a[3] * ki1) * w1, yi1 = (a[2] * ki1 + a[3] * kr1) * w1;
                        *(unsigned*)(yp + f0) = cvt_pk_bf16(yr0, yr1); *(unsigned*)(yp + Nh + f0) = cvt_pk_bf16(yi0, yi1); }
                asm volatile("" ::: "memory"); }
    }
};
struct EpiHI {
    static constexpr bool PERM = false;
    bf16_t* ycat; const bf16_t* Wt; const bf16_t* x0c; const float* ynq; const float* bias; int L, rowbase;
    DEV void operator()(const Acc& acc, const Unit& u, int wr, int wc, int fr, int fq, LAS unsigned char*) const {
#pragma unroll
        for (int ai = 0; ai < 2; ++ai)
#pragma unroll
            for (int m = 0; m < 4; ++m) { const int r = u.pm * 256 + ai * 128 + wr * 64 + m * 16 + fr, b = r >> 9, c = r & 511; const float ny = ynq[r], bs = bias[c];
                const bf16_t* wp = Wt + (size_t)r * L; const bf16_t* xp = x0c + (size_t)r * L;
                bf16_t* op = ycat + (size_t)(rowbase + b * L) * DM + 512 + c;
#pragma unroll
                for (int bj = 0; bj < 2; ++bj)
#pragma unroll
                    for (int n = 0; n < 2; ++n) { const int t0 = u.pn * 256 + bj * 128 + wc * 32 + n * 16 + 4 * fq;
                        const u32x2 wv = *(const u32x2*)(wp + t0), xv = *(const u32x2*)(xp + t0); const f32x4 a = acc[ai][bj][m][n];
                        const float w0 = __uint_as_float(wv.x << 16), w1 = __uint_as_float(wv.x & 0xffff0000u), w2 = __uint_as_float(wv.y << 16), w3 = __uint_as_float(wv.y & 0xffff0000u);
                        const float x0 = __uint_as_float(xv.x << 16), x1 = __uint_as_float(xv.x & 0xffff0000u), x2 = __uint_as_float(xv.y << 16), x3 = __uint_as_float(xv.y & 0xffff0000u);
                        const float y0 = x0 * (a[0] + ny + w0 * bs), y1 = x1 * (a[1] - ny + w1 * bs), y2 = x2 * (a[2] + ny + w2 * bs), y3 = x3 * (a[3] - ny + w3 * bs);
                        const unsigned p01 = cvt_pk_bf16(y0, y1), p23 = cvt_pk_bf16(y2, y3);
                        op[(size_t)(t0 + 0) * DM] = (bf16_t)(p01 & 0xffffu); op[(size_t)(t0 + 1) * DM] = (bf16_t)(p01 >> 16);
                        op[(size_t)(t0 + 2) * DM] = (bf16_t)(p23 & 0xffffu); op[(size_t)(t0 + 3) * DM] = (bf16_t)(p23 >> 16); }
                asm volatile("" ::: "memory"); }
    }
};
struct EpiFFN {
    static constexpr bool PERM = true;
    bf16_t* act; const float* cw; const float* cb; float* sb;
    DEV void operator()(const Acc& acc, const Unit& u, int wr, int wc, int fr, int fq, LAS unsigned char* misc) const {
        asm volatile("" : "+v"(fr), "+v"(fq));
        const int lane = fq * 16 + fr;
        const int sbase = u.pm * 256, s0 = 0;
        float* sbp = sb + (size_t)u.pm * 6 * DFF;
        LAS float* xl = (LAS float*)misc;
        LAS float* xf = xl + 512;
#pragma unroll
        for (int ai = 0; ai < 2; ++ai) { const int q = 2 * ai + wr;
#pragma unroll
            for (int n = 0; n < 2; ++n) { const int cc = wc * 32 + 8 * fq + 4 * n;
                if (fr == 15) *(LAS f32x4*)(xl + q * 128 + cc) = acc[ai][0][3][n];
                if (fr == 0) *(LAS f32x4*)(xf + q * 128 + cc) = acc[ai][0][0][n]; } }
        asm volatile("s_waitcnt lgkmcnt(0)" ::: "memory"); __builtin_amdgcn_s_barrier(); asm volatile("" ::: "memory");
#define ROR1(x) __int_as_float(__builtin_amdgcn_update_dpp(0, __float_as_int(x), 0x121, 0xf, 0xf, false))
#define ROR15(x) __int_as_float(__builtin_amdgcn_update_dpp(0, __float_as_int(x), 0x12F, 0xf, 0xf, false))
#pragma unroll
        for (int n = 0; n < 2; ++n) { const int cc = wc * 32 + 8 * fq + 4 * n, j = u.pn * 128 + cc;
            const f32x4 w0 = *(const f32x4*)(cw + j), w1 = *(const f32x4*)(cw + DFF + j), w2 = *(const f32x4*)(cw + 2 * DFF + j), bb = *(const f32x4*)(cb + j);
#pragma unroll
            for (int ai = 0; ai < 2; ++ai) { const int q = 2 * ai + wr;
                const f32x4 bup = (q > 0) ? *(LAS f32x4*)(xl + (q - 1) * 128 + cc) : (f32x4){0.f, 0.f, 0.f, 0.f};
                const f32x4 bdn = (q < 3) ? *(LAS f32x4*)(xf + (q + 1) * 128 + cc) : (f32x4){0.f, 0.f, 0.f, 0.f};
                f32x4 Rprev = bup, Dcur;
#pragma unroll
                for (int e = 0; e < 4; ++e) Dcur[e] = ROR15(acc[ai][0][0][n][e]);
#pragma unroll
                for (int m = 0; m < 4; ++m) {
                    f32x4 Rm, Dnext = bdn;
#pragma unroll
                    for (int e = 0; e < 4; ++e) { Rm[e] = ROR1(acc[ai][0][m][n][e]); if (m < 3) Dnext[e] = ROR15(acc[ai][0][m < 3 ? m + 1 : 3][n][e]); }
                    const f32x4 up = (fr > 0) ? Rm : Rprev;
                    const f32x4 dn = (fr < 15) ? Dcur : Dnext;
                    Rprev = Rm; Dcur = Dnext;
                    const int rr = q * 64 + m * 16 + fr, sq = s0 + rr;
                    const f32x4 g = acc[ai][0][m][n], v = acc[ai][1][m][n];
                    f32x4 o;
#pragma unroll
                    for (int e = 0; e < 4; ++e) { const float z = w0[e] * up[e] + w1[e] * g[e] + w2[e] * dn[e] + bb[e]; o[e] = z * __builtin_amdgcn_rcpf(1.f + __builtin_amdgcn_exp2f(-1.4426950408889634f * z)) * v[e]; }
                    if (rr >= 1 && rr <= 254) { u32x2 w; w.x = cvt_pk_bf16(o[0], o[1]); w.y = cvt_pk_bf16(o[2], o[3]);
                        *(u32x2*)(act + (size_t)(sbase + sq) * DFF + j) = w; }
                    if (rr < 2 || rr > 253) { const int rid = rr < 2 ? rr : rr - 252; *(f32x4*)(sbp + (size_t)rid * DFF + j) = g;
                        if (rr == 0 || rr == 255) *(f32x4*)(sbp + (size_t)(4 + (rr == 255)) * DFF + j) = v; }
                }
                asm volatile("" ::: "memory");
            } }
#undef ROR1
#undef ROR15
    }
};
}

namespace att {
constexpr int KST = 12288, VST = 8192, STG = KST + VST;
constexpr int OFF_WS = 2 * STG;
constexpr int NT = 68;
constexpr float QSCALE = 0.10206207261596577f * 1.4426950408889634f;
DEV int crow(int r, int hi) { return (r & 3) + 8 * (r >> 2) + 4 * hi; }
DEV unsigned cvtpk(float lo, float hi) { return cvt_pk_bf16(lo, hi); }
DEV void pv(f32x16* o, int vb, bf16x8 pa0, bf16x8 pa1, bf16x8 pa2, bf16x8 pa3) {
#pragma unroll
    for (int d0 = 0; d0 < 2; ++d0) { s16x4 lo[4], hi[4];
#pragma unroll
        for (int ks = 0; ks < 4; ++ks) {
            asm volatile("ds_read_b64_tr_b16 %0,%1 offset:%c2" : "=&v"(lo[ks]) : "v"(vb), "i"(d0 * 4096 + ks * 1024) : "memory");
            asm volatile("ds_read_b64_tr_b16 %0,%1 offset:%c2" : "=&v"(hi[ks]) : "v"(vb), "i"(d0 * 4096 + ks * 1024 + 512) : "memory"); }
        asm volatile("s_waitcnt lgkmcnt(0)" ::: "memory"); __builtin_amdgcn_sched_barrier(0);
#define PKV(k) (bf16x8){lo[k][0], lo[k][1], lo[k][2], lo[k][3], hi[k][0], hi[k][1], hi[k][2], hi[k][3]}
        o[d0] = __builtin_amdgcn_mfma_f32_32x32x16_bf16(pa0, PKV(0), o[d0], 0, 0, 0);
        o[d0] = __builtin_amdgcn_mfma_f32_32x32x16_bf16(pa1, PKV(1), o[d0], 0, 0, 0);
        o[d0] = __builtin_amdgcn_mfma_f32_32x32x16_bf16(pa2, PKV(2), o[d0], 0, 0, 0);
        o[d0] = __builtin_amdgcn_mfma_f32_32x32x16_bf16(pa3, PKV(3), o[d0], 0, 0, 0);
#undef PKV
    }
}
DEV void pvh(f32x16* o, int vb, bf16x8 pa, bf16x8 pb) {
    s16x4 lo[4], hi[4];
#pragma unroll
    for (int d0 = 0; d0 < 2; ++d0)
#pragma unroll
        for (int kk = 0; kk < 2; ++kk) {
            asm volatile("ds_read_b64_tr_b16 %0,%1 offset:%c2" : "=&v"(lo[d0 * 2 + kk]) : "v"(vb), "i"(d0 * 4096 + kk * 1024) : "memory");
            asm volatile("ds_read_b64_tr_b16 %0,%1 offset:%c2" : "=&v"(hi[d0 * 2 + kk]) : "v"(vb), "i"(d0 * 4096 + kk * 1024 + 512) : "memory"); }
    asm volatile("s_waitcnt lgkmcnt(0)" ::: "memory"); __builtin_amdgcn_sched_barrier(0);
#define PKV(k) (bf16x8){lo[k][0], lo[k][1], lo[k][2], lo[k][3], hi[k][0], hi[k][1], hi[k][2], hi[k][3]}
    o[0] = __builtin_amdgcn_mfma_f32_32x32x16_bf16(pa, PKV(0), o[0], 0, 0, 0);
    o[1] = __builtin_amdgcn_mfma_f32_32x32x16_bf16(pa, PKV(2), o[1], 0, 0, 0);
    o[0] = __builtin_amdgcn_mfma_f32_32x32x16_bf16(pb, PKV(1), o[0], 0, 0, 0);
    o[1] = __builtin_amdgcn_mfma_f32_32x32x16_bf16(pb, PKV(3), o[1], 0, 0, 0);
#undef PKV
}
DEV float max3f(float a, float b, float c) { return fmaxf(fmaxf(a, b), c); }
DEV void attn_unit(int b, int h, int qb, const bf16_t* Q, const bf16_t* K, const bf16_t* V, bf16_t* O, LAS unsigned char* sh, const int tid, const float* qgain) {
    const int lane = tid & 63, r32 = lane & 31, hi = lane >> 5; const int wid = __builtin_amdgcn_readfirstlane(tid >> 6);
    const long qrow0 = (long)b * SEQ + qb * 256 + wid * 32;
    const bf16_t* Qw = Q + qrow0 * 1536 + h * 96;
    const unsigned lds0 = (unsigned)(uintptr_t)sh;
    LAS float* wsf = (LAS float*)(sh + OFF_WS) + wid * 64;
    bf16x8 qr[6];
#pragma unroll
    for (int d0 = 0; d0 < 6; ++d0) qr[d0] = *(const bf16x8*)(Qw + (long)r32 * 1536 + d0 * 16 + hi * 8);
    {
        float qv[6][8]; float ss = 0.f;
#pragma unroll
        for (int d0 = 0; d0 < 6; ++d0) { const u32x4 raw = __builtin_bit_cast(u32x4, qr[d0]);
            qv[d0][0] = __uint_as_float(raw.x << 16); qv[d0][1] = __uint_as_float(raw.x & 0xffff0000u); qv[d0][2] = __uint_as_float(raw.y << 16); qv[d0][3] = __uint_as_float(raw.y & 0xffff0000u);
            qv[d0][4] = __uint_as_float(raw.z << 16); qv[d0][5] = __uint_as_float(raw.z & 0xffff0000u); qv[d0][6] = __uint_as_float(raw.w << 16); qv[d0][7] = __uint_as_float(raw.w & 0xffff0000u);
#pragma unroll
            for (int e = 0; e < 8; ++e) ss += qv[d0][e] * qv[d0][e]; }
        ss += __shfl_xor(ss, 32);
        const float rstd = 1.0f / sqrtf(ss * (1.f / 96.f) + EPS);
#pragma unroll
        for (int d0 = 0; d0 < 6; ++d0) { const f32x4 g0 = *(const f32x4*)(qgain + d0 * 16 + hi * 8), g1 = *(const f32x4*)(qgain + d0 * 16 + hi * 8 + 4);
#pragma unroll
            for (int e = 0; e < 4; ++e) { qv[d0][e] *= rstd * g0[e]; qv[d0][4 + e] *= rstd * g1[e]; } }
        const int tq = qb * 256 + wid * 32 + r32; const float pr = (float)(tq >> 6), pc = (float)(tq & 63);
#pragma unroll
        for (int e = 0; e < 8; ++e) { const float invf = exp2f(-(float)e * (13.287712379549449f / 8.f));
            const float rr_ = pr * invf * 0.15915494309189535f, rc_ = pc * invf * 0.15915494309189535f;
            const float sr = __builtin_amdgcn_sinf(rr_), cr = __builtin_amdgcn_cosf(rr_), sc_ = __builtin_amdgcn_sinf(rc_), cc = __builtin_amdgcn_cosf(rc_);
            const float o4 = qv[4][e], o5 = qv[5][e], p4 = __shfl_xor(o4, 32), p5 = __shfl_xor(o5, 32);
            qv[4][e] = hi ? (p4 * sr + o4 * cr) : (o4 * cr - p4 * sr);
            qv[5][e] = hi ? (p5 * sc_ + o5 * cc) : (o5 * cc - p5 * sc_); }
#pragma unroll
        for (int d0 = 0; d0 < 6; ++d0) { u32x4 w; w.x = cvt_pk_bf16(qv[d0][0] * QSCALE, qv[d0][1] * QSCALE); w.y = cvt_pk_bf16(qv[d0][2] * QSCALE, qv[d0][3] * QSCALE);
            w.z = cvt_pk_bf16(qv[d0][4] * QSCALE, qv[d0][5] * QSCALE); w.w = cvt_pk_bf16(qv[d0][6] * QSCALE, qv[d0][7] * QSCALE); qr[d0] = __builtin_bit_cast(bf16x8, w); }
    }
    u32x4 kreg0, kreg1, vreg;
    const bool k2 = wid < 4;
#define KBASE(t) ((t) < 64 ? (long)b * SEQ + (t) * 64 : (long)TX + b * CTXL + ((t) - 64) * 64)
#define LOADT(t) do { const long kb_ = KBASE(t); \
        kreg0 = *(const u32x4*)(K + (kb_ + lane) * 1536 + h * 96 + wid * 8); \
        if (k2) kreg1 = *(const u32x4*)(K + (kb_ + lane) * 1536 + h * 96 + (8 + wid) * 8); \
        vreg = *(const u32x4*)(V + (kb_ + 16 * (wid & 3) + (lane >> 2)) * 1024 + h * 64 + (wid >> 2) * 32 + (lane & 3) * 8); } while (0)
#define STORET(s) do { LAS unsigned char* st_ = sh + (s) * STG; \
        *(LAS u32x4*)(st_ + wid * 1024 + lane * 16) = kreg0; if (k2) *(LAS u32x4*)(st_ + (8 + wid) * 1024 + lane * 16) = kreg1; \
        *(LAS u32x4*)(st_ + KST + wid * 1024 + lane * 16) = vreg; } while (0)
    float mrun = 0.f, lsum = 0.f; f32x16 o[2]; o[0] = f32x16{}; o[1] = f32x16{}; const f32x16 zero16 = f32x16{};
#define LOADK(t) do { const long kb_ = KBASE(t); kreg0 = *(const u32x4*)(K + (kb_ + lane) * 1536 + h * 96 + wid * 8); \
        if (k2) kreg1 = *(const u32x4*)(K + (kb_ + lane) * 1536 + h * 96 + (8 + wid) * 8); } while (0)
#define LOADV(t) do { const long kb_ = KBASE(t); vreg = *(const u32x4*)(V + (kb_ + 16 * (wid & 3) + (lane >> 2)) * 1024 + h * 64 + (wid >> 2) * 32 + (lane & 3) * 8); } while (0)
#define STOREK(s) do { LAS unsigned char* st_ = sh + (s) * STG; *(LAS u32x4*)(st_ + wid * 1024 + lane * 16) = kreg0; if (k2) *(LAS u32x4*)(st_ + (8 + wid) * 1024 + lane * 16) = kreg1; } while (0)
#define STOREV(s) do { LAS unsigned char* st_ = sh + (s) * STG; *(LAS u32x4*)(st_ + KST + wid * 1024 + lane * 16) = vreg; } while (0)
#define QKT(P0, P1, s) do { LAS unsigned char* kb = sh + (s) * STG + hi * 1024 + r32 * 16; \
        _Pragma("unroll") for (int d0 = 0; d0 < 6; ++d0) { \
            const bf16x8 b0 = *(const LAS bf16x8*)(kb + d0 * 2048), b1 = *(const LAS bf16x8*)(kb + d0 * 2048 + 512); \
            P0 = __builtin_amdgcn_mfma_f32_32x32x16_bf16(b0, qr[d0], d0 == 0 ? zero16 : P0, 0, 0, 0); \
            P1 = __builtin_amdgcn_mfma_f32_32x32x16_bf16(b1, qr[d0], d0 == 0 ? zero16 : P1, 0, 0, 0); } } while (0)
#define SOFTPAIR(P, r) do { mx = max3f(mx, P[r], P[r + 1]); f32x2 v_ = (f32x2){P[r], P[r + 1]} - m2; v_.x = __builtin_amdgcn_exp2f(v_.x); v_.y = __builtin_amdgcn_exp2f(v_.y); P[r] = v_.x; P[r + 1] = v_.y; sum2 += v_; } while (0)
#define STEP(PA0, PA1, PB0, PB1, t, HASQK) do { const int s = (t) & 1; const bool more1 = (t) + 1 < NT, more2 = (t) + 2 < NT; \
        if (more2) LOADK((t) + 2); if (more1) LOADV((t) + 1); \
        if (HASQK) QKT(PB0, PB1, s ^ 1); \
        float mx = PA0[0]; f32x2 sum2 = (f32x2){0.f, 0.f}; const f32x2 m2 = (f32x2){mrun, mrun}; \
        _Pragma("unroll") for (int r = 0; r < 16; r += 2) { SOFTPAIR(PA0, r); } \
        u32x4 pw0, pw1, pw2, pw3; \
        pw0 = (u32x4){cvtpk(PA0[0], PA0[1]), cvtpk(PA0[2], PA0[3]), cvtpk(PA0[4], PA0[5]), cvtpk(PA0[6], PA0[7])}; \
        pw1 = (u32x4){cvtpk(PA0[8], PA0[9]), cvtpk(PA0[10], PA0[11]), cvtpk(PA0[12], PA0[13]), cvtpk(PA0[14], PA0[15])}; \
        if (HASQK) { __builtin_amdgcn_sched_group_barrier(0x100, 3, 0); \
            _Pragma("unroll") for (int i_ = 0; i_ < 12; ++i_) { __builtin_amdgcn_sched_group_barrier(0x008, 1, 0); __builtin_amdgcn_sched_group_barrier(0x100, 1, 0); __builtin_amdgcn_sched_group_barrier(0x002, 5, 0); } } \
        __builtin_amdgcn_sched_barrier(0); \
        const int vb = (int)(lds0 + s * STG + KST) + ((lane >> 4) & 1) * 32 + (lane & 3) * 8 + (4 * hi + ((lane & 15) >> 2)) * 64; \
        pvh(o, vb, __builtin_bit_cast(bf16x8, pw0), __builtin_bit_cast(bf16x8, pw1)); \
        _Pragma("unroll") for (int r = 0; r < 16; r += 2) { SOFTPAIR(PA1, r); } \
        pw2 = (u32x4){cvtpk(PA1[0], PA1[1]), cvtpk(PA1[2], PA1[3]), cvtpk(PA1[4], PA1[5]), cvtpk(PA1[6], PA1[7])}; \
        pw3 = (u32x4){cvtpk(PA1[8], PA1[9]), cvtpk(PA1[10], PA1[11]), cvtpk(PA1[12], PA1[13]), cvtpk(PA1[14], PA1[15])}; \
        __builtin_amdgcn_sched_barrier(0); \
        pvh(o, vb + 2048, __builtin_bit_cast(bf16x8, pw2), __builtin_bit_cast(bf16x8, pw3)); \
        lsum += sum2.x + sum2.y; \
        float rm = fmaxf(mx, __shfl_xor(mx, 32)); \
        if (__any(rm - mrun > 8.0f)) { const float dl = fmaxf(rm - mrun, 0.f); mrun += dl; \
            const float f = __builtin_amdgcn_exp2f(-dl); lsum *= f; \
            if (hi == 0) wsf[r32] = f; \
            asm volatile("s_waitcnt lgkmcnt(0)" ::: "memory"); \
            _Pragma("unroll") for (int r = 0; r < 16; ++r) { const float fr_ = wsf[crow(r, hi)]; o[0][r] *= fr_; o[1][r] *= fr_; } } \
        if (more2) STOREK(s); if (more1) STOREV(s ^ 1); \
        __syncthreads(); } while (0)
    LOADK(0); LOADV(0); STOREK(0); STOREV(0); LOADK(1); STOREK(1); __syncthreads();
    f32x16 pA0, pA1, pB0 = f32x16{}, pB1 = f32x16{};
    QKT(pA0, pA1, 0);
    { float m0 = pA0[0];
#pragma unroll
        for (int r = 0; r < 16; ++r) m0 = max3f(m0, pA0[r], pA1[r]);
        mrun = fmaxf(m0, __shfl_xor(m0, 32)); }
    for (int t = 0; t < NT - 2; t += 2) {
        STEP(pA0, pA1, pB0, pB1, t, true);
        STEP(pB0, pB1, pA0, pA1, t + 1, true);
    }
    STEP(pA0, pA1, pB0, pB1, NT - 2, true);
    STEP(pB0, pB1, pA0, pA1, NT - 1, false);
#undef SOFTPAIR
#undef LOADK
#undef LOADV
#undef STOREK
#undef STOREV
#undef QKT
#undef STEP
#undef LOADT
#undef STORET
#undef KBASE
    lsum += __shfl_xor(lsum, 32);
    if (hi == 0) wsf[r32] = 1.0f / lsum;
    asm volatile("s_waitcnt lgkmcnt(0)" ::: "memory");
    bf16_t* Ow = O + qrow0 * 1024 + h * 64;
#pragma unroll
    for (int r = 0; r < 16; ++r) { const int q = crow(r, hi); const float f = wsf[q];
        const unsigned a = cvt_pk_bf16(o[0][r] * f, o[1][r] * f);
        Ow[(long)q * 1024 + r32] = (bf16_t)(a & 0xffffu); Ow[(long)q * 1024 + 32 + r32] = (bf16_t)(a >> 16); }
    __syncthreads();
}
}

namespace fftl {
constexpr float W16C[8] = {1.f, 0.923879533f, 0.707106781f, 0.382683432f, 0.f, -0.382683432f, -0.707106781f, -0.923879533f};
constexpr float W16S[8] = {0.f, 0.382683432f, 0.707106781f, 0.923879533f, 1.f, 0.923879533f, 0.707106781f, 0.382683432f};
DEV int padi(int n) { return n + ((n >> 5) << 2); }
template <bool INV> DEV void bfly(float& xr, float& xi, float& yr, float& yi, const float c, const float s) {
    if (!INV) { const float dr = xr - yr, di = xi - yi; xr += yr; xi += yi; yr = dr * c + di * s; yi = di * c - dr * s; }
    else { const float tr = yr * c - yi * s, ti = yr * s + yi * c; yr = xr - tr; yi = xi - ti; xr += tr; xi += ti; }
}
template <int LR, bool INV, bool PRUNE = false> DEV void pass_strided(LAS float* re, LAS float* im, const int N, const int s, const int tid, const int ncol, const int cstride) {
    constexpr int R = 1 << LR; const int h2 = N >> (s + LR), ngr = N / R; const float invN = 1.f / (float)N;
    const bool lin = (h2 & 31) == 0; const int ph2 = h2 + ((h2 >> 5) << 2);
    for (int w = tid; w < ngr * ncol; w += NTHREADS) {
        const int col = w >> __builtin_ctz(ngr), g = w & (ngr - 1);
        const int j = g & (h2 - 1), base = (g - j) * R + j, pbase = padi(base);
        float twc[LR][R / 2], tws[LR][R / 2];
        { const float rev = (float)(j << s) * invN; float c = __builtin_amdgcn_cosf(rev), sn = __builtin_amdgcn_sinf(rev);
#pragma unroll
            for (int k = 0; k < LR; ++k) { const int dk = R >> (k + 1);
#pragma unroll
                for (int mm = 0; mm < R / 2; ++mm) { float cc = 0.f, ss = 0.f;
                    if (mm < dk) { const int e8 = mm * (4 / dk);
                        if (e8 == 0) { cc = c; ss = sn; } else if (e8 == 1) { cc = (c - sn) * 0.70710678f; ss = (sn + c) * 0.70710678f; } else if (e8 == 2) { cc = -sn; ss = c; } else { cc = (-c - sn) * 0.70710678f; ss = (c - sn) * 0.70710678f; } }
                    twc[k][mm] = cc; tws[k][mm] = ss; }
                const float c2 = c * c - sn * sn, s2 = 2.f * c * sn; c = c2; sn = s2; } }
        LAS float* r_ = re + col * cstride; LAS float* i_ = im + col * cstride;
        float xr[R], xi[R];
#pragma unroll
        for (int m = 0; m < R; ++m) { if (PRUNE && !INV && m >= R / 2) { xr[m] = 0.f; xi[m] = 0.f; } else { const int p = lin ? pbase + m * ph2 : padi(base + m * h2); xr[m] = r_[p]; xi[m] = i_[p]; } }
#pragma unroll
        for (int kk = 0; kk < LR; ++kk) { const int k = INV ? LR - 1 - kk : kk; const int dk = R >> (k + 1);
#pragma unroll
            for (int m = 0; m < R; ++m) if ((m & dk) == 0) bfly<INV>(xr[m], xi[m], xr[m + dk], xi[m + dk], twc[k][m & (dk - 1)], tws[k][m & (dk - 1)]); }
#pragma unroll
        for (int m = 0; m < R; ++m) { if (!(PRUNE && INV && m >= R / 2)) { const int p = lin ? pbase + m * ph2 : padi(base + m * h2); r_[p] = xr[m]; i_[p] = xi[m]; } }
    }
}
template <bool INV> DEV void pass_final16(LAS float* re, LAS float* im, const int N, const int tid, const int ncol, const int cstride) {
    const int ng = N >> 4;
    for (int w = tid; w < ng * ncol; w += NTHREADS) { const int col = w >> __builtin_ctz(ng), g = w & (ng - 1); const int p0 = padi(16 * g);
        LAS float* r_ = re + col * cstride + p0; LAS float* i_ = im + col * cstride + p0;
        float xr[16], xi[16];
#pragma unroll
        for (int m = 0; m < 16; ++m) { xr[m] = r_[m]; xi[m] = i_[m]; }
#pragma unroll
        for (int kk = 0; kk < 4; ++kk) { const int k = INV ? 3 - kk : kk; const int dk = 8 >> k;
#pragma unroll
            for (int m = 0; m < 16; ++m) if ((m & dk) == 0) bfly<INV>(xr[m], xi[m], xr[m + dk], xi[m + dk], W16C[(m & (dk - 1)) << k], W16S[(m & (dk - 1)) << k]); }
#pragma unroll
        for (int m = 0; m < 16; ++m) { r_[m] = xr[m]; i_[m] = xi[m]; }
    }
}
template <bool INV> DEV void pass_any(const int LR, LAS float* re, LAS float* im, const int N, const int s, const int tid, const int ncol, const int cstride) {
    if (LR == 3) pass_strided<3, INV>(re, im, N, s, tid, ncol, cstride);
    else if (LR == 2) pass_strided<2, INV>(re, im, N, s, tid, ncol, cstride);
    else pass_strided<1, INV>(re, im, N, s, tid, ncol, cstride);
}
template <bool INV, bool PRUNE = false> DEV void run(LAS float* re, LAS float* im, const int logN, const int tid_in, const int ncol, const int cstride) {
    int tid = tid_in; asm volatile("" : "+v"(tid));
    const int N = 1 << logN, front = logN - 4;
    if (!INV) {
        if (PRUNE) pass_strided<3, false, true>(re, im, N, 0, tid, ncol, cstride); else pass_strided<3, false, false>(re, im, N, 0, tid, ncol, cstride);
        __syncthreads();
        for (int s = 3; s < front;) { const int LR = (front - s >= 3) ? 3 : front - s; pass_any<false>(LR, re, im, N, s, tid, ncol, cstride); __syncthreads(); s += LR; }
        pass_final16<false>(re, im, N, tid, ncol, cstride); __syncthreads();
    } else {
        pass_final16<true>(re, im, N, tid, ncol, cstride); __syncthreads();
        int s = front; const int rem = front % 3;
        if (rem) { s -= rem; pass_any<true>(rem, re, im, N, s, tid, ncol, cstride); __syncthreads(); }
        while (s > 3) { s -= 3; pass_any<true>(3, re, im, N, s, tid, ncol, cstride); __syncthreads(); }
        if (PRUNE) pass_strided<3, true, true>(re, im, N, 0, tid, ncol, cstride); else pass_strided<3, true, false>(re, im, N, 0, tid, ncol, cstride);
        __syncthreads();
    }
}
}

struct Args { const float* in[33]; float* out; unsigned char* ws; int ph_lo, ph_hi; };
enum { I_X = 0, I_C, I_CTX, I_CCTX, I_NORM1, I_NORM2, I_WMOD, I_BMOD, I_FUP, I_FCW, I_FCB, I_FDOWN, I_FHIN, I_FHOUT, I_HCW, I_HCB,
       I_HW1, I_HB1, I_HW2, I_HB2, I_HW3, I_HB3, I_HW4, I_HFREQ, I_HBIAS, I_MIN, I_MQAN, I_MUQ, I_MKVAN, I_MUKV, I_MQN, I_MKN, I_MWO };

struct Op {
    int type; const bf16_t* A; const bf16_t* Bt; int lda, ldb, K; long sAz, sBz; int nM, nN, nZ, mode, rot;
    void* o0; void* o1; const void* p0; const void* p1; const void* p2; const void* p3; void* x0; void* x1;
    int i0, i1, i2, i3, i4; float f0, f1;
};
enum { T_G1 = 0, T_BF16, T_F32, T_RES, T_HF, T_HI, T_FFN, T_MLA };

typedef const __attribute__((address_space(4))) unsigned char* kptr_t;
#define KIN(i) (((const float* const __attribute__((address_space(4)))*)kp)[i])
#define KOUT (*(float* const __attribute__((address_space(4)))*)(kp + 264))
#define KWS (*(unsigned char* const __attribute__((address_space(4)))*)(kp + 272))
DEV bool get_op(kptr_t kp, int ph, int idx, Op& o) {
    unsigned char* ws = KWS;
#define BF(off) ((bf16_t*)(ws + (off)))
#define FP(off) ((float*)(ws + (off)))
    o.sAz = 0; o.sBz = 0; o.nZ = 1; o.mode = 0; o.rot = 0; o.o1 = nullptr; o.p0 = o.p1 = o.p2 = o.p3 = nullptr; o.x0 = o.x1 = nullptr; o.i0 = o.i1 = o.i2 = o.i3 = o.i4 = 0; o.f0 = 1.f; o.f1 = 0.f;
    float* mod = FP(WS_MOD);
    switch (ph) {
    case 2:
        if (idx == 0) { o.type = T_G1; o.A = BF(W_W1T); o.Bt = BF(WS_HX); o.lda = 1024; o.ldb = 1024; o.K = 1024; o.nM = 10; o.nN = 136; o.o0 = BF(WS_PQT); o.o1 = BF(WS_HT); o.p0 = BF(WS_PQTC); o.p1 = BF(WS_HTC); return true; }
        if (idx == 99) { o.type = T_F32; o.A = BF(WS_FILT); o.Bt = BF(WS_T1); o.lda = 4096; o.ldb = 4096; o.K = 4096; o.nM = 4; o.nN = 32; o.rot = 176; o.o0 = FP(WS_KF); o.i0 = 8192; return true; }
        if (idx == 98) { o.type = T_F32; o.A = BF(WS_FILTC); o.Bt = BF(WS_T1C); o.lda = 256; o.ldb = 256; o.K = 256; o.nM = 4; o.nN = 2; o.rot = 240; o.o0 = FP(WS_KFC); o.i0 = 512; return true; }
        return false;
    case 4:
        if (idx == 95) { o.type = T_BF16; o.A = BF(WS_T2); o.Bt = BF(WS_PQT); o.lda = 8192; o.ldb = 8192; o.K = 8192; o.sBz = 512L * 8192; o.nM = 16; o.nN = 2; o.nZ = 8; o.o0 = BF(WS_HX); o.i0 = 1024; o.i1 = 0; o.i2 = 0; o.i3 = 4096; o.f0 = 0.001381067932004975f; return true; }
        if (idx == 97) { o.type = T_HF; o.A = BF(WS_WT); o.Bt = BF(WS_T1); o.lda = 4096; o.ldb = 4096; o.K = 4096; o.nM = 16; o.nN = 32; o.o0 = BF(WS_YT); o.p0 = FP(WS_KF); o.p1 = FP(WS_SMALL); o.i0 = 4096; return true; }
        if (idx == 94) { o.type = T_BF16; o.A = BF(WS_CSC); o.Bt = BF(WS_PQTC); o.lda = 512; o.ldb = 512; o.K = 512; o.sBz = 512L * 512; o.nM = 1; o.nN = 2; o.nZ = 8; o.rot = 128; o.o0 = BF(WS_HX); o.i0 = 1024; o.i1 = 0; o.i2 = TX; o.i3 = 256; o.f0 = 0.005524271728019903f; return true; }
        if (idx == 96) { o.type = T_HF; o.A = BF(WS_WTC); o.Bt = BF(WS_T1C); o.lda = 256; o.ldb = 256; o.K = 256; o.nM = 16; o.nN = 2; o.rot = 160; o.o0 = BF(WS_YTC); o.p0 = FP(WS_KFC); o.p1 = FP(WS_SMALL + 4096); o.i0 = 256; return true; }
        return false;
    case 5:
        return false;
        if (idx == 0) { o.type = T_HI; o.A = BF(WS_YT); o.Bt = BF(WS_T1); o.lda = 8192; o.ldb = 8192; o.K = 8192; o.nM = 16; o.nN = 16; o.o0 = BF(WS_HX); o.p0 = BF(WS_WT); o.p1 = BF(WS_X0C); o.p2 = FP(WS_SMALL + 16384); o.p3 = KIN(I_HBIAS); o.i0 = 4096; o.i1 = 0; return true; }
        if (idx == 1) { o.type = T_HI; o.A = BF(WS_YTC); o.Bt = BF(WS_T1C); o.lda = 512; o.ldb = 512; o.K = 512; o.nM = 16; o.nN = 1; o.o0 = BF(WS_HX); o.p0 = BF(WS_WTC); o.p1 = BF(WS_X0CC); o.p2 = FP(WS_SMALL + 32768); o.p3 = KIN(I_HBIAS); o.i0 = 256; o.i1 = TX; return true; }
        return false;
    case 6:
        if (idx == 0) { o.type = T_RES; o.A = BF(WS_HX); o.Bt = BF(W_WOUT); o.lda = 1024; o.ldb = 1024; o.K = 1024; o.nM = 136; o.nN = 4; o.p0 = KIN(I_X); o.p1 = KIN(I_CTX); o.o0 = FP(WS_XR); o.o1 = FP(WS_XR) + (size_t)TX * DM; o.p2 = mod + 2 * 1024; return true; }
        return false;
    case 8:
        if (idx == 0) { o.type = T_FFN; o.A = BF(WS_HX); o.Bt = BF(W_WUP); o.lda = 1024; o.ldb = 1024; o.K = 1024; o.nM = 136; o.nN = 22; o.mode = 0; o.o0 = BF(WS_ACT); o.o1 = FP(WS_SB); o.p0 = KIN(I_FCW); o.p1 = KIN(I_FCB); return true; }
        return false;
    case 9:
        if (idx == 0) { o.type = T_RES; o.A = BF(WS_ACT); o.Bt = BF(W_WDOWN); o.lda = DFF; o.ldb = DFF; o.K = DFF; o.nM = 136; o.nN = 4; o.p0 = FP(WS_XR); o.p1 = FP(WS_XR) + (size_t)TX * DM; o.o0 = FP(WS_XR); o.o1 = FP(WS_XR) + (size_t)TX * DM; o.p2 = mod + 5 * 1024; return true; }
        return false;
    case 11:
        if (idx == 0) { o.type = T_MLA; o.A = BF(WS_HX); o.Bt = BF(W_MLAIN); o.lda = 1024; o.ldb = 1024; o.K = 1024; o.nM = 136; o.nN = 2; o.o0 = BF(WS_AQN); o.o1 = BF(WS_CKVN); o.x0 = FP(WS_KPE); o.x1 = FP(WS_SSQ2); o.p0 = KIN(I_MQAN); o.p1 = KIN(I_MKVAN); return true; }
        return false;
    case 13:
        if (idx == 0) { o.type = T_BF16; o.A = BF(WS_AQN); o.Bt = BF(W_WUQ); o.lda = 256; o.ldb = 256; o.K = 256; o.nM = 128; o.nN = 6; o.o0 = BF(WS_QB); o.i0 = 1536; o.i3 = 0; o.p0 = FP(WS_SSQ2); o.i4 = 0; o.f1 = 1.f / 256.f; return true; }
        if (idx == 1) { o.type = T_BF16; o.A = BF(WS_CKVN); o.Bt = BF(W_WUKV); o.lda = 128; o.ldb = 128; o.K = 128; o.nM = 136; o.nN = 8; o.o0 = BF(WS_KRAW); o.o1 = BF(WS_VB); o.i0 = 1024; o.i1 = 1024; o.p0 = FP(WS_SSQ2); o.i4 = 1; o.f1 = 1.f / 128.f; return true; }
        return false;
    case 16:
        if (idx == 0) { o.type = T_RES; o.A = BF(WS_OB); o.Bt = BF(W_WO); o.lda = 1024; o.ldb = 1024; o.K = 1024; o.nM = 128; o.nN = 4; o.p0 = FP(WS_XR); o.p1 = FP(WS_XR) + (size_t)TX * DM; o.o0 = FP(WS_XR); o.o1 = FP(WS_XR) + (size_t)TX * DM; o.p2 = mod + 9 * 6144 + 2 * 1024; return true; }
        return false;
    case 18:
        if (idx == 0) { o.type = T_FFN; o.A = BF(WS_HX); o.Bt = BF(W_WUP); o.lda = 1024; o.ldb = 1024; o.K = 1024; o.nM = 128; o.nN = 22; o.mode = 0; o.o0 = BF(WS_ACT); o.o1 = FP(WS_SB); o.p0 = KIN(I_FCW) + 3 * DFF; o.p1 = KIN(I_FCB) + DFF; return true; }
        return false;
    case 19:
        if (idx == 0) { o.type = T_RES; o.A = BF(WS_ACT); o.Bt = BF(W_WDOWN); o.lda = DFF; o.ldb = DFF; o.K = DFF; o.nM = 128; o.nN = 4; o.p0 = FP(WS_XR); o.p1 = FP(WS_XR) + (size_t)TX * DM; o.o0 = KOUT; o.o1 = KOUT; o.p2 = mod + 9 * 6144 + 5 * 1024; return true; }
        return false;
    default: return false;
    }
#undef BF
#undef FP
}

DEV void tr_item(const float* W, int ldw, int K, bf16_t* WT, int dst_n0, int src_n0, int k0, LAS float* scr, int lane) {
#pragma unroll 8
    for (int i = 0; i < 32; ++i) { const int kk = 2 * i + (lane >> 5); scr[kk * 33 + (lane & 31)] = (src_n0 >= 0) ? W[(size_t)(k0 + kk) * ldw + src_n0 + (lane & 31)] : 0.f; }
    asm volatile("s_waitcnt lgkmcnt(0)" ::: "memory");
    const int c = lane & 7;
#pragma unroll
    for (int j = 0; j < 4; ++j) { const int n = (lane >> 3) + 8 * j; const LAS float* s = scr + (8 * c) * 33 + n;
        u32x4 o; o.x = cvt_pk_bf16(s[0 * 33], s[1 * 33]); o.y = cvt_pk_bf16(s[2 * 33], s[3 * 33]); o.z = cvt_pk_bf16(s[4 * 33], s[5 * 33]); o.w = cvt_pk_bf16(s[6 * 33], s[7 * 33]);
        *(u32x4*)(WT + (size_t)(dst_n0 + n) * K + k0 + 8 * c) = o; }
    asm volatile("s_waitcnt lgkmcnt(0)" ::: "memory");
}
DEV void tr_matrix(const float* W, int ldw, int K, int Ndst, bf16_t* WT, int map, int nvalid, int src_off, LAS float* scr, int gw, int NGW, int lane) {
    const int nblk = Ndst / 32, nit = (K / 64) * nblk;
    for (int it = gw; it < nit; it += NGW) { const int kb = it / nblk, nb = it % nblk, d0 = nb * 32; int s0 = d0;
        if (map == 1) { const int pn = d0 >> 8, wi = d0 & 255, bj = wi >> 7, jj = wi & 127; s0 = bj * DFF + 128 * pn + jj; }
        else if (map == 2) { if (d0 < 1024) s0 = (d0 >> 6) * 128 + (d0 & 63); else { const int n2 = d0 - 1024; s0 = (n2 >> 6) * 128 + 64 + (n2 & 63); } }
        else if (map == 3) { if (d0 >= nvalid) s0 = -1; }
        tr_item(W, ldw, K, WT, d0, s0 < 0 ? -1 : s0 + src_off, kb * 64, scr, lane); }
}
DEV void modnorm_rows(const float* srcX, const float* srcC, int nrows, const float* g, const float* shift, const float* scale, bf16_t* dst, int gw, int NGW, int lane) {
    for (int row0 = gw; row0 < nrows; row0 += 2 * NGW) {
        const int row1 = row0 + NGW; const bool has1 = row1 < nrows;
        const float* xr0 = (row0 < TX) ? srcX + (size_t)row0 * DM : srcC + (size_t)(row0 - TX) * DM;
        const float* xr1 = !has1 ? xr0 : ((row1 < TX) ? srcX + (size_t)row1 * DM : srcC + (size_t)(row1 - TX) * DM);
        f32x4 v0[4], v1[4]; float s0 = 0.f, s1 = 0.f;
#pragma unroll
        for (int j = 0; j < 4; ++j) { v0[j] = __builtin_nontemporal_load((const f32x4*)(xr0 + 256 * j + 4 * lane)); v1[j] = __builtin_nontemporal_load((const f32x4*)(xr1 + 256 * j + 4 * lane)); }
#pragma unroll
        for (int j = 0; j < 4; ++j) { s0 += (v0[j][0] * v0[j][0] + v0[j][1] * v0[j][1]) + (v0[j][2] * v0[j][2] + v0[j][3] * v0[j][3]); s1 += (v1[j][0] * v1[j][0] + v1[j][1] * v1[j][1]) + (v1[j][2] * v1[j][2] + v1[j][3] * v1[j][3]); }
        const float rstd0 = 1.0f / sqrtf(wave_sum(s0) * (1.f / DM) + EPS), rstd1 = 1.0f / sqrtf(wave_sum(s1) * (1.f / DM) + EPS);
        const int mr0 = (row0 < TX) ? (row0 >> 12) : 8, mr1 = (row1 < TX) ? (row1 >> 12) : 8;
#pragma unroll
        for (int j = 0; j < 4; ++j) { const int col = 256 * j + 4 * lane; const f32x4 gg = *(const f32x4*)(g + col);
            { const f32x4 sh = *(const f32x4*)(shift + (size_t)mr0 * 6144 + col), sc = *(const f32x4*)(scale + (size_t)mr0 * 6144 + col); f32x4 y;
#pragma unroll
                for (int e = 0; e < 4; ++e) y[e] = (v0[j][e] * rstd0 * gg[e]) * (1.f + sc[e]) + sh[e];
                u32x2 w; w.x = cvt_pk_bf16(y[0], y[1]); w.y = cvt_pk_bf16(y[2], y[3]); *(u32x2*)(dst + (size_t)row0 * DM + col) = w; }
            if (has1) { const f32x4 sh = *(const f32x4*)(shift + (size_t)mr1 * 6144 + col), sc = *(const f32x4*)(scale + (size_t)mr1 * 6144 + col); f32x4 y;
#pragma unroll
                for (int e = 0; e < 4; ++e) y[e] = (v1[j][e] * rstd1 * gg[e]) * (1.f + sc[e]) + sh[e];
                u32x2 w; w.x = cvt_pk_bf16(y[0], y[1]); w.y = cvt_pk_bf16(y[2], y[3]); *(u32x2*)(dst + (size_t)row1 * DM + col) = w; } }
    }
}

constexpr size_t WS_BAR = 3 * MiB;
DEV void grid_barrier(unsigned* cnt, const unsigned target, const int tid) {
    asm volatile("s_waitcnt vmcnt(0)" ::: "memory");
    __syncthreads();
    if (tid == 0) {
        __builtin_amdgcn_fence(__ATOMIC_RELEASE, "agent");
        __hip_atomic_fetch_add(cnt, 1u, __ATOMIC_RELAXED, __HIP_MEMORY_SCOPE_AGENT);
        while (__hip_atomic_load(cnt, __ATOMIC_RELAXED, __HIP_MEMORY_SCOPE_AGENT) < target) __builtin_amdgcn_s_sleep(20);
        __builtin_amdgcn_fence(__ATOMIC_ACQUIRE, "agent");
        asm volatile("s_waitcnt vmcnt(0)" ::: "memory");
    }
    __syncthreads();
}
DEV void ffn_fixup(const float* sb, bf16_t* act, const float* cw, const float* cb, const int nrt, const int gt, const int NGT) {
    const int per = DFF / 4;
    for (int i = gt; i < nrt * 2 * per; i += NGT) { const int pm = i / (2 * per), r2 = i - pm * 2 * per, e = r2 / per, j = (r2 - e * per) * 4;
        const bool isx = pm < 128; const bool first = isx ? ((pm & 15) == 0) : true, last = isx ? ((pm & 15) == 15) : true;
        const float* me = sb + (size_t)pm * 6 * DFF + j; const f32x4 z4 = (f32x4){0.f, 0.f, 0.f, 0.f};
        f32x4 up, g, dn, v;
        if (e == 0) { up = first ? z4 : *(const f32x4*)(me - (size_t)6 * DFF + (size_t)3 * DFF); g = *(const f32x4*)(me); dn = *(const f32x4*)(me + DFF); v = *(const f32x4*)(me + (size_t)4 * DFF); }
        else { up = *(const f32x4*)(me + (size_t)2 * DFF); g = *(const f32x4*)(me + (size_t)3 * DFF); dn = last ? z4 : *(const f32x4*)(me + (size_t)6 * DFF); v = *(const f32x4*)(me + (size_t)5 * DFF); }
        const f32x4 w0 = *(const f32x4*)(cw + j), w1 = *(const f32x4*)(cw + DFF + j), w2 = *(const f32x4*)(cw + 2 * DFF + j), bb = *(const f32x4*)(cb + j);
        f32x4 o;
#pragma unroll
        for (int q = 0; q < 4; ++q) { const float z = w0[q] * up[q] + w1[q] * g[q] + w2[q] * dn[q] + bb[q]; o[q] = z * __builtin_amdgcn_rcpf(1.f + __builtin_amdgcn_exp2f(-1.4426950408889634f * z)) * v[q]; }
        const int row = pm * 256 + (e ? 255 : 0);
        u32x2 w; w.x = cvt_pk_bf16(o[0], o[1]); w.y = cvt_pk_bf16(o[2], o[3]); *(u32x2*)(act + (size_t)row * DFF + j) = w; }
}
DEV void hy_conv8(const bf16_t* ht, const int b, const int c, const int L, const int t0, const bool act_, const float* cwp, const float* cbp, float (&x0o)[8], float (&wo)[8]) {
    float outv[3][8];
#pragma unroll
    for (int q = 0; q < 3; ++q) { const int cp = q * 512 + c; const bf16_t* src = ht + (size_t)(b * 1536 + cp) * L;
        const float w0 = cwp[cp], w1 = cwp[1536 + cp], w2 = cwp[3072 + cp], bq = cbp[cp];
        float x[10];
        if (act_) { const u32x4 raw = *(const u32x4*)(src + t0);
            x[1] = __uint_as_float(raw.x << 16); x[2] = __uint_as_float(raw.x & 0xffff0000u); x[3] = __uint_as_float(raw.y << 16); x[4] = __uint_as_float(raw.y & 0xffff0000u);
            x[5] = __uint_as_float(raw.z << 16); x[6] = __uint_as_float(raw.z & 0xffff0000u); x[7] = __uint_as_float(raw.w << 16); x[8] = __uint_as_float(raw.w & 0xffff0000u);
            x[0] = (t0 > 0) ? bf2f(src[t0 - 1]) : 0.f; x[9] = (t0 + 8 < L) ? bf2f(src[t0 + 8]) : 0.f; }
        else {
#pragma unroll
            for (int e = 0; e < 10; ++e) x[e] = 0.f; }
#pragma unroll
        for (int e = 0; e < 8; ++e) outv[q][e] = w0 * x[e] + w1 * x[e + 1] + w2 * x[e + 2] + bq; }
#pragma unroll
    for (int e = 0; e < 8; ++e) { x0o[e] = outv[0][e]; wo[e] = outv[2][e] * outv[1][e]; }
}
#define BF(off) ((bf16_t*)(ws + (off)))
#define FP(off) ((float*)(ws + (off)))
#define PHASE(k) ((LO) <= (k) && (k) < (HI) && ph == (k))
#ifndef DUP_PH
#define DUP_PH -1
#endif
template <int LO, int HI>
DEV void run_phases(LAS unsigned char* lds, const int ph_lo, const int ph_hi, const int G, const int wave0, unsigned& nbar) {
    int dup_left = 1;
    for (int ph = (ph_lo > LO ? ph_lo : LO); ph < (ph_hi < HI ? ph_hi : HI); ++ph) {
        if (ph == 3 || ph == 5 || ph == 12) continue;
        kptr_t kp = (kptr_t)__builtin_amdgcn_kernarg_segment_ptr(); asm volatile("" : "+s"(kp));
        int bid = blockIdx.x; asm volatile("" : "+s"(bid));
        const int NGW = G * 8, NGT = G * NTHREADS;
        unsigned char* ws = KWS;
        float* mod = FP(WS_MOD);
        {
        int tid; asm volatile("v_mbcnt_lo_u32_b32 %0, -1, 0\n\tv_mbcnt_hi_u32_b32 %0, -1, %0" : "=v"(tid)); tid += wave0 * 64; asm volatile("" : "+v"(tid));
        const int gt = bid * NTHREADS + tid;
        if (PHASE(9) || PHASE(19)) {
            const int l1_ = (ph == 19);
            ffn_fixup(FP(WS_SB), BF(WS_ACT), KIN(I_FCW) + l1_ * 3 * DFF, KIN(I_FCB) + l1_ * DFF, l1_ ? 128 : 136, gt, NGT);
            if (ph_lo < ph) { ++nbar; grid_barrier((unsigned*)(ws + WS_BAR), nbar * (unsigned)G, tid); }
        }
        {
            Op o;
            for (int idx = 0; get_op(kp, ph, idx, o); ++idx) {
                pg8::Gemm g{o.A, o.Bt, o.lda, o.ldb, o.K, o.sAz, o.sBz};
                pg8::Sched S{o.nM, o.nN, o.nZ, G, (bid + o.rot) % G, o.mode};
                int tid2 = tid; asm volatile("" : "+v"(tid2));
                switch (o.type) {
                case T_G1: if (LO <= 2 && 2 < HI) { pg8::EpiG1 E{(bf16_t*)o.o0, (bf16_t*)o.o1, (bf16_t*)o.p0, (bf16_t*)o.p1}; pg8::gemm_phase(lds, g, S, E, tid2); } break;
                case T_BF16: if (LO <= 13 && 13 < HI) { pg8::EpiBf16 E{(bf16_t*)o.o0, (bf16_t*)o.o1, o.i0, o.i1, o.i2, o.i3, o.f0, (const float*)o.p0, o.i4, o.f1}; pg8::gemm_phase(lds, g, S, E, tid2); } break;
                case T_F32: if (LO <= 11 && 11 < HI) { pg8::EpiF32 E{(float*)o.o0, o.i0}; pg8::gemm_phase(lds, g, S, E, tid2); } break;
                case T_RES: if (HI > 6) { pg8::EpiRes E{(const float*)o.p0, (const float*)o.p1, (float*)o.o0, (float*)o.o1, (const float*)o.p2}; pg8::gemm_phase(lds, g, S, E, tid2); } break;
                case T_FFN: if (HI > 8) { pg8::EpiFFN E{(bf16_t*)o.o0, (const float*)o.p0, (const float*)o.p1, (float*)o.o1}; pg8::gemm_phase(lds, g, S, E, tid2); } break;
                case T_MLA: if (LO <= 11 && 11 < HI) { pg8::EpiMla E{(bf16_t*)o.o0, (bf16_t*)o.o1, (float*)o.x0, (float*)o.x1, (const float*)o.p0, (const float*)o.p1}; pg8::gemm_phase(lds, g, S, E, tid2); } break;
                }
                __syncthreads();
            }
        }
        }
        int tid; asm volatile("v_mbcnt_lo_u32_b32 %0, -1, 0\n\tv_mbcnt_hi_u32_b32 %0, -1, %0" : "=v"(tid)); tid += wave0 * 64; asm volatile("" : "+v"(tid));
        const int lane = tid & 63, wave = __builtin_amdgcn_readfirstlane(tid >> 6);
        const int gw = bid * 8 + wave;
        const int gt = bid * NTHREADS + tid;
        if (PHASE(0)) {
            const bool bal0 = (G == 256); const int nrep0 = (bal0 && bid >= 192) ? 2 : 1, vNGW0 = bal0 ? 2560 : NGW;
            {
                LAS float* sl = (LAS float*)lds;
                LAS float* part = sl + 9 * 1024;
                bool loaded = false;
                for (int it = bid; it < 192; it += G) {
                    if (!loaded) { for (int i = tid; i < 9 * 1024; i += NTHREADS) { const float x = (i < 8192) ? KIN(I_C)[i] : KIN(I_CCTX)[i - 8192]; sl[i] = silu_f(x); } loaded = true; __syncthreads(); }
                    const int l = it / 96, n0 = (it % 96) * 64; const float* wm = KIN(I_WMOD) + (size_t)l * 1024 * 6144 + n0 + lane;
                    float acc9[9];
#pragma unroll
                    for (int r = 0; r < 9; ++r) acc9[r] = 0.f;
#pragma unroll 32
                    for (int k = wave * 128; k < wave * 128 + 128; ++k) { const float wv = wm[(size_t)k * 6144];
#pragma unroll
                        for (int r = 0; r < 9; ++r) acc9[r] += sl[r * 1024 + k] * wv; }
#pragma unroll
                    for (int r = 0; r < 9; ++r) part[(wave * 9 + r) * 64 + lane] = acc9[r];
                    __syncthreads();
                    for (int i = tid; i < 576; i += NTHREADS) { const int r = i >> 6, ln = i & 63; float s = 0.f;
#pragma unroll
                        for (int w = 0; w < 8; ++w) s += part[(w * 9 + r) * 64 + ln];
                        mod[(size_t)(l * 9 + r) * 6144 + n0 + ln] = s + KIN(I_BMOD)[l * 6144 + n0 + ln]; }
                    __syncthreads();
                }
                __syncthreads();
            }
            {
                LAS float* scr = (LAS float*)(lds + wave * 16384);
                for (int rep = 0; rep < nrep0; ++rep) { const int vgw = bal0 ? (bid < 192 ? gw : 1536 + (bid - 192) * 16 + rep * 8 + wave) : gw;
                    tr_matrix(KIN(I_FHIN), 2048, 1024, 1536, BF(W_W1T) + (size_t)1024 * 1024, 0, 0, 512, scr, vgw, vNGW0, lane);
                    tr_matrix(KIN(I_FHOUT), 1024, 1024, 1024, BF(W_WOUT), 0, 0, 0, scr, vgw, vNGW0, lane);
                    tr_matrix(KIN(I_FUP), 2 * DFF, 1024, 2 * DFF, BF(W_WUP), 1, 0, 0, scr, vgw, vNGW0, lane);
                    tr_matrix(KIN(I_FDOWN), 1024, DFF, 1024, BF(W_WDOWN), 0, 0, 0, scr, vgw, vNGW0, lane); }
                __syncthreads();
            }
            {
                LAS float* wt = (LAS float*)lds;
                LAS float* cs = wt + 16 * 128;
                if (tid < 128) { cs[tid] = __builtin_amdgcn_cosf((float)tid / 128.f); cs[128 + tid] = __builtin_amdgcn_sinf((float)tid / 128.f); }
                for (int it = bid; it < 256; it += G) { const int g = it >> 6, k0 = (it & 63) * 16;
                    __syncthreads();
                    for (int i = tid; i < 2048; i += NTHREADS) { const int kk = i >> 7, j = i & 127; wt[i] = KIN(I_FHIN)[(size_t)(k0 + kk) * 2048 + g * 128 + j]; }
                    __syncthreads();
                    const int rowi = tid >> 1, hh = tid & 1, m = rowi >> 1, part = rowi & 1;
                    float s[8];
#pragma unroll
                    for (int e = 0; e < 8; ++e) s[e] = 0.f;
                    for (int j = 0; j < 128; ++j) { const float tr = cs[part * 128 + ((j * m) & 127)];
#pragma unroll
                        for (int e = 0; e < 8; ++e) s[e] += wt[(hh * 8 + e) * 128 + j] * tr; }
                    u32x4 w; w.x = cvt_pk_bf16(s[0], s[1]); w.y = cvt_pk_bf16(s[2], s[3]); w.z = cvt_pk_bf16(s[4], s[5]); w.w = cvt_pk_bf16(s[6], s[7]);
                    *(u32x4*)(BF(W_W1T) + (size_t)(2 * (g * 128 + m) + part) * 1024 + k0 + hh * 8) = w;
                }
                __syncthreads();
            }
            for (int rep = 0; rep < nrep0; ++rep)
            for (int it = bal0 ? (bid < 192 ? gw : 1536 + (bid - 192) * 16 + rep * 8 + wave) : gw; it < 4096 + 256; it += vNGW0) {
                const bool isc = it >= 4096; const int L = isc ? 256 : 4096, pos = isc ? it - 4096 : it;
                const float t = (float)pos / (float)(L - 1);
                float z = 0.f;
                if (lane == 0) z = t;
                else if (lane < 33) { const int i = (lane - 1) & 15; const float band = 1e-4f + (float)i * ((15.0f - 1e-4f) / 15.0f);
                    const float ang = (6.283185307179586f / (float)L) * (float)pos * band; z = (lane <= 16) ? cosf(ang) : -sinf(ang); }
                const float fr_ = KIN(I_HFREQ)[lane];
                float h = KIN(I_HB1)[lane];
#pragma unroll 11
                for (int i = 0; i < 33; ++i) h += __shfl(z, i) * KIN(I_HW1)[i * 64 + lane];
                h = sinf(fr_ * h);
                float h2 = KIN(I_HB2)[lane];
#pragma unroll 16
                for (int i = 0; i < 64; ++i) h2 += __shfl(h, i) * KIN(I_HW2)[i * 64 + lane];
                h2 = sinf(fr_ * h2);
                float h3 = KIN(I_HB3)[lane];
#pragma unroll 16
                for (int i = 0; i < 64; ++i) h3 += __shfl(h2, i) * KIN(I_HW3)[i * 64 + lane];
                h3 = sinf(fr_ * h3);
                (isc ? FP(WS_H3C) : FP(WS_H3X))[(size_t)pos * 64 + lane] = h3;
            }
        }
        else if (PHASE(1)) {
            modnorm_rows(KIN(I_X), KIN(I_CTX), TT, KIN(I_NORM1), mod + 0 * 1024, mod + 1 * 1024, BF(WS_HX), gw, NGW, lane);
        }
        else if (PHASE(4)) {
            {
            LAS float* re = (LAS float*)lds; LAS float* im = re + 9216; LAS float* kre = re + 18432; LAS float* kim = kre + 8192;
            LAS float* w4 = kim + 8192; LAS float* red = w4 + 128;
            for (int it = bid; it < 1024; it += G) {
                const bool isc = it >= 512; const int c = (G == 256) ? ((((it >> 8) & 1) * 8 + (bid & 7)) * 32 + (bid >> 3)) : (it & 511), L = isc ? 256 : 4096, N = 2 * L, logN = isc ? 9 : 13;
                const float invN = 1.f / (float)N;
                const float* h3 = isc ? FP(WS_H3C) : FP(WS_H3X);
                __syncthreads();
                if (tid < 128) w4[tid] = KIN(I_HW4)[(size_t)(tid & 63) * 1024 + (tid >> 6) * 512 + c];
                __syncthreads();
                const float MIND = -15.350567286626973f, MAXD = -3.0701134573253946f;
                const float ad = fabsf(MIND + (float)c * ((MAXD - MIND) / 511.f));
                float l1 = 0.f;
                for (int p = tid; p < L; p += NTHREADS) { const float* hp = h3 + (size_t)p * 64; float sf = 0.f, sb = 0.f;
#pragma unroll
                    for (int j4 = 0; j4 < 16; ++j4) { const f32x4 hv = *(const f32x4*)(hp + 4 * j4);
#pragma unroll
                        for (int e = 0; e < 4; ++e) { sf += hv[e] * w4[4 * j4 + e]; sb += hv[e] * w4[64 + 4 * j4 + e]; } }
                    const float t = (float)p / (float)(L - 1), dec = expf(-t * ad); sf *= dec; sb = (p == 0) ? 0.f : sb * dec;
                    re[fftl::padi(p)] = sf; im[fftl::padi(p)] = 0.f; im[fftl::padi(p + L)] = 0.f;
                    if (p > 0) re[fftl::padi(N - p)] = sb; else re[fftl::padi(L)] = 0.f;
                    l1 += fabsf(sf) + fabsf(sb); }
                l1 = wave_sum(l1);
                if (lane == 0) red[wave] = l1;
                __syncthreads();
                float l1t = 0.f;
#pragma unroll
                for (int w = 0; w < 8; ++w) l1t += red[w];
                const float ksc = invN / l1t;
                fftl::run<false>(re, im, logN, tid, 1, 0);
                for (int i = tid; i < N; i += NTHREADS) { const int p = fftl::padi(i); kre[i] = re[p] * ksc; kim[i] = im[p] * ksc; }
                __syncthreads();
                const bf16_t* ht = isc ? BF(WS_HTC) : BF(WS_HT);
                const float* cwp = KIN(I_HCW); const float* cbp = KIN(I_HCB); const float hb_ = KIN(I_HBIAS)[c];
                const int npb = isc ? 4 : 1, cst = isc ? 576 : 0, cpp = L / 8;
                const int pl = tid >> __builtin_ctz(cpp), t0 = (tid & (cpp - 1)) * 8; const bool act_ = pl < npb; const int pt0 = pl * cst + fftl::padi(t0), pt1 = pl * cst + fftl::padi(L + t0);
                for (int bp0 = 0; bp0 < 4; bp0 += npb) { const int bp = bp0 + (act_ ? pl : 0);
                    float xk[2][8], wk[2][8];
                    hy_conv8(ht, 2 * bp, c, L, t0, act_, cwp, cbp, xk[0], wk[0]); hy_conv8(ht, 2 * bp + 1, c, L, t0, act_, cwp, cbp, xk[1], wk[1]);
                    if (act_) {
#pragma unroll
                        for (int e = 0; e < 8; ++e) { re[pt0 + e] = wk[0][e]; im[pt0 + e] = wk[1][e]; } }
                    __syncthreads();
                    fftl::run<false, true>(re, im, logN, tid, npb, cst);
                    for (int i = tid; i < N * npb; i += NTHREADS) { const int cl = i >> logN, ii = i & (N - 1); const int p = cl * cst + fftl::padi(ii); const float zr = re[p], zi = im[p], kr = kre[ii], ki = kim[ii]; re[p] = zr * kr - zi * ki; im[p] = zr * ki + zi * kr; }
                    __syncthreads();
                    fftl::run<true, true>(re, im, logN, tid, npb, cst);
                    if (act_) {
#pragma unroll
                        for (int bb = 0; bb < 2; ++bb) { const int b = 2 * bp + bb; bf16_t* op = BF(WS_HX) + (size_t)((isc ? TX : 0) + b * L + t0) * DM + 512 + c;
#pragma unroll
                            for (int e = 0; e < 8; e += 2) { const float y0 = (bb ? im[pt0 + e] : re[pt0 + e]), y1 = (bb ? im[pt0 + e + 1] : re[pt0 + e + 1]);
                                const unsigned pk = cvt_pk_bf16(xk[bb][e] * (y0 + wk[bb][e] * hb_), xk[bb][e + 1] * (y1 + wk[bb][e + 1] * hb_));
                                op[(size_t)e * DM] = (bf16_t)(pk & 0xffffu); op[(size_t)(e + 1) * DM] = (bf16_t)(pk >> 16); } } }
                    __syncthreads();
                }
            }
            __syncthreads();
            }
            {
                LAS float* fre = (LAS float*)lds; LAS float* fim = fre + 9216;
                u32x4 pfc[2], pfs[2];
#define FPRE(itn) do { if ((itn) < 4096) { const bool isc_ = (itn) >= 2048; const int L_ = isc_ ? 256 : 4096, b_ = ((itn) & 2047) >> 8, n_ = ((G == 256) ? ((bid & 7) * 32 + (bid >> 3)) : ((itn) & 255)) * 2; \
                        const bf16_t* src_ = (isc_ ? BF(WS_PQTC) : BF(WS_PQT)) + (size_t)(b_ * 512 + n_) * (2 * L_); \
                        _Pragma("unroll") for (int u_ = 0; u_ < 2; ++u_) { const int i_ = tid + u_ * NTHREADS; if (i_ < L_ / 4) { const int j_ = i_ / (L_ / 8), t_ = (i_ % (L_ / 8)) * 8; \
                            pfc[u_] = *(const u32x4*)(src_ + (size_t)j_ * 2 * L_ + t_); pfs[u_] = *(const u32x4*)(src_ + (size_t)j_ * 2 * L_ + L_ + t_); } } } } while (0)
                pfc[0] = pfc[1] = pfs[0] = pfs[1] = u32x4{};
                FPRE(bid);
                for (int it = bid; it < 4096; it += G) {
                    const bool isc = it >= 2048; const int L = isc ? 256 : 4096, logL = isc ? 8 : 12, b = (it & 2047) >> 8, n0 = ((G == 256) ? ((bid & 7) * 32 + (bid >> 3)) : (it & 255)) * 2;
                    const float oscale = isc ? 0.005524271728019903f : 0.001381067932004975f;
                    __syncthreads();
#pragma unroll
                    for (int u_ = 0; u_ < 2; ++u_) { const int i = tid + u_ * NTHREADS; if (i < L / 4) { const int j = i / (L / 8), t0 = (i % (L / 8)) * 8;
                        const u32x4 rc = pfc[u_], rs = pfs[u_];
                        LAS float* pr = fre + j * 4608 + fftl::padi(t0); LAS float* pi = fim + j * 4608 + fftl::padi(t0);
                        pr[0] = __uint_as_float(rc.x << 16); pr[1] = __uint_as_float(rc.x & 0xffff0000u); pr[2] = __uint_as_float(rc.y << 16); pr[3] = __uint_as_float(rc.y & 0xffff0000u);
                        pr[4] = __uint_as_float(rc.z << 16); pr[5] = __uint_as_float(rc.z & 0xffff0000u); pr[6] = __uint_as_float(rc.w << 16); pr[7] = __uint_as_float(rc.w & 0xffff0000u);
                        pi[0] = -__uint_as_float(rs.x << 16); pi[1] = -__uint_as_float(rs.x & 0xffff0000u); pi[2] = -__uint_as_float(rs.y << 16); pi[3] = -__uint_as_float(rs.y & 0xffff0000u);
                        pi[4] = -__uint_as_float(rs.z << 16); pi[5] = -__uint_as_float(rs.z & 0xffff0000u); pi[6] = -__uint_as_float(rs.w << 16); pi[7] = -__uint_as_float(rs.w & 0xffff0000u); } }
                    __syncthreads();
                    FPRE(it + G);
                    fftl::run<false>(fre, fim, logL, tid, 2, 4608);
                    bf16_t* yb = BF(WS_HX) + (size_t)((isc ? TX : 0) + b * L) * DM + n0;
                    for (int p = tid; p < L; p += NTHREADS) { const int k1 = (int)(__brev((unsigned)p) >> (32 - logL)); const int pp = fftl::padi(p);
                        *(unsigned*)(yb + (size_t)k1 * DM) = cvt_pk_bf16(fre[pp] * oscale, fre[4608 + pp] * oscale); }
                }
#undef FPRE
                __syncthreads();
            }
        }
        else if (PHASE(7)) {
            modnorm_rows(FP(WS_XR), FP(WS_XR) + (size_t)TX * DM, TT, KIN(I_NORM2), mod + 3 * 1024, mod + 4 * 1024, BF(WS_HX), gw, NGW, lane);
        }
        else if (PHASE(6)) {
            LAS float* scr = (LAS float*)(lds + wave * 16384);
            tr_matrix(KIN(I_MIN), 416, 1024, 512, BF(W_MLAIN), 3, 416, 0, scr, gw, NGW, lane);
            tr_matrix(KIN(I_MUQ), 1536, 256, 1536, BF(W_WUQ), 0, 0, 0, scr, gw, NGW, lane);
            tr_matrix(KIN(I_MUKV), 2048, 128, 2048, BF(W_WUKV), 2, 0, 0, scr, gw, NGW, lane);
            tr_matrix(KIN(I_MWO), 1024, 1024, 1024, BF(W_WO), 0, 0, 0, scr, gw, NGW, lane);
            __syncthreads();
        }
        else if (PHASE(9)) {
            LAS float* scr = (LAS float*)(lds + wave * 16384);
            tr_matrix(KIN(I_FUP) + (size_t)1024 * 2 * DFF, 2 * DFF, 1024, 2 * DFF, BF(W_WUP), 1, 0, 0, scr, gw, NGW, lane);
            __syncthreads();
        }
        else if (PHASE(10)) {
            modnorm_rows(FP(WS_XR), FP(WS_XR) + (size_t)TX * DM, TT, KIN(I_NORM1) + 1024, mod + 9 * 6144 + 0 * 1024, mod + 9 * 6144 + 1 * 1024, BF(WS_HX), gw, NGW, lane);
        }
        else if (PHASE(11)) {
            LAS float* scr = (LAS float*)(lds + wave * 16384);
            tr_matrix(KIN(I_FDOWN) + (size_t)DFF * 1024, 1024, DFF, 1024, BF(W_WDOWN), 0, 0, 0, scr, gw, NGW, lane);
            __syncthreads();
        }
        else if (PHASE(12)) {
            const float* ab = FP(WS_ABUF);
            for (int row = gw; row < TT; row += NGW) { const float* ar = ab + (size_t)row * 512;
                const f32x4 q = *(const f32x4*)(ar + 4 * lane); const f32x2 kv = *(const f32x2*)(ar + 256 + 2 * lane);
                const float sq = wave_sum((q[0] * q[0] + q[1] * q[1]) + (q[2] * q[2] + q[3] * q[3])), sk = wave_sum(kv[0] * kv[0] + kv[1] * kv[1]);
                const float rq = 1.0f / sqrtf(sq * (1.f / 256.f) + EPS), rk = 1.0f / sqrtf(sk * (1.f / 128.f) + EPS);
                if (row < TX) { const f32x4 gq = *(const f32x4*)(KIN(I_MQAN) + 4 * lane); u32x2 w; w.x = cvt_pk_bf16(q[0] * rq * gq[0], q[1] * rq * gq[1]); w.y = cvt_pk_bf16(q[2] * rq * gq[2], q[3] * rq * gq[3]);
                    *(u32x2*)(BF(WS_AQN) + (size_t)row * 256 + 4 * lane) = w; }
                const f32x2 gk = *(const f32x2*)(KIN(I_MKVAN) + 2 * lane);
                *(unsigned*)(BF(WS_CKVN) + (size_t)row * 128 + 2 * lane) = cvt_pk_bf16(kv[0] * rk * gk[0], kv[1] * rk * gk[1]);
                if (lane < 32) FP(WS_KPE)[(size_t)row * 32 + lane] = ar[384 + lane];
            }
        }
        else if (PHASE(14)) {
            const int h = lane >> 2, q = lane & 3;
            for (int it = TX + gw; it < TX + TT; it += NGW) {
                const bool isq = it < TX; const int row = isq ? it : it - TX;
                const bf16_t* bsrc = isq ? BF(WS_QB) + (size_t)row * 1536 + h * 96 : BF(WS_KRAW) + (size_t)row * 1024 + h * 64;
                const float* kper = FP(WS_KPE) + (size_t)row * 32;
                const float* gn = isq ? KIN(I_MQN) : KIN(I_MKN);
                float v[3][8]; float ss = 0.f;
#pragma unroll
                for (int j = 0; j < 3; ++j) { const int d0 = 8 * (3 * q + j); const bool frombf = isq || d0 < 64;
                    const int db = frombf ? d0 : 0, dk = frombf ? 0 : d0 - 64;
                    const u32x4 raw = *(const u32x4*)(bsrc + db); const f32x4 t0 = *(const f32x4*)(kper + dk), t1 = *(const f32x4*)(kper + dk + 4);
                    v[j][0] = frombf ? __uint_as_float(raw.x << 16) : t0[0]; v[j][1] = frombf ? __uint_as_float(raw.x & 0xffff0000u) : t0[1];
                    v[j][2] = frombf ? __uint_as_float(raw.y << 16) : t0[2]; v[j][3] = frombf ? __uint_as_float(raw.y & 0xffff0000u) : t0[3];
                    v[j][4] = frombf ? __uint_as_float(raw.z << 16) : t1[0]; v[j][5] = frombf ? __uint_as_float(raw.z & 0xffff0000u) : t1[1];
                    v[j][6] = frombf ? __uint_as_float(raw.w << 16) : t1[2]; v[j][7] = frombf ? __uint_as_float(raw.w & 0xffff0000u) : t1[3];
#pragma unroll
                    for (int e = 0; e < 8; ++e) ss += v[j][e] * v[j][e]; }
                ss += __shfl_xor(ss, 1); ss += __shfl_xor(ss, 2);
                const float rstd = 1.0f / sqrtf(ss * (1.f / 96.f) + EPS);
#pragma unroll
                for (int j = 0; j < 3; ++j) { const int d0 = 8 * (3 * q + j); const f32x4 g0 = *(const f32x4*)(gn + d0), g1 = *(const f32x4*)(gn + d0 + 4);
#pragma unroll
                    for (int e = 0; e < 4; ++e) { v[j][e] *= rstd * g0[e]; v[j][4 + e] *= rstd * g1[e]; } }
                if (row < TX) { const int t = row & 4095; const float pr = (float)(t >> 6), pc = (float)(t & 63);
#pragma unroll
                    for (int e = 0; e < 8; ++e) { const float invf = exp2f(-(float)e * (13.287712379549449f / 8.f));
                        const float rr_ = pr * invf * 0.15915494309189535f, rc_ = pc * invf * 0.15915494309189535f;
                        const float sr = __builtin_amdgcn_sinf(rr_), cr = __builtin_amdgcn_cosf(rr_), sc_ = __builtin_amdgcn_sinf(rc_), cc = __builtin_amdgcn_cosf(rc_);
                        const float send = (q == 2) ? v[2][e] : v[0][e]; const float recv = __shfl_xor(send, 1);
                        if (q == 2) v[2][e] = v[2][e] * cr - recv * sr;
                        if (q == 3) { v[0][e] = recv * sr + v[0][e] * cr; const float b1 = v[1][e], b2 = v[2][e]; v[1][e] = b1 * cc - b2 * sc_; v[2][e] = b1 * sc_ + b2 * cc; } } }
                const float osc = isq ? att::QSCALE : 1.f;
                bf16_t* dst = (isq ? BF(WS_QB) : BF(WS_KB)) + (size_t)row * 1536 + h * 96;
#pragma unroll
                for (int j = 0; j < 3; ++j) { const int d0 = 8 * (3 * q + j); u32x4 w; w.x = cvt_pk_bf16(v[j][0] * osc, v[j][1] * osc); w.y = cvt_pk_bf16(v[j][2] * osc, v[j][3] * osc);
                    w.z = cvt_pk_bf16(v[j][4] * osc, v[j][5] * osc); w.w = cvt_pk_bf16(v[j][6] * osc, v[j][7] * osc); *(u32x4*)(dst + d0) = w; }
            }
        }
        else if (PHASE(15)) {
            const int vcu = (G % 8 == 0) ? (bid % 8) * (G / 8) + bid / 8 : bid;
            const int per = (2048 + G - 1) / G;
            int tid3 = tid; asm volatile("" : "+v"(tid3));
            for (int k = 0; k < per; ++k) {
                int un = vcu * per + k;
                if (G == 256) {
                    const int xcd = vcu >> 5, loc = vcu & 31; un = ((xcd * 16 + 2 * k + (loc >> 4)) << 4) | (loc & 15); }
                if (un >= 2048) break;
                const int bh = un >> 4, qb = un & 15;
                att::attn_unit(bh >> 4, bh & 15, qb, BF(WS_QB), BF(WS_KB), BF(WS_VB), BF(WS_OB), lds, tid3, KIN(I_MQN)); }
        }
        else if (PHASE(17)) {
            modnorm_rows(FP(WS_XR), FP(WS_XR) + (size_t)TX * DM, TX, KIN(I_NORM2) + 1024, mod + 9 * 6144 + 3 * 1024, mod + 9 * 6144 + 4 * 1024, BF(WS_HX), gw, NGW, lane);
        }
        if (ph + 1 < ph_hi) { __syncthreads(); if (HI == 1) cg::this_grid().sync(); else { ++nbar; grid_barrier((unsigned*)(ws + WS_BAR), nbar * (unsigned)G, tid); } }
        if (DUP_PH >= 0 && ph == DUP_PH && dup_left > 0) { --dup_left; --ph; }
    }
}
#undef PHASE
#undef BF
#undef FP
__global__ void __launch_bounds__(NTHREADS, 2) mega(Args a) {
    extern __shared__ __attribute__((aligned(16))) unsigned char lds_raw[];
    LAS unsigned char* lds = (LAS unsigned char*)lds_raw;
    const int G = gridDim.x;
    const int ph_lo = a.ph_lo, ph_hi = a.ph_hi;
    const int wave0 = __builtin_amdgcn_readfirstlane((int)threadIdx.x >> 6);
    unsigned nbar = 0;
    run_phases<0, 1>(lds, ph_lo, ph_hi, G, wave0, nbar);
    run_phases<1, 10>(lds, ph_lo, ph_hi, G, wave0, nbar);
    run_phases<10, 20>(lds, ph_lo, ph_hi, G, wave0, nbar);
}

extern "C" void kernel_launch(void* const* d_in, const int* in_sizes, int n_in, void* d_out, int out_size, void* d_ws, size_t ws_size, hipStream_t stream) {
    static int grid = 0;
    if (grid == 0) {
        if (n_in != 33 || ws_size < WS_END) { fprintf(stderr, "kernel_launch: need 33 inputs and >= %zu bytes of workspace; got %d, %zu\n", (size_t)WS_END, n_in, ws_size); grid = -1; return; }
        int dev = 0, cus = 0, per_cu = 0;
        hipGetDevice(&dev); hipDeviceGetAttribute(&cus, hipDeviceAttributeMultiprocessorCount, dev);
        if (hipFuncSetAttribute((const void*)mega, hipFuncAttributeMaxDynamicSharedMemorySize, LDS_BYTES) != hipSuccess) { fprintf(stderr, "kernel_launch: hipFuncSetAttribute failed\n"); grid = -1; return; }
        hipOccupancyMaxActiveBlocksPerMultiprocessor(&per_cu, (const void*)mega, NTHREADS, LDS_BYTES);
        if (per_cu < 1) { fprintf(stderr, "kernel_launch: occupancy query says %d blocks per CU\n", per_cu); per_cu = 1; }
        (void)hipGetLastError();
        grid = cus;
    }
    if (grid < 0) return;
    Args a{};
    for (int i = 0; i < 33; ++i) a.in[i] = (const float*)d_in[i];
    a.out = (float*)d_out; a.ws = (unsigned char*)d_ws;
#if MK_COOP
    (void)hipMemsetAsync((char*)d_ws + WS_BAR, 0, 256, stream);
    a.ph_lo = 0; a.ph_hi = NPH;
    void* args[] = {&a};
    hipError_t e = hipLaunchCooperativeKernel((const void*)mega, dim3(grid), dim3(NTHREADS), args, LDS_BYTES, stream);
    if (e != hipSuccess) fprintf(stderr, "cooperative launch failed: %s (grid %d)\n", hipGetErrorString(e), grid);
#else
#ifndef NPH_RUN
#define NPH_RUN NPH
#endif
    for (int ph = 0; ph < NPH_RUN; ++ph) { a.ph_lo = ph; a.ph_hi = ph + 1;
        hipLaunchKernelGGL(mega, dim3(grid), dim3(NTHREADS), LDS_BYTES, stream, a); }
#endif
}
```
